# Optimizing an MI355X kernel written in HIP

```python
import math
import jax, jax.numpy as jnp
from jax import lax
import numpy as np

D_MODEL = 1024
BATCH = 8
SEQ = 2048
DEPTH = 2

HEAD_DIM = 64
SB_WIDTH = D_MODEL // 2
N_HEADS_SB = SB_WIDTH // HEAD_DIM
DSA_WIDTH = D_MODEL // 2
N_HEADS_DSA = DSA_WIDTH // HEAD_DIM
KV_DIM = HEAD_DIM
IDX_HEADS = 8
IDX_DIM = 64
INDEX_TOPK_MAX = 256
BLOCK_Q = 128
REL_BUCKETS = 32
REL_MAX_DIST = 128
N_EXPERTS = 16
N_GROUPS = 4
EXPERTS_PER_GROUP = N_EXPERTS // N_GROUPS
TOP_K = 2
D_EXPERT = D_MODEL // 2
N_MOD = 6
EPS = 1e-6

IN_SIZES = [SB_WIDTH, SB_WIDTH, SB_WIDTH,
            DSA_WIDTH, KV_DIM, KV_DIM,
            IDX_HEADS * IDX_DIM, IDX_DIM, IDX_HEADS,
            D_MODEL, D_MODEL]
N_IN = int(sum(IN_SIZES))
IN_OFFSETS = [int(o) for o in np.cumsum(IN_SIZES)[:-1]]

kernel_name = "hybrid_stickbreak_dsa_grouped_moe_adaln"


def rmsnorm(x, g):
    xf = x.astype(jnp.float32)
    y = xf * lax.rsqrt(jnp.mean(xf * xf, axis=-1, keepdims=True) + EPS)
    return (y * g.astype(jnp.float32)).astype(x.dtype)


def t5_bucket(dist):
    max_exact = REL_BUCKETS // 2
    is_small = dist < max_exact
    d_f = jnp.maximum(dist, 1).astype(jnp.float32)
    large = max_exact + (jnp.log(d_f / max_exact) / math.log(REL_MAX_DIST / max_exact)
                         * (REL_BUCKETS - max_exact)).astype(jnp.int32)
    large = jnp.minimum(large, REL_BUCKETS - 1)
    return jnp.where(is_small, dist, large)


def stick_breaking_attention(q, k, v):
    B, S, H, dh = q.shape
    outs = []
    for start in range(0, S, BLOCK_Q):
        end = start + BLOCK_Q
        z = jnp.einsum('bqhd,bkhd->bhqk', q[:, start:end], k[:, :end]).astype(jnp.float32) * dh ** -0.5
        t_pos = start + jnp.arange(BLOCK_Q)[:, None]
        s_pos = jnp.arange(end)[None, :]
        before = s_pos < t_pos
        log_1m = jnp.where(before, jax.nn.log_sigmoid(-z), 0.0)
        csum = jnp.cumsum(log_1m, axis=-1)
        log_a = jax.nn.log_sigmoid(z) + (csum[..., -1:] - csum)
        a = jnp.where(before, jnp.exp(log_a), 0.0)
        outs.append(jnp.einsum('bhqk,bkhd->bqhd', a.astype(v.dtype), v[:, :end]))
    return jnp.concatenate(outs, axis=1)


def dsa_sparse_attention(q, k, v, q_idx, k_idx, w_idx, rel_bias):
    B, S, H, dh = q.shape
    ktop = min(INDEX_TOPK_MAX, S // 4)
    gather = jax.vmap(lambda arr, idx: arr[idx])
    outs = []
    for start in range(0, S, BLOCK_Q):
        end = start + BLOCK_Q
        kl = min(S, max(end, ktop))
        t_pos = start + jnp.arange(BLOCK_Q)[:, None]
        s_pos = jnp.arange(kl)[None, :]
        dots = jnp.einsum('bqhd,bkd->bqhk', q_idx[:, start:end], k_idx[:, :kl]).astype(jnp.float32)
        score = jnp.einsum('bqh,bqhk->bqk', w_idx[:, start:end].astype(jnp.float32), jax.nn.relu(dots))
        score = jnp.where(s_pos <= t_pos, score, -jnp.inf)
        _, sel = lax.top_k(score, ktop)
        k_sel = gather(k[:, :kl], sel)
        v_sel = gather(v[:, :kl], sel)
        dist = t_pos[None] - sel
        valid = dist >= 0
        bias = rel_bias[t5_bucket(jnp.maximum(dist, 0))]
        logits = (jnp.einsum('bqhd,bqkd->bhqk', q[:, start:end], k_sel).astype(jnp.float32) * dh ** -0.5
                  + jnp.transpose(bias, (0, 3, 1, 2)).astype(jnp.float32))
        logits = jnp.where(valid[:, None], logits, -jnp.inf)
        p = jax.nn.softmax(logits, axis=-1)
        outs.append(jnp.einsum('bhqk,bqkd->bqhd', p.astype(v.dtype), v_sel))
    return jnp.concatenate(outs, axis=1)


def grouped_moe(h, router_w, router_b, w_gate, w_up, w_down):
    B, S, D = h.shape
    t = h.reshape(-1, D)
    logits = (t @ router_w).astype(jnp.float32) + router_b.astype(jnp.float32)
    probs = jax.nn.softmax(logits, axis=-1)
    pg = probs.reshape(-1, N_GROUPS, EXPERTS_PER_GROUP)
    group_score = jnp.sum(lax.top_k(pg, TOP_K)[0], axis=-1)
    g = jnp.argmax(group_score, axis=-1)
    in_group = jnp.take_along_axis(pg, g[:, None, None], axis=1)[:, 0]
    vals, local = lax.top_k(in_group, TOP_K)
    experts = g[:, None] * EXPERTS_PER_GROUP + local
    weights = vals / jnp.sum(vals, axis=-1, keepdims=True)
    combine = jnp.sum(jax.nn.one_hot(experts, N_EXPERTS, dtype=jnp.float32) * weights[..., None], axis=1)
    hidden = jax.nn.silu(jnp.einsum('td,edf->tef', t, w_gate)) * jnp.einsum('td,edf->tef', t, w_up)
    hidden = hidden * combine[:, :, None].astype(hidden.dtype)
    y = jnp.einsum('tef,efd->td', hidden, w_down)
    return y.reshape(B, S, D)


def setup_inputs(seed: int = 0) -> dict:
    key = jax.random.key(seed)
    ks = jax.random.split(key, 20)
    f32 = jnp.float32
    nrm = lambda k, shape, s: jax.random.normal(k, shape, f32) * s
    return {
        "x": nrm(ks[0], (BATCH, SEQ, D_MODEL), 1.0),
        "c": nrm(ks[1], (BATCH, D_MODEL), 1.0),
        "w_ada": nrm(ks[2], (DEPTH, D_MODEL, N_MOD * D_MODEL), 0.5 * D_MODEL ** -0.5),
        "b_ada": nrm(ks[3], (DEPTH, N_MOD * D_MODEL), 0.02),
        "norm1_g": 1.0 + nrm(ks[4], (DEPTH, D_MODEL), 0.02),
        "w_in": nrm(ks[5], (DEPTH, D_MODEL, N_IN), D_MODEL ** -0.5),
        "q_norm_g": 1.0 + nrm(ks[6], (DEPTH, HEAD_DIM), 0.02),
        "k_norm_g": 1.0 + nrm(ks[7], (DEPTH, KV_DIM), 0.02),
        "rel_bias": nrm(ks[8], (REL_BUCKETS, N_HEADS_DSA), 0.5),
        "w_o_a": nrm(ks[9], (DEPTH, SB_WIDTH, D_MODEL), SB_WIDTH ** -0.5),
        "w_o_b": nrm(ks[10], (DEPTH, DSA_WIDTH, D_MODEL), DSA_WIDTH ** -0.5),
        "w_out": nrm(ks[11], (DEPTH, D_MODEL, D_MODEL), D_MODEL ** -0.5),
        "norm2_g": 1.0 + nrm(ks[12], (DEPTH, D_MODEL), 0.02),
        "router_w": nrm(ks[13], (D_MODEL, N_EXPERTS), D_MODEL ** -0.5),
        "router_b": nrm(ks[14], (N_EXPERTS,), 0.01),
        "w_gate": nrm(ks[15], (DEPTH, N_EXPERTS, D_MODEL, D_EXPERT), D_MODEL ** -0.5),
        "w_up": nrm(ks[16], (DEPTH, N_EXPERTS, D_MODEL, D_EXPERT), D_MODEL ** -0.5),
        "w_down": nrm(ks[17], (DEPTH, N_EXPERTS, D_EXPERT, D_MODEL), D_EXPERT ** -0.5),
    }


def reference(x, c, w_ada, b_ada, norm1_g, w_in, q_norm_g, k_norm_g, rel_bias,
              w_o_a, w_o_b, w_out, norm2_g, router_w, router_b, w_gate, w_up, w_down):
    B, S, D = x.shape
    for l in range(DEPTH):
        mod = jax.nn.silu(c) @ w_ada[l] + b_ada[l]
        shift1, scale1, gate1, shift2, scale2, gate2 = [m[:, None, :] for m in jnp.split(mod, N_MOD, axis=-1)]

        h = rmsnorm(x, norm1_g[l]) * (1.0 + scale1) + shift1
        proj = h @ w_in[l]
        (q_a, k_a, v_a, q_b, k_b, v_b, q_i, k_i, w_i, g_a, g_b) = jnp.split(proj, IN_OFFSETS, axis=-1)

        q_a = q_a.reshape(B, S, N_HEADS_SB, HEAD_DIM)
        k_a = k_a.reshape(B, S, N_HEADS_SB, HEAD_DIM)
        v_a = v_a.reshape(B, S, N_HEADS_SB, HEAD_DIM)
        o_a = stick_breaking_attention(q_a, k_a, v_a).reshape(B, S, SB_WIDTH)

        q_b = rmsnorm(q_b.reshape(B, S, N_HEADS_DSA, HEAD_DIM), q_norm_g[l])
        k_b = rmsnorm(k_b, k_norm_g[l])
        q_i = q_i.reshape(B, S, IDX_HEADS, IDX_DIM)
        o_b = dsa_sparse_attention(q_b, k_b, v_b, q_i, k_i, w_i, rel_bias).reshape(B, S, DSA_WIDTH)

        merged = jax.nn.sigmoid(g_a) * (o_a @ w_o_a[l]) + jax.nn.sigmoid(g_b) * (o_b @ w_o_b[l])
        x = x + gate1 * (merged @ w_out[l])

        h2 = rmsnorm(x, norm2_g[l]) * (1.0 + scale2) + shift2
        x = x + gate2 * grouped_moe(h2, router_w, router_b, w_gate[l], w_up[l], w_down[l])
    return x
```

```cpp
#include <hip/hip_runtime.h>
#include <cstdio>
#include <cstdint>

#define LAS __attribute__((address_space(3)))
#define GAS __attribute__((address_space(1)))
typedef unsigned short bf16_t;
typedef short bf16x8 __attribute__((ext_vector_type(8)));
typedef float f32x4 __attribute__((ext_vector_type(4)));
typedef float f32x2 __attribute__((ext_vector_type(2)));
typedef unsigned u32x4 __attribute__((ext_vector_type(4)));
typedef unsigned u32x2 __attribute__((ext_vector_type(2)));

constexpr int BATCH = 8, SEQ = 2048, DM = 1024, T = BATCH * SEQ, DEPTH = 2;
constexpr int NIN = 4808, NMOD = 6 * DM;
constexpr int NE = 16, DEXP = 512;
constexpr int NMAIN = 4352;
constexpr int PMAX = 36864;
constexpr float EPS = 1e-6f;
constexpr int NWAVES = 8, NTHR = 512;

#ifndef ONE_LAUNCH
#define ONE_LAUNCH 1
#endif

constexpr size_t MiB = 1u << 20;
constexpr size_t WS_CTL = 0, CTL_ZERO_BYTES = 1 * MiB;
constexpr size_t WS_MOD = 1 * MiB;
constexpr size_t WS_MODP = 2 * MiB;
constexpr size_t WS_ETOK = 8 * MiB, WS_EW = 9 * MiB, WS_EDST = 10 * MiB;
constexpr size_t WS_SLOTW = 11 * MiB, WS_SLOTD = 11 * MiB + 256 * 1024;
constexpr size_t WS_MASK = 12 * MiB;
constexpr size_t WS_WIN = 16 * MiB;
constexpr size_t WIN_LAYER = (size_t)4864 * 1024 * 2;
constexpr size_t WS_WO = 35 * MiB, WS_WOUT = 39 * MiB;
constexpr size_t WS_WGU = 43 * MiB;
constexpr size_t WS_WD = 75 * MiB;
constexpr size_t WS_H = 92 * MiB;
constexpr size_t WS_QA = 124 * MiB, WS_KA = 140 * MiB, WS_VAT = 156 * MiB, WS_QB = 172 * MiB, WS_QI = 188 * MiB;
constexpr size_t WS_KB = 204 * MiB, WS_VB = 206 * MiB, WS_KI = 208 * MiB, WS_WI = 210 * MiB;
constexpr size_t WS_SGA = 212 * MiB, WS_SGB = 244 * MiB, WS_OAB = 276 * MiB;
constexpr size_t WS_MERGED = 124 * MiB;
constexpr size_t WS_TMP = 156 * MiB;
constexpr size_t WS_XG = 124 * MiB;
constexpr size_t WS_HID = 196 * MiB;
constexpr size_t WS_Y = 232 * MiB;
constexpr size_t WS_END = 308 * MiB;
constexpr int CW_GCNT = 64;
constexpr int CW_BAR = 4096;

#define LDS_WAIT() asm volatile("s_waitcnt lgkmcnt(0)" ::: "memory")
#define VM_WAIT() asm volatile("s_waitcnt vmcnt(0)" ::: "memory")
#define RLX_AGENT __ATOMIC_RELAXED, __HIP_MEMORY_SCOPE_AGENT
__device__ __forceinline__ unsigned f2bf(float f) { unsigned u = __builtin_bit_cast(unsigned, f); return (u + 0x7fffu + ((u >> 16) & 1u)) >> 16; }
__device__ __forceinline__ unsigned pk2(float lo, float hi) { return f2bf(lo) | (f2bf(hi) << 16); }
__device__ __forceinline__ float bflo(unsigned w) { return __builtin_bit_cast(float, w << 16); }
__device__ __forceinline__ float bfhi(unsigned w) { return __builtin_bit_cast(float, w & 0xffff0000u); }
__device__ __forceinline__ float bf2f(bf16_t h) { return __builtin_bit_cast(float, (unsigned)h << 16); }
__device__ __forceinline__ unsigned cvt_pk_bf16(float lo, float hi) { unsigned r; asm volatile("v_cvt_pk_bf16_f32 %0, %1, %2" : "=v"(r) : "v"(lo), "v"(hi)); return r; }
__device__ __forceinline__ u32x4 pack8(f32x4 a, f32x4 b) { u32x4 w; w.x = cvt_pk_bf16(a[0], a[1]); w.y = cvt_pk_bf16(a[2], a[3]); w.z = cvt_pk_bf16(b[0], b[1]); w.w = cvt_pk_bf16(b[2], b[3]); return w; }
__device__ __forceinline__ float sigmoidf_(float x) { return 1.f / (1.f + __expf(-x)); }
__device__ __forceinline__ float wave_sum(float v) {
#pragma unroll
    for (int o = 1; o < 64; o <<= 1) v += __shfl_xor(v, o);
    return v;
}

namespace pg8 {
constexpr int BM = 256, BK = 64, HALF = 128, HTB = HALF * BK * 2, STAGE_BYTES = 8 * HTB, NXCD = 8, WGM = 8;
__host__ __device__ __forceinline__ int lds_byte(int r, int c) { const int st = (r >> 4) * 2 + (c >> 5), rr = r & 15, cc = c & 31, ob = rr * 64 + cc * 2; return st * 1024 + (ob ^ (((ob >> 9) & 1) << 5)); }
__host__ __device__ __forceinline__ void stage_rc(int b, int& R, int& C) { const int st = b / 1024, sb = b % 1024, swz = sb ^ (((sb >> 9) & 1) << 5); R = (st >> 1) * 16 + swz / 64; C = (st & 1) * 32 + (swz % 64) / 2; }
__host__ __device__ __forceinline__ int perm32(int rho) { const int n = rho >> 4, i = rho & 15; return 8 * (i >> 2) + 4 * n + (i & 3); }

struct Unit { int pm, pn; };
struct Gemm { const bf16_t* A; const bf16_t* Bt; };

struct StaticOrder {
    int nM, nN, nwg, G, c;
    __host__ __device__ void init(int M, int N, int G_, int c_) { nM = M / BM; nN = N / BM; nwg = nM * nN; G = G_; c = c_; }
    __host__ __device__ bool next(int i, Unit& u) const {
        const long L = (long)i * G + c; if (L >= nwg) return false;
        int wgid = (int)L; { const int q = nwg / NXCD, r = nwg % NXCD, xcd = wgid % NXCD, off = wgid / NXCD; wgid = (xcd < r ? xcd * (q + 1) : r * (q + 1) + (xcd - r) * q) + off; }
        const int nig = WGM * nN, gid = wgid / nig, fm = gid * WGM, gsz = (nM - fm) < WGM ? (nM - fm) : WGM;
        u.pm = fm + ((wgid % nig) % gsz); u.pn = (wgid % nig) / gsz; return true;
    }
    __device__ __forceinline__ void a_ready(const Unit&) const {}
    __device__ __forceinline__ void done(const Unit&) const {}
};

template <int LDA, int LDB, int KK, class Epi, class Sched, bool ALIGN_EPI>
__device__ __forceinline__ void gemm_phase(LAS unsigned char* lds, const Gemm g, const Sched& S, const Epi& E) {
    int tid = threadIdx.x; asm volatile("" : "+v"(tid));
    const int wid = __builtin_amdgcn_readfirstlane(tid >> 6), lane = tid & 63, wr = wid >> 2, wc = wid & 3, fr = lane & 15, fq = lane >> 4;
    constexpr int nt = KK / BK;
    unsigned voffA[2], voffB[2];
#pragma unroll
    for (int i = 0; i < 2; ++i) { int R, C; stage_rc(tid * 16 + i * 8192, R, C); const int Rb = Epi::PERM ? ((R & ~31) + perm32(R & 31)) : R;
        voffA[i] = (unsigned)(R * LDA + C) * 2u; voffB[i] = (unsigned)(Rb * LDB + C) * 2u; }
    constexpr size_t kstep = (size_t)(BK * 2);
    constexpr size_t hstepA = (size_t)HALF * LDA * 2, hstepB = (size_t)HALF * LDB * 2;
    constexpr size_t tstepA = 2 * hstepA, tstepB = 2 * hstepB;
    const unsigned ldsw = (unsigned)wid * 1024u;
    const int aoff = lds_byte(wr * 64 + fr, fq * 8), boff = lds_byte(wc * 32 + fr, fq * 8);
#define PG8_SA(b, h) (((b) * 2 + (h)) * HTB)
#define PG8_SB(b, h) ((4 + (b) * 2 + (h)) * HTB)
#define PG8_STAGE(bufoff, gbase, voff) do { _Pragma("unroll") for (int _i = 0; _i < 2; ++_i) \
        __builtin_amdgcn_global_load_lds((const unsigned*)((const char*)(gbase) + (voff)[_i]), (LAS unsigned*)(lds + (bufoff) + ldsw + _i * 8192), 16, 0, 0); } while (0)
#define PG8_LDA(dst, b, h) do { _Pragma("unroll") for (int m = 0; m < 4; ++m) _Pragma("unroll") for (int k = 0; k < 2; ++k) dst[m][k] = *(const LAS bf16x8*)(lds + PG8_SA(b, h) + aoff + m * 2048 + k * 1024); } while (0)
#define PG8_LDB(dst, b, h) do { _Pragma("unroll") for (int n = 0; n < 2; ++n) _Pragma("unroll") for (int k = 0; k < 2; ++k) dst[n][k] = *(const LAS bf16x8*)(lds + PG8_SB(b, h) + boff + n * 2048 + k * 1024); } while (0)
#define PG8_MMA(ai, bj, At, Bt) do { __builtin_amdgcn_s_setprio(1); _Pragma("unroll") for (int m = 0; m < 4; ++m) _Pragma("unroll") for (int n = 0; n < 2; ++n) _Pragma("unroll") for (int k = 0; k < 2; ++k) \
        acc[ai][bj][m][n] = __builtin_amdgcn_mfma_f32_16x16x32_bf16(Bt[n][k], At[m][k], acc[ai][bj][m][n], 0, 0, 0); __builtin_amdgcn_s_setprio(0); } while (0)
#define PG8_WAIT_V(n) asm volatile("s_waitcnt vmcnt(" #n ")" ::: "memory")
#define PG8_WAIT_L(n) asm volatile("s_waitcnt lgkmcnt(" #n ")" ::: "memory")
#define PG8_BAR __builtin_amdgcn_s_barrier()
#define PG8_SCHED __builtin_amdgcn_sched_barrier(0)
    Unit cur, nxt; int ui = 0;
    if (!S.next(0, cur)) return;
    f32x4 acc[2][2][4][2];
#pragma unroll
    for (int a = 0; a < 2; ++a)
#pragma unroll
        for (int b = 0; b < 2; ++b)
#pragma unroll
            for (int m = 0; m < 4; ++m)
#pragma unroll
                for (int n = 0; n < 2; ++n) acc[a][b][m][n] = (f32x4){0.f, 0.f, 0.f, 0.f};
    bf16x8 At[4][2], B0[2][2], B1[2][2];
    const char* cA = (const char*)g.A + (size_t)cur.pm * tstepA; const char* cB = (const char*)g.Bt + (size_t)cur.pn * tstepB;
    S.a_ready(cur);
    PG8_STAGE(PG8_SB(0, 0), cB, voffB); PG8_STAGE(PG8_SB(0, 1), cB + hstepB, voffB); PG8_STAGE(PG8_SA(0, 0), cA, voffA); PG8_STAGE(PG8_SA(0, 1), cA + hstepA, voffA);
    if (wr == 1) PG8_BAR;
    PG8_WAIT_V(2); PG8_BAR;
    PG8_STAGE(PG8_SB(1, 0), cB + kstep, voffB); PG8_STAGE(PG8_SA(1, 0), cA + kstep, voffA); PG8_STAGE(PG8_SB(1, 1), cB + hstepB + kstep, voffB);
    PG8_WAIT_V(6); PG8_BAR;
    for (;;) {
        const bool has_next = S.next(ui + 1, nxt);
        const char* nA = has_next ? (const char*)g.A + (size_t)nxt.pm * tstepA : cA; const char* nB = has_next ? (const char*)g.Bt + (size_t)nxt.pn * tstepB : cB;
        for (int t = 0; t < nt; t += 2) {
            const bool last = (t == nt - 2);
            const char* a1 = cA + (size_t)(t + 1) * kstep;
            const char* a2 = last ? nA : cA + (size_t)(t + 2) * kstep; const char* b2 = last ? nB : cB + (size_t)(t + 2) * kstep;
            const char* a3 = a2 + kstep; const char* b3 = b2 + kstep;
            if (last && has_next) S.a_ready(nxt);
            PG8_LDB(B0, 0, 0); PG8_LDB(B1, 0, 1); PG8_SCHED; PG8_LDA(At, 0, 0); PG8_STAGE(PG8_SA(1, 1), a1 + hstepA, voffA);
            PG8_WAIT_V(8); PG8_WAIT_L(0); PG8_BAR; PG8_MMA(0, 0, At, B0); PG8_MMA(0, 1, At, B1); PG8_BAR; PG8_SCHED;
            PG8_LDA(At, 0, 1); PG8_STAGE(PG8_SB(0, 0), b2, voffB); PG8_STAGE(PG8_SB(0, 1), b2 + hstepB, voffB); PG8_STAGE(PG8_SA(0, 0), a2, voffA);
            PG8_WAIT_V(8); PG8_WAIT_L(0); PG8_BAR; PG8_MMA(1, 0, At, B0); PG8_MMA(1, 1, At, B1); PG8_BAR; PG8_SCHED;
            PG8_LDB(B0, 1, 0); PG8_LDB(B1, 1, 1); PG8_SCHED; PG8_LDA(At, 1, 0); PG8_STAGE(PG8_SA(0, 1), a2 + hstepA, voffA);
            PG8_WAIT_V(8); PG8_WAIT_L(0); PG8_BAR; PG8_MMA(0, 0, At, B0); PG8_MMA(0, 1, At, B1); PG8_BAR; PG8_SCHED;
            PG8_LDA(At, 1, 1); PG8_STAGE(PG8_SB(1, 0), b3, voffB); PG8_STAGE(PG8_SB(1, 1), b3 + hstepB, voffB); PG8_STAGE(PG8_SA(1, 0), a3, voffA);
            PG8_WAIT_V(8); PG8_WAIT_L(0); PG8_BAR; PG8_MMA(1, 0, At, B0); PG8_MMA(1, 1, At, B1); PG8_BAR; PG8_SCHED;
        }
        if constexpr (ALIGN_EPI) { if (wr == 0) PG8_BAR; }
        E(acc, cur, wr, wc, fr, fq); S.done(cur);
        if (!has_next) break;
#pragma unroll
        for (int a = 0; a < 2; ++a)
#pragma unroll
            for (int b = 0; b < 2; ++b)
#pragma unroll
                for (int m = 0; m < 4; ++m)
#pragma unroll
                    for (int n = 0; n < 2; ++n) acc[a][b][m][n] = (f32x4){0.f, 0.f, 0.f, 0.f};
        cur = nxt; cA = nA; cB = nB; ++ui;
        if constexpr (ALIGN_EPI) { if (wr == 1) PG8_BAR; }
    }
    PG8_WAIT_V(0);
    if constexpr (!ALIGN_EPI) { if (wr == 0) PG8_BAR; }
    PG8_BAR;
#undef PG8_SA
#undef PG8_SB
#undef PG8_STAGE
#undef PG8_LDA
#undef PG8_LDB
#undef PG8_MMA
#undef PG8_WAIT_V
#undef PG8_WAIT_L
#undef PG8_BAR
#undef PG8_SCHED
}
}
typedef f32x4 AccT[2][2][4][2];

template <int SIG> __device__ __forceinline__ void store_tile_bf16(bf16_t* O, int ld, int colt, float sc, const AccT& acc, int row0, int wc, int fq) {
    const int col0 = colt + wc * 32 + 8 * fq;
#pragma unroll
    for (int ai = 0; ai < 2; ++ai)
#pragma unroll
        for (int m = 0; m < 4; ++m) { bf16_t* rowp = O + (size_t)(row0 + ai * 128 + m * 16) * ld + col0;
#pragma unroll
            for (int bj = 0; bj < 2; ++bj) { f32x4 v0 = acc[ai][bj][m][0] * sc, v1 = acc[ai][bj][m][1] * sc;
                if (SIG) {
#pragma unroll
                    for (int i = 0; i < 4; ++i) { v0[i] = sigmoidf_(v0[i]); v1[i] = sigmoidf_(v1[i]); } }
                *(u32x4*)(rowp + bj * 128) = pack8(v0, v1); } }
}
template <int NORM> __device__ __forceinline__ void store_head64(bf16_t* O, int ld, int cbase, const float* gain, float gsc, const AccT& acc, int row0, int fq) {
    f32x4 gq[2][2];
#pragma unroll
    for (int bj = 0; bj < 2; ++bj)
#pragma unroll
        for (int n = 0; n < 2; ++n) gq[bj][n] = NORM ? *(const f32x4*)(gain + 32 * bj + 8 * fq + 4 * n) * gsc : (f32x4){1.f, 1.f, 1.f, 1.f};
#pragma unroll
    for (int ai = 0; ai < 2; ++ai)
#pragma unroll
        for (int m = 0; m < 4; ++m) {
            float r = 1.f;
            if (NORM) { float ss = 0.f;
#pragma unroll
                for (int bj = 0; bj < 2; ++bj)
#pragma unroll
                    for (int n = 0; n < 2; ++n) { const f32x4 x = acc[ai][bj][m][n]; ss += (x[0] * x[0] + x[1] * x[1]) + (x[2] * x[2] + x[3] * x[3]); }
                ss += __shfl_xor(ss, 16); ss += __shfl_xor(ss, 32);
                r = 1.0f / sqrtf(ss * (1.0f / 64.0f) + EPS); }
            bf16_t* rowp = O + (size_t)(row0 + ai * 128 + m * 16) * ld + cbase + 8 * fq;
#pragma unroll
            for (int bj = 0; bj < 2; ++bj) { const f32x4 v0 = acc[ai][bj][m][0] * r * gq[bj][0], v1 = acc[ai][bj][m][1] * r * gq[bj][1];
                *(u32x4*)(rowp + 32 * bj) = pack8(v0, v1); } }
}
struct EpiIn {
    static constexpr bool PERM = true;
    bf16_t *qa, *ka, *qb, *qi, *kb, *vb, *ki, *sga, *sgb; float* wi; const float *qg, *kg;
    __device__ __forceinline__ void operator()(const AccT& acc, const pg8::Unit& u, int wr, int wc, int fr, int fq) const {
        asm volatile("" : "+v"(fr), "+v"(fq));
        const int pn = u.pn, row0 = u.pm * 256 + wr * 64 + fr;
        if (pn < 2) store_tile_bf16<0>(qa, 512, pn * 256, 0.125f, acc, row0, wc, fq);
        else if (pn < 4) store_tile_bf16<0>(ka, 512, (pn - 2) * 256, 1.f, acc, row0, wc, fq);
        else if (pn < 6) store_head64<1>(qb, 512, ((pn - 4) * 4 + wc) * 64, qg, 0.125f, acc, row0, fq);
        else if (pn < 8) store_tile_bf16<0>(qi, 512, (pn - 6) * 256, 1.f, acc, row0, wc, fq);
        else if (pn == 8) {
            if (wc == 0) store_head64<1>(kb, 64, 0, kg, 1.f, acc, row0, fq);
            else if (wc == 1) store_head64<0>(vb, 64, 0, nullptr, 1.f, acc, row0, fq);
            else if (wc == 2) store_head64<0>(ki, 64, 0, nullptr, 1.f, acc, row0, fq);
            else { if (fq == 0) {
#pragma unroll
                for (int ai = 0; ai < 2; ++ai)
#pragma unroll
                    for (int m = 0; m < 4; ++m) { float* p = wi + (size_t)(row0 + ai * 128 + m * 16) * 8; *(f32x4*)p = acc[ai][0][m][0]; *(f32x4*)(p + 4) = acc[ai][0][m][1]; } } }
        }
        else if (pn < 13) store_tile_bf16<1>(sga, 1024, (pn - 9) * 256, 1.f, acc, row0, wc, fq);
        else store_tile_bf16<1>(sgb, 1024, (pn - 13) * 256, 1.f, acc, row0, wc, fq);
    }
};
struct EpiPlain {
    static constexpr bool PERM = true;
    bf16_t* O; int ld;
    __device__ __forceinline__ void operator()(const AccT& acc, const pg8::Unit& u, int wr, int wc, int fr, int fq) const {
        asm volatile("" : "+v"(fr), "+v"(fq));
        store_tile_bf16<0>(O, ld, u.pn * 256, 1.f, acc, u.pm * 256 + wr * 64 + fr, wc, fq);
    }
};
struct EpiGate {
    static constexpr bool PERM = true;
    bf16_t* O; const bf16_t* gate; const bf16_t* add;
    __device__ __forceinline__ void operator()(const AccT& acc, const pg8::Unit& u, int wr, int wc, int fr, int fq) const {
        asm volatile("" : "+v"(fr), "+v"(fq));
        const int row0 = u.pm * 256 + wr * 64 + fr, col0 = u.pn * 256 + wc * 32 + 8 * fq;
#pragma unroll
        for (int ai = 0; ai < 2; ++ai)
#pragma unroll
            for (int m = 0; m < 4; ++m) { const size_t off = (size_t)(row0 + ai * 128 + m * 16) * 1024 + col0;
#pragma unroll
                for (int bj = 0; bj < 2; ++bj) { const u32x4 gw = *(const u32x4*)(gate + off + bj * 128);
                    f32x4 v0 = acc[ai][bj][m][0], v1 = acc[ai][bj][m][1];
                    v0[0] *= bflo(gw.x); v0[1] *= bfhi(gw.x); v0[2] *= bflo(gw.y); v0[3] *= bfhi(gw.y);
                    v1[0] *= bflo(gw.z); v1[1] *= bfhi(gw.z); v1[2] *= bflo(gw.w); v1[3] *= bfhi(gw.w);
                    if (add) { const u32x4 aw = *(const u32x4*)(add + off + bj * 128);
                        v0[0] += bflo(aw.x); v0[1] += bfhi(aw.x); v0[2] += bflo(aw.y); v0[3] += bfhi(aw.y);
                        v1[0] += bflo(aw.z); v1[1] += bfhi(aw.z); v1[2] += bflo(aw.w); v1[3] += bfhi(aw.w); }
                    *(u32x4*)(O + off + bj * 128) = pack8(v0, v1); } }
    }
};
struct EpiOut {
    static constexpr bool PERM = false;
    const float* xin; float* xout; const float* gvec;
    __device__ __forceinline__ void operator()(const AccT& acc, const pg8::Unit& u, int wr, int wc, int fr, int fq) const {
        asm volatile("" : "+v"(fr), "+v"(fq));
        const int row0 = u.pm * 256 + wr * 64 + fr, col0 = u.pn * 256 + wc * 32 + 4 * fq;
        const int b = (u.pm * 256) / SEQ;
        f32x4 gv[2][2];
#pragma unroll
        for (int bj = 0; bj < 2; ++bj)
#pragma unroll
            for (int n = 0; n < 2; ++n) gv[bj][n] = *(const f32x4*)(gvec + (size_t)b * NMOD + col0 + bj * 128 + n * 16);
#pragma unroll
        for (int ai = 0; ai < 2; ++ai)
#pragma unroll
            for (int m = 0; m < 4; ++m) { const size_t off = (size_t)(row0 + ai * 128 + m * 16) * 1024 + col0;
#pragma unroll
                for (int bj = 0; bj < 2; ++bj)
#pragma unroll
                    for (int n = 0; n < 2; ++n) { const f32x4 xi = *(const f32x4*)(xin + off + bj * 128 + n * 16);
                        *(f32x4*)(xout + off + bj * 128 + n * 16) = xi + gv[bj][n] * acc[ai][bj][m][n]; } }
    }
};
struct EpiMoe1 {
    static constexpr bool PERM = true;
    bf16_t* hid; const float* slotw;
    __device__ __forceinline__ void operator()(const AccT& acc, const pg8::Unit& u, int wr, int wc, int fr, int fq) const {
        asm volatile("" : "+v"(fr), "+v"(fq));
        const int row0 = u.pm * 256 + wr * 64 + fr, pnl = u.pn & 3, col0 = 128 * pnl + 16 * wc + 4 * fq;
#pragma unroll
        for (int ai = 0; ai < 2; ++ai)
#pragma unroll
            for (int m = 0; m < 4; ++m) { const int row = row0 + ai * 128 + m * 16; const float cw = slotw[row];
#pragma unroll
                for (int bj = 0; bj < 2; ++bj) { const f32x4 gt = acc[ai][bj][m][0], up = acc[ai][bj][m][1]; f32x4 h;
#pragma unroll
                    for (int i = 0; i < 4; ++i) h[i] = gt[i] * sigmoidf_(gt[i]) * up[i] * cw;
                    u32x2 w; w.x = cvt_pk_bf16(h[0], h[1]); w.y = cvt_pk_bf16(h[2], h[3]);
                    *(u32x2*)(hid + (size_t)row * DEXP + col0 + 64 * bj) = w; } }
    }
};
struct EpiMoe2 {
    static constexpr bool PERM = true;
    bf16_t* y; const int* slotd;
    __device__ __forceinline__ void operator()(const AccT& acc, const pg8::Unit& u, int wr, int wc, int fr, int fq) const {
        asm volatile("" : "+v"(fr), "+v"(fq));
        const int row0 = u.pm * 256 + wr * 64 + fr, col0 = (u.pn & 3) * 256 + wc * 32 + 8 * fq;
#pragma unroll
        for (int ai = 0; ai < 2; ++ai)
#pragma unroll
            for (int m = 0; m < 4; ++m) { const int dst = slotd[row0 + ai * 128 + m * 16];
                if (dst >= 0) { bf16_t* rowp = y + (size_t)dst * 1024 + col0;
#pragma unroll
                    for (int bj = 0; bj < 2; ++bj) *(u32x4*)(rowp + bj * 128) = pack8(acc[ai][bj][m][0], acc[ai][bj][m][1]); } }
    }
};
struct MoeOrder {
    const LAS int* tile_end; int ntiles, G, c;
    __device__ __forceinline__ bool next(int i, pg8::Unit& u) const {
        const int L = i * G + c; if (L >= 4 * ntiles) return false;
        const int rt = L >> 2; int e = 0;
#pragma unroll
        for (int j = 0; j < NE; ++j) e += (rt >= tile_end[j]) ? 1 : 0;
        u.pm = rt; u.pn = __builtin_amdgcn_readfirstlane(e * 4 + (L & 3)); return true;
    }
    __device__ __forceinline__ void a_ready(const pg8::Unit&) const {}
    __device__ __forceinline__ void done(const pg8::Unit&) const {}
};

constexpr int RING_BYTES = 131072, MISC_OFF = RING_BYTES, LDS_BYTES = 147456;
struct Args { const float* in[18]; float* out; unsigned char* ws; int ph_lo, ph_hi; };
struct Frame {
    LAS unsigned char* lds; int tid, lane, wave, G, blk;
    float* out; unsigned char* ws; unsigned* ctl;
    __device__ __forceinline__ const float* in(int i) const {
        const LAS unsigned* t = (const LAS unsigned*)(lds + MISC_OFF + 1024) + 2 * i;
        const unsigned lo = __builtin_amdgcn_readfirstlane(t[0]), hi = __builtin_amdgcn_readfirstlane(t[1]);
        return (const float*)(((unsigned long long)hi << 32) | lo);
    }
};
enum { IN_X = 0, IN_C, IN_WADA, IN_BADA, IN_N1G, IN_WIN, IN_QNG, IN_KNG, IN_RELB, IN_WOA, IN_WOB, IN_WOUT, IN_N2G, IN_RW, IN_RB, IN_WG, IN_WU, IN_WDN };

__device__ __forceinline__ int win_src_col(int r) {
    if (r < 1024) return r;
    if (r < 1536) { const int rho = r - 1024, tile = rho >> 8, q = rho & 255, bj = q >> 7, wc = (q >> 5) & 3, j = q & 31; return 1536 + (tile * 4 + wc) * 64 + 32 * bj + j; }
    if (r < 2048) return 2176 + (r - 1536);
    if (r < 2304) { const int q = r - 2048, bj = q >> 7, wc = (q >> 5) & 3, j = q & 31, cs = 32 * bj + j;
        if (wc == 0) return 2048 + cs; if (wc == 1) return 2112 + cs; if (wc == 2) return 2688 + cs; return cs < 8 ? 2752 + cs : -1; }
    if (r < 3328) return 2760 + (r - 2304);
    if (r < 4352) return 3784 + (r - 3328);
    return 1024 + (r - 4352);
}
__device__ __forceinline__ void transpose_item(const float* colp, int ldw, int ksrc0, bf16_t* WT, size_t drow0, int ldk, int kdst0, LAS float* scr, int lane) {
#pragma unroll 8
    for (int i = 0; i < 32; ++i) { const int kk = 2 * i + (lane >> 5); scr[kk * 33 + (lane & 31)] = colp ? colp[(size_t)(ksrc0 + kk) * ldw] : 0.f; }
    LDS_WAIT(); asm volatile("" ::: "memory");
    const int c = lane & 7;
#pragma unroll
    for (int j = 0; j < 4; ++j) { const int n = (lane >> 3) + 8 * j; const LAS float* s = scr + (8 * c) * 33 + n;
        u32x4 o; o.x = pk2(s[0 * 33], s[1 * 33]); o.y = pk2(s[2 * 33], s[3 * 33]); o.z = pk2(s[4 * 33], s[5 * 33]); o.w = pk2(s[6 * 33], s[7 * 33]);
        *(u32x4*)(WT + (drow0 + n) * ldk + kdst0 + 8 * c) = o; }
    LDS_WAIT(); asm volatile("" ::: "memory");
}
constexpr int IT_WIN = 152 * 16, IT_WO = 32 * 16, IT_WOUT = 32 * 16, IT_SMALL = IT_WIN + IT_WO + IT_WOUT;
constexpr int IT_WGU = 16 * 32 * 16, IT_WD = 16 * 32 * 8, IT_EXP = IT_WGU + IT_WD;
__device__ __forceinline__ void convert_small_item(Frame& F, int l, int it, LAS float* scr) {
    const int n31 = F.lane & 31;
    if (it < IT_WIN) { const int rg = it >> 4, kg = it & 15; const int col = win_src_col(rg * 32 + n31);
        transpose_item(col >= 0 ? F.in(IN_WIN) + (size_t)l * DM * NIN + col : nullptr, NIN, kg * 64, (bf16_t*)(F.ws + WS_WIN + l * WIN_LAYER), (size_t)rg * 32, 1024, kg * 64, scr, F.lane); return; }
    it -= IT_WIN;
    if (it < IT_WO) { const int rg = it >> 4, kg = it & 15, k0 = kg * 64; const float* src = (k0 < 512 ? F.in(IN_WOA) : F.in(IN_WOB)) + (size_t)l * 512 * 1024 + rg * 32 + n31;
        transpose_item(src, 1024, k0 & 511, (bf16_t*)(F.ws + WS_WO) + (size_t)l * 1024 * 1024, (size_t)rg * 32, 1024, k0, scr, F.lane); return; }
    it -= IT_WO;
    { const int rg = it >> 4, kg = it & 15; transpose_item(F.in(IN_WOUT) + (size_t)l * 1024 * 1024 + rg * 32 + n31, 1024, kg * 64, (bf16_t*)(F.ws + WS_WOUT) + (size_t)l * 1024 * 1024, (size_t)rg * 32, 1024, kg * 64, scr, F.lane); }
}
__device__ __forceinline__ void convert_expert_item(Frame& F, int l, int it, LAS float* scr) {
    const int n31 = F.lane & 31;
    if (it < IT_WGU) { const int e = it >> 9, r2 = it & 511, rg = r2 >> 4, kg = r2 & 15; const int r = rg * 32 + n31, q = r >> 3, i = r & 7;
        const float* src = (i < 4 ? F.in(IN_WG) : F.in(IN_WU)) + (size_t)(l * NE + e) * DM * DEXP + 4 * q + (i & 3);
        transpose_item(src, DEXP, kg * 64, (bf16_t*)(F.ws + WS_WGU) + (size_t)e * 1024 * 1024, (size_t)rg * 32, 1024, kg * 64, scr, F.lane); return; }
    it -= IT_WGU;
    { const int e = it >> 8, r2 = it & 255, rg = r2 >> 3, kg = r2 & 7;
        transpose_item(F.in(IN_WDN) + (size_t)(l * NE + e) * DEXP * DM + rg * 32 + n31, DM, kg * 64, (bf16_t*)(F.ws + WS_WD) + (size_t)e * 1024 * 512, (size_t)rg * 32, 512, kg * 64, scr, F.lane); }
}

__device__ __forceinline__ void phase_prologue(Frame& F) {
    LAS float* scr = (LAS float*)(F.lds + F.wave * 8448);
    LAS float* sil = (LAS float*)(F.lds + 69632);
    const float* cin = F.in(IN_C); const float* badap = F.in(IN_BADA);
    for (int i = F.tid; i < BATCH * DM; i += NTHR) { const float v = cin[i]; sil[i] = v / (1.f + __expf(-v)); }
    __syncthreads();
    const int gw = F.blk * NWAVES + F.wave, NGW = F.G * NWAVES;
    float* modp = (float*)(F.ws + WS_MODP);
    for (int it = gw; it < 16 * 2 * 96; it += NGW) {
        const int jb = it % 96, l = (it / 96) & 1, kc = it / 192; const int j = jb * 64 + F.lane;
        float a[BATCH];
#pragma unroll
        for (int b = 0; b < BATCH; ++b) a[b] = 0.f;
        const float* wp = F.in(IN_WADA) + ((size_t)l * DM + kc * 64) * NMOD + j;
#pragma unroll 4
        for (int k = 0; k < 64; ++k) { const float w = wp[(size_t)k * NMOD];
#pragma unroll
            for (int b = 0; b < BATCH; ++b) a[b] += sil[b * DM + kc * 64 + k] * w; }
        const float bias = (kc == 0) ? badap[l * NMOD + j] : 0.f;
#pragma unroll
        for (int b = 0; b < BATCH; ++b) modp[(((size_t)kc * 2 + l) * BATCH + b) * NMOD + j] = a[b] + bias;
    }
    for (int it = gw; it < 2 * IT_SMALL; it += NGW) { const int l = it >= IT_SMALL ? 1 : 0; convert_small_item(F, l, it - l * IT_SMALL, scr); }
    for (int it = gw; it < IT_EXP; it += NGW) convert_expert_item(F, 0, it, scr);
}

__device__ __forceinline__ float modsum(const float* modp, int l, int b, int j) {
    float s = 0.f;
#pragma unroll
    for (int kc = 0; kc < 16; ++kc) s += modp[(((size_t)kc * 2 + l) * BATCH + b) * NMOD + j];
    return s;
}
__device__ __forceinline__ void phase_rows(Frame& F, int l, int mode) {
    LAS float* Av = (LAS float*)F.lds; LAS float* Sv = Av + DM; LAS float* Gv = Sv + DM;
    const float* modp = (const float*)(F.ws + WS_MODP);
    float* mod = (float*)(F.ws + WS_MOD);
    const float* n1g = F.in(IN_N1G); const float* xin = F.in(IN_X);
    const int row_base = F.blk * (T / F.G);
    const int b = row_base / SEQ;
    if (mode == 0) {
        const int per = (2 * BATCH * NMOD) / F.G;
        for (int i = F.tid; i < per; i += NTHR) { const int idx = F.blk * per + i; const int ll = idx / (BATCH * NMOD), bb = (idx / NMOD) % BATCH, j = idx % NMOD; mod[idx] = modsum(modp, ll, bb, j); }
    }
    for (int d = F.tid; d < DM; d += NTHR) {
        if (mode != 2) { Av[d] = n1g[l * DM + d] * (1.f + modsum(modp, l, b, 1 * DM + d)); Sv[d] = modsum(modp, l, b, 0 * DM + d); }
        if (mode != 0) Gv[d] = modsum(modp, l - 1, b, 5 * DM + d);
    }
    if (mode == 1) {
        LAS float* scr = (LAS float*)(F.lds + 16384 + F.wave * 8448);
        const int gw = F.blk * NWAVES + F.wave, NGW = F.G * NWAVES;
        for (int it = gw; it < IT_EXP; it += NGW) convert_expert_item(F, l, it, scr);
    }
    __syncthreads();
    const bf16_t* ybuf = (const bf16_t*)(F.ws + WS_Y);
    bf16_t* hb = (bf16_t*)(F.ws + WS_H);
    const int rows_per_wave = (T / F.G) / NWAVES;
    for (int i = 0; i < rows_per_wave; ++i) {
        const int row = row_base + F.wave * rows_per_wave + i;
        f32x4 v[4];
        const float* xr = (mode == 0 ? xin : F.out) + (size_t)row * DM;
#pragma unroll
        for (int j = 0; j < 4; ++j) v[j] = *(const f32x4*)(xr + 4 * F.lane + 256 * j);
        if (mode != 0) {
#pragma unroll
            for (int j = 0; j < 4; ++j) { const int c0 = 4 * F.lane + 256 * j;
                const u32x2 y0 = *(const u32x2*)(ybuf + (size_t)(2 * row) * DM + c0), y1 = *(const u32x2*)(ybuf + (size_t)(2 * row + 1) * DM + c0);
                v[j][0] += Gv[c0 + 0] * (bflo(y0.x) + bflo(y1.x)); v[j][1] += Gv[c0 + 1] * (bfhi(y0.x) + bfhi(y1.x));
                v[j][2] += Gv[c0 + 2] * (bflo(y0.y) + bflo(y1.y)); v[j][3] += Gv[c0 + 3] * (bfhi(y0.y) + bfhi(y1.y));
                *(f32x4*)(F.out + (size_t)row * DM + c0) = v[j]; }
        }
        if (mode != 2) {
            float ss = 0.f;
#pragma unroll
            for (int j = 0; j < 4; ++j) ss += (v[j][0] * v[j][0] + v[j][1] * v[j][1]) + (v[j][2] * v[j][2] + v[j][3] * v[j][3]);
            const float r = 1.0f / sqrtf(wave_sum(ss) * (1.0f / DM) + EPS);
#pragma unroll
            for (int j = 0; j < 4; ++j) { const int c0 = 4 * F.lane + 256 * j; u32x2 w;
                w.x = pk2(v[j][0] * r * Av[c0] + Sv[c0], v[j][1] * r * Av[c0 + 1] + Sv[c0 + 1]);
                w.y = pk2(v[j][2] * r * Av[c0 + 2] + Sv[c0 + 2], v[j][3] * r * Av[c0 + 3] + Sv[c0 + 3]);
                *(u32x2*)(hb + (size_t)row * DM + c0) = w; }
        }
    }
}

__device__ __forceinline__ void phase_sb_naive(Frame& F) {
    const bf16_t* qa = (const bf16_t*)(F.ws + WS_QA); const bf16_t* ka = (const bf16_t*)(F.ws + WS_KA); const bf16_t* vaT = (const bf16_t*)(F.ws + WS_VAT);
    bf16_t* oab = (bf16_t*)(F.ws + WS_OAB);
    for (int gid = F.blk * NTHR + F.tid; gid < T * 8; gid += F.G * NTHR) {
        const int bh = gid >> 11, t = gid & 2047, b = bh >> 3, h = bh & 7; const size_t row = (size_t)b * SEQ + t;
        float q[64], o[64];
#pragma unroll
        for (int d8 = 0; d8 < 8; ++d8) { const u32x4 w = *(const u32x4*)(qa + row * 512 + h * 64 + d8 * 8);
            q[d8 * 8 + 0] = bflo(w.x); q[d8 * 8 + 1] = bfhi(w.x); q[d8 * 8 + 2] = bflo(w.y); q[d8 * 8 + 3] = bfhi(w.y);
            q[d8 * 8 + 4] = bflo(w.z); q[d8 * 8 + 5] = bfhi(w.z); q[d8 * 8 + 6] = bflo(w.w); q[d8 * 8 + 7] = bfhi(w.w); }
#pragma unroll
        for (int d = 0; d < 64; ++d) o[d] = 0.f;
        float R = 0.f;
        for (int s = t - 1; s >= 0 && R > -104.f; --s) {
            const bf16_t* kr = ka + ((size_t)b * SEQ + s) * 512 + h * 64;
            float z = 0.f;
#pragma unroll
            for (int d8 = 0; d8 < 8; ++d8) { const u32x4 w = *(const u32x4*)(kr + d8 * 8);
                z += q[d8 * 8 + 0] * bflo(w.x); z += q[d8 * 8 + 1] * bfhi(w.x); z += q[d8 * 8 + 2] * bflo(w.y); z += q[d8 * 8 + 3] * bfhi(w.y);
                z += q[d8 * 8 + 4] * bflo(w.z); z += q[d8 * 8 + 5] * bfhi(w.z); z += q[d8 * 8 + 6] * bflo(w.w); z += q[d8 * 8 + 7] * bfhi(w.w); }
            const float sp = fmaxf(z, 0.f) + log1pf(expf(-fabsf(z)));
            const float a = expf((z - sp) + R);
            R -= sp;
            const bf16_t* vc = vaT + (size_t)(h * 64) * T + (size_t)b * SEQ + s;
#pragma unroll
            for (int d = 0; d < 64; ++d) o[d] += a * bf2f(vc[(size_t)d * T]);
        }
#pragma unroll
        for (int d8 = 0; d8 < 8; ++d8) { u32x4 w; w.x = pk2(o[d8 * 8 + 0], o[d8 * 8 + 1]); w.y = pk2(o[d8 * 8 + 2], o[d8 * 8 + 3]); w.z = pk2(o[d8 * 8 + 4], o[d8 * 8 + 5]); w.w = pk2(o[d8 * 8 + 6], o[d8 * 8 + 7]);
            *(u32x4*)(oab + row * 1024 + h * 64 + d8 * 8) = w; }
    }
}

__device__ __forceinline__ unsigned sortable(float f) { const unsigned u = __builtin_bit_cast(unsigned, f); return (u & 0x80000000u) ? ~u : (u | 0x80000000u); }
__device__ __forceinline__ void topk_select_store(const unsigned (&key)[32], unsigned* maskrow, int lane) {
    unsigned thr = 0u;
    for (int bit = 31; bit >= 0; --bit) { const unsigned cand = thr | (1u << bit); int cnt = 0;
#pragma unroll
        for (int j = 0; j < 32; ++j) cnt += __popcll(__ballot(key[j] >= cand));
        if (cnt >= 256) thr = cand; }
    int cgt = 0;
#pragma unroll
    for (int j = 0; j < 32; ++j) cgt += __popcll(__ballot(key[j] > thr));
    const int need = 256 - cgt; int run = 0; unsigned myword = 0u;
    const unsigned long long lt = (1ull << lane) - 1ull;
#pragma unroll
    for (int j = 0; j < 32; ++j) {
        const unsigned long long eq = __ballot(key[j] == thr), gt = __ballot(key[j] > thr);
        const bool tie_sel = (key[j] == thr) && (run + __popcll(eq & lt) < need);
        const unsigned long long sel = gt | __ballot(tie_sel);
        run += __popcll(eq);
        if (lane == 2 * j) myword = (unsigned)sel;
        if (lane == 2 * j + 1) myword = (unsigned)(sel >> 32);
    }
    maskrow[lane] = myword;
}
__device__ __forceinline__ void phase_idx_naive(Frame& F) {
    const bf16_t* qi = (const bf16_t*)(F.ws + WS_QI); const bf16_t* ki = (const bf16_t*)(F.ws + WS_KI); const float* wi = (const float*)(F.ws + WS_WI);
    unsigned* mask = (unsigned*)(F.ws + WS_MASK);
    LAS float* qs = (LAS float*)(F.lds + F.wave * 2048);
    LAS float* sc = (LAS float*)(F.lds + 16384 + F.wave * 8192);
    const int NGW = F.G * NWAVES;
    for (int gw = F.blk * NWAVES + F.wave; gw < SEQ; gw += NGW) {
        for (int b = 0; b < BATCH; ++b) {
            const int t = (b & 1) ? (SEQ - 1 - gw) : gw; const size_t row = (size_t)b * SEQ + t;
            unsigned* mrow = mask + row * 64;
            if (t < 256) { const int nb = t + 1 - 32 * F.lane; mrow[F.lane] = nb >= 32 ? 0xffffffffu : (nb <= 0 ? 0u : ((1u << nb) - 1u)); continue; }
            { const u32x4 w = *(const u32x4*)(qi + row * 512 + F.lane * 8);
              qs[F.lane * 8 + 0] = bflo(w.x); qs[F.lane * 8 + 1] = bfhi(w.x); qs[F.lane * 8 + 2] = bflo(w.y); qs[F.lane * 8 + 3] = bfhi(w.y);
              qs[F.lane * 8 + 4] = bflo(w.z); qs[F.lane * 8 + 5] = bfhi(w.z); qs[F.lane * 8 + 6] = bflo(w.w); qs[F.lane * 8 + 7] = bfhi(w.w); }
            float wh[8];
#pragma unroll
            for (int h = 0; h < 8; ++h) wh[h] = wi[row * 8 + h];
            LDS_WAIT(); asm volatile("" ::: "memory");
            const int nk = t + 1;
            for (int s = F.lane; s < nk; s += 64) {
                float kv[64];
                const bf16_t* kr = ki + ((size_t)b * SEQ + s) * 64;
#pragma unroll
                for (int d8 = 0; d8 < 8; ++d8) { const u32x4 w = *(const u32x4*)(kr + d8 * 8);
                    kv[d8 * 8 + 0] = bflo(w.x); kv[d8 * 8 + 1] = bfhi(w.x); kv[d8 * 8 + 2] = bflo(w.y); kv[d8 * 8 + 3] = bfhi(w.y);
                    kv[d8 * 8 + 4] = bflo(w.z); kv[d8 * 8 + 5] = bfhi(w.z); kv[d8 * 8 + 6] = bflo(w.w); kv[d8 * 8 + 7] = bfhi(w.w); }
                float score = 0.f;
#pragma unroll
                for (int h = 0; h < 8; ++h) { float dot = 0.f;
#pragma unroll
                    for (int d4 = 0; d4 < 16; ++d4) { const f32x4 qv = *(const LAS f32x4*)(qs + h * 64 + d4 * 4);
                        dot += qv[0] * kv[d4 * 4 + 0]; dot += qv[1] * kv[d4 * 4 + 1]; dot += qv[2] * kv[d4 * 4 + 2]; dot += qv[3] * kv[d4 * 4 + 3]; }
                    score += wh[h] * fmaxf(dot, 0.f); }
                sc[s] = score + 0.f;
            }
            LDS_WAIT(); asm volatile("" ::: "memory");
            unsigned key[32];
#pragma unroll
            for (int j = 0; j < 32; ++j) { const int s = F.lane + 64 * j; key[j] = (s < nk) ? sortable(sc[s]) : 0u; }
            topk_select_store(key, mrow, F.lane);
            LDS_WAIT(); asm volatile("" ::: "memory");
        }
    }
}

__device__ __forceinline__ int t5_bucket_idx(int dist) {
    return dist < 113 ? dist : 113;
}
__device__ __forceinline__ int t5_bucket(int d) {
    if (d < 16) return d;
    int bkt = 16;
    bkt += (d >= 19); bkt += (d >= 21); bkt += (d >= 24); bkt += (d >= 27); bkt += (d >= 31); bkt += (d >= 35); bkt += (d >= 40); bkt += (d >= 46);
    bkt += (d >= 52); bkt += (d >= 59); bkt += (d >= 67); bkt += (d >= 77); bkt += (d >= 87); bkt += (d >= 99); bkt += (d >= 113);
    return bkt;
}
__device__ __forceinline__ void phase_dsa_naive(Frame& F) {
    const bf16_t* qb = (const bf16_t*)(F.ws + WS_QB); const bf16_t* kb = (const bf16_t*)(F.ws + WS_KB); const bf16_t* vb = (const bf16_t*)(F.ws + WS_VB);
    const unsigned* mask = (const unsigned*)(F.ws + WS_MASK);
    bf16_t* oab = (bf16_t*)(F.ws + WS_OAB);
    LAS float* lut = (LAS float*)F.lds;
    const float* relb = F.in(IN_RELB);
    for (int i = F.tid; i < 8 * 114; i += NTHR) { const int h = i / 114, d = i % 114; lut[i] = relb[t5_bucket(d) * 8 + h]; }
    __syncthreads();
    for (int gid = F.blk * NTHR + F.tid; gid < T * 8; gid += F.G * NTHR) {
        const int tq = gid >> 3, h = gid & 7, b = tq >> 11, t = tq & 2047;
        float q[64], o[64];
#pragma unroll
        for (int d8 = 0; d8 < 8; ++d8) { const u32x4 w = *(const u32x4*)(qb + (size_t)tq * 512 + h * 64 + d8 * 8);
            q[d8 * 8 + 0] = bflo(w.x); q[d8 * 8 + 1] = bfhi(w.x); q[d8 * 8 + 2] = bflo(w.y); q[d8 * 8 + 3] = bfhi(w.y);
            q[d8 * 8 + 4] = bflo(w.z); q[d8 * 8 + 5] = bfhi(w.z); q[d8 * 8 + 6] = bflo(w.w); q[d8 * 8 + 7] = bfhi(w.w); }
#pragma unroll
        for (int d = 0; d < 64; ++d) o[d] = 0.f;
        float mx = -1e30f, l = 0.f;
        for (int j = 0; j <= (t >> 5); ++j) {
            unsigned w = mask[(size_t)tq * 64 + j];
            while (w) { const int bit = __builtin_ctz(w); w &= w - 1u; const int s = 32 * j + bit;
                const bf16_t* kr = kb + ((size_t)b * SEQ + s) * 64;
                float z = lut[h * 114 + t5_bucket_idx(t - s)];
#pragma unroll
                for (int d8 = 0; d8 < 8; ++d8) { const u32x4 kw = *(const u32x4*)(kr + d8 * 8);
                    z += q[d8 * 8 + 0] * bflo(kw.x); z += q[d8 * 8 + 1] * bfhi(kw.x); z += q[d8 * 8 + 2] * bflo(kw.y); z += q[d8 * 8 + 3] * bfhi(kw.y);
                    z += q[d8 * 8 + 4] * bflo(kw.z); z += q[d8 * 8 + 5] * bfhi(kw.z); z += q[d8 * 8 + 6] * bflo(kw.w); z += q[d8 * 8 + 7] * bfhi(kw.w); }
                const float mn = fmaxf(mx, z), scl = __expf(mx - mn), p = __expf(z - mn);
                l = l * scl + p; mx = mn;
                const bf16_t* vr = vb + ((size_t)b * SEQ + s) * 64;
#pragma unroll
                for (int d8 = 0; d8 < 8; ++d8) { const u32x4 vw = *(const u32x4*)(vr + d8 * 8);
                    o[d8 * 8 + 0] = o[d8 * 8 + 0] * scl + p * bflo(vw.x); o[d8 * 8 + 1] = o[d8 * 8 + 1] * scl + p * bfhi(vw.x);
                    o[d8 * 8 + 2] = o[d8 * 8 + 2] * scl + p * bflo(vw.y); o[d8 * 8 + 3] = o[d8 * 8 + 3] * scl + p * bfhi(vw.y);
                    o[d8 * 8 + 4] = o[d8 * 8 + 4] * scl + p * bflo(vw.z); o[d8 * 8 + 5] = o[d8 * 8 + 5] * scl + p * bfhi(vw.z);
                    o[d8 * 8 + 6] = o[d8 * 8 + 6] * scl + p * bflo(vw.w); o[d8 * 8 + 7] = o[d8 * 8 + 7] * scl + p * bfhi(vw.w); }
            }
        }
        const float il = 1.f / l;
#pragma unroll
        for (int d8 = 0; d8 < 8; ++d8) { u32x4 w; w.x = pk2(o[d8 * 8 + 0] * il, o[d8 * 8 + 1] * il); w.y = pk2(o[d8 * 8 + 2] * il, o[d8 * 8 + 3] * il); w.z = pk2(o[d8 * 8 + 4] * il, o[d8 * 8 + 5] * il); w.w = pk2(o[d8 * 8 + 6] * il, o[d8 * 8 + 7] * il);
            *(u32x4*)(oab + (size_t)tq * 1024 + 512 + h * 64 + d8 * 8) = w; }
    }
}

__device__ __forceinline__ void phase_h2_route(Frame& F, int l) {
    LAS float* Av = (LAS float*)F.lds; LAS float* Sv = Av + DM;
    LAS float* RW = (LAS float*)(F.lds + 8192);
    LAS float* RB = (LAS float*)(F.lds + 73728);
    LAS int* lcnt = (LAS int*)(F.lds + 73728 + 64);
    LAS int* lbase = (LAS int*)(F.lds + 73728 + 128);
    LAS int* rinfo = (LAS int*)(F.lds + 73728 + 256);
    const float* mod = (const float*)(F.ws + WS_MOD) + (size_t)l * BATCH * NMOD;
    const int rows_per_blk = T / F.G, row_base = F.blk * rows_per_blk, b = row_base / SEQ;
    const float* n2g = F.in(IN_N2G); const float* rwp = F.in(IN_RW); const float* rbp = F.in(IN_RB);
    for (int d = F.tid; d < DM; d += NTHR) { Av[d] = n2g[l * DM + d] * (1.f + mod[(size_t)b * NMOD + 4 * DM + d]); Sv[d] = mod[(size_t)b * NMOD + 3 * DM + d]; }
    for (int i = F.tid; i < DM * NE; i += NTHR) RW[i] = rwp[i];
    if (F.tid < NE) { RB[F.tid] = rbp[F.tid]; lcnt[F.tid] = 0; }
    __syncthreads();
    bf16_t* hb = (bf16_t*)(F.ws + WS_H);
    const int rows_per_wave = rows_per_blk / NWAVES;
    for (int i = 0; i < rows_per_wave; ++i) {
        const int lr = F.wave * rows_per_wave + i, row = row_base + lr;
        f32x4 v[4]; float ss = 0.f;
#pragma unroll
        for (int j = 0; j < 4; ++j) { v[j] = *(const f32x4*)(F.out + (size_t)row * DM + 4 * F.lane + 256 * j); ss += (v[j][0] * v[j][0] + v[j][1] * v[j][1]) + (v[j][2] * v[j][2] + v[j][3] * v[j][3]); }
        const float r = 1.0f / sqrtf(wave_sum(ss) * (1.0f / DM) + EPS);
        float lg[NE];
#pragma unroll
        for (int e = 0; e < NE; ++e) lg[e] = 0.f;
#pragma unroll
        for (int j = 0; j < 4; ++j) { const int c0 = 4 * F.lane + 256 * j; u32x2 w;
#pragma unroll
            for (int k = 0; k < 4; ++k) { v[j][k] = v[j][k] * r * Av[c0 + k] + Sv[c0 + k];
#pragma unroll
                for (int e4 = 0; e4 < 4; ++e4) { const f32x4 rw = *(const LAS f32x4*)(RW + (c0 + k) * NE + e4 * 4);
                    lg[e4 * 4 + 0] += v[j][k] * rw[0]; lg[e4 * 4 + 1] += v[j][k] * rw[1]; lg[e4 * 4 + 2] += v[j][k] * rw[2]; lg[e4 * 4 + 3] += v[j][k] * rw[3]; } }
            w.x = pk2(v[j][0], v[j][1]); w.y = pk2(v[j][2], v[j][3]);
            *(u32x2*)(hb + (size_t)row * DM + c0) = w; }
        float mxl = -1e30f;
#pragma unroll
        for (int e = 0; e < NE; ++e) { lg[e] = wave_sum(lg[e]) + RB[e]; mxl = fmaxf(mxl, lg[e]); }
        float pr[NE], den = 0.f;
#pragma unroll
        for (int e = 0; e < NE; ++e) { pr[e] = expf(lg[e] - mxl); den += pr[e]; }
        const float iden = 1.f / den;
#pragma unroll
        for (int e = 0; e < NE; ++e) pr[e] *= iden;
        int bg = 0; float bs = -1.f, bv0 = 0.f, bv1 = 0.f; int bi0 = 0, bi1 = 1;
#pragma unroll
        for (int g = 0; g < 4; ++g) {
            float v0 = pr[4 * g], v1 = -1.f; int i0 = 0, i1 = -1;
#pragma unroll
            for (int k = 1; k < 4; ++k) { const float p = pr[4 * g + k];
                if (p > v0) { v1 = v0; i1 = i0; v0 = p; i0 = k; } else if (p > v1) { v1 = p; i1 = k; } }
            const float gs = v0 + v1;
            if (gs > bs) { bs = gs; bg = g; bv0 = v0; bv1 = v1; bi0 = i0; bi1 = i1; }
        }
        const int e0 = bg * 4 + bi0, e1 = bg * 4 + bi1; const float wsum = bv0 + bv1, w0 = bv0 / wsum, w1 = bv1 / wsum;
        if (F.lane == 0) { const int p0 = __hip_atomic_fetch_add(lcnt + e0, 1, __ATOMIC_RELAXED, __HIP_MEMORY_SCOPE_WORKGROUP), p1 = __hip_atomic_fetch_add(lcnt + e1, 1, __ATOMIC_RELAXED, __HIP_MEMORY_SCOPE_WORKGROUP);
            rinfo[lr * 6 + 0] = e0; rinfo[lr * 6 + 1] = p0; rinfo[lr * 6 + 2] = __float_as_int(w0); rinfo[lr * 6 + 3] = e1; rinfo[lr * 6 + 4] = p1; rinfo[lr * 6 + 5] = __float_as_int(w1); }
    }
    __syncthreads();
    unsigned* gcnt = F.ctl + CW_GCNT + 64 * l;
    if (F.tid < NE) lbase[F.tid] = (int)__hip_atomic_fetch_add(gcnt + F.tid, (unsigned)lcnt[F.tid], RLX_AGENT);
    __syncthreads();
    int* etok = (int*)(F.ws + WS_ETOK); float* ew = (float*)(F.ws + WS_EW); int* edst = (int*)(F.ws + WS_EDST);
    if (F.tid < 2 * rows_per_blk) { const int lr = F.tid >> 1, k = F.tid & 1; const int e = rinfo[lr * 6 + 3 * k], p = rinfo[lr * 6 + 3 * k + 1]; const float w = __int_as_float(rinfo[lr * 6 + 3 * k + 2]);
        const int slot = lbase[e] + p, tok = row_base + lr;
        etok[e * T + slot] = tok; ew[e * T + slot] = w; edst[e * T + slot] = 2 * tok + k; }
}

__device__ __forceinline__ int moe_table(Frame& F, int l, LAS int* tile_end) {
    if (F.tid < 64) { const int e = F.lane & 15; const int n = (int)__hip_atomic_load(F.ctl + CW_GCNT + 64 * l + e, RLX_AGENT); int tiles = (n + 255) >> 8, cum = tiles;
#pragma unroll
        for (int o = 1; o < 16; o <<= 1) { const int v = __shfl_up(cum, o, 16); if (e >= o) cum += v; }
        if (F.lane < 16) { tile_end[e] = cum; tile_end[16 + e] = n; } }
    __syncthreads();
    return tile_end[15];
}
__device__ __forceinline__ void phase_gather(Frame& F, int l) {
    LAS int* tile_end = (LAS int*)(F.lds + MISC_OFF + 512);
    const int ntiles = moe_table(F, l, tile_end);
    const int* etok = (const int*)(F.ws + WS_ETOK); const float* ew = (const float*)(F.ws + WS_EW); const int* edst = (const int*)(F.ws + WS_EDST);
    float* slotw = (float*)(F.ws + WS_SLOTW); int* slotd = (int*)(F.ws + WS_SLOTD);
    const bf16_t* hb = (const bf16_t*)(F.ws + WS_H); bf16_t* xg = (bf16_t*)(F.ws + WS_XG);
    const int NGW = F.G * NWAVES;
    for (int p = F.blk * NWAVES + F.wave; p < ntiles * 256; p += NGW) {
        const int rt = p >> 8; int e = 0;
#pragma unroll
        for (int j = 0; j < NE; ++j) e += (rt >= tile_end[j]) ? 1 : 0;
        const int rbase = (e == 0 ? 0 : tile_end[e - 1]) * 256, idx = p - rbase, n = tile_end[16 + e];
        u32x4 a = (u32x4){0u, 0u, 0u, 0u}, c = a;
        if (idx < n) { const int tok = etok[e * T + idx]; const u32x4* src = (const u32x4*)(hb + (size_t)tok * DM); a = src[F.lane]; c = src[64 + F.lane];
            if (F.lane == 0) { slotw[p] = ew[e * T + idx]; slotd[p] = edst[e * T + idx]; } }
        else if (F.lane == 0) { slotw[p] = 0.f; slotd[p] = -1; }
        u32x4* dst = (u32x4*)(xg + (size_t)p * DM); dst[F.lane] = a; dst[64 + F.lane] = c;
    }
}

#define XB_TMO      128
#define XB_XCNT(j)  (256  + 64 * (j))
#define XB_XSUB(j)  (1280 + 64 * (j))
#define XB_XGEN(j)  (2304 + 64 * (j))
#define XB_TOP      3328
#define XB_TOPGEN   3392
#define XCD_BAR_WORDS 3456
#define XB_SPIN_CAP (1u << 20)
__device__ __forceinline__ unsigned xb_ld(unsigned* p)              { return __hip_atomic_load(p, __ATOMIC_RELAXED, __HIP_MEMORY_SCOPE_AGENT); }
__device__ __forceinline__ unsigned xb_add(unsigned* p, unsigned v) { return __hip_atomic_fetch_add(p, v, __ATOMIC_RELAXED, __HIP_MEMORY_SCOPE_AGENT); }
__device__ __forceinline__ unsigned xb_xcc_id() { return (unsigned)__builtin_amdgcn_s_getreg((3 << 11) | 20) & 0xFu; }
#define XB_SPIN(cond, bar) do { unsigned _sp = 0; while (cond) { __builtin_amdgcn_s_sleep(1); \
    if ((++_sp & 255u) == 0u) { if (xb_ld(&(bar)[XB_TMO])) break; if (_sp > XB_SPIN_CAP) { atomicAdd(&(bar)[XB_TMO], 1u); break; } } } } while (0)
struct XcdBarrier { unsigned* bar; unsigned x; volatile LAS unsigned* st; };
__device__ __forceinline__ XcdBarrier xcd_barrier_post(unsigned* bar, volatile LAS unsigned* st) {
    XcdBarrier b; b.bar = bar; b.x = xb_xcc_id(); b.st = st;
    if (threadIdx.x == 0) (void)xb_add(&bar[XB_XCNT(b.x)], 1u);
    return b;
}
__device__ __forceinline__ void xcd_barrier_complete(unsigned* bar, unsigned x, unsigned& nloc, unsigned& nx) {
    const unsigned G = gridDim.x * gridDim.y * gridDim.z;
    unsigned sum, cnt, mine, sp = 0u;
    for (;;) {
        sum = 0u; cnt = 0u; mine = 0u;
#pragma unroll
        for (unsigned j = 0; j < 16; ++j) { const unsigned c = xb_ld(&bar[XB_XCNT(j)]); sum += c; cnt += (c > 0u) ? 1u : 0u; mine = (j == x) ? c : mine; }
        if (sum == G) break;
        __builtin_amdgcn_s_sleep(1);
        if ((++sp & 255u) == 0u) { if (xb_ld(&bar[XB_TMO])) break; if (sp > XB_SPIN_CAP) { atomicAdd(&bar[XB_TMO], 1u); break; } }
    }
    nloc = mine > 0u ? mine : 1u; nx = cnt > 0u ? cnt : 1u;
}
__device__ __forceinline__ void xcd_barrier(const XcdBarrier& b) {
    asm volatile("s_waitcnt vmcnt(0)" ::: "memory");
    __syncthreads();
    if (threadIdx.x == 0) {
        unsigned* bar = b.bar;
        __builtin_amdgcn_s_waitcnt(0);
        unsigned nloc = b.st[0], nx = b.st[1];
        if (nloc == 0u) { xcd_barrier_complete(bar, b.x, nloc, nx); b.st[0] = nloc; b.st[1] = nx; }
        const unsigned old = xb_add(&bar[XB_XSUB(b.x)], 1u);
        const unsigned gen = old / nloc;
        if (old + 1u == (gen + 1u) * nloc) {
            __builtin_amdgcn_fence(__ATOMIC_RELEASE, "agent");
            asm volatile("s_waitcnt vmcnt(0)" ::: "memory");
            const unsigned og = xb_add(&bar[XB_TOP], 1u);
            const unsigned tg = og / nx;
            if (og + 1u == (tg + 1u) * nx) xb_add(&bar[XB_TOPGEN], 1u);
            else XB_SPIN(xb_ld(&bar[XB_TOPGEN]) == tg, bar);
            __builtin_amdgcn_fence(__ATOMIC_ACQUIRE, "agent");
            xb_add(&bar[XB_XGEN(b.x)], 1u);
            asm volatile("s_waitcnt vmcnt(0)" ::: "memory");
        } else {
            XB_SPIN(xb_ld(&bar[XB_XGEN(b.x)]) == gen, bar);
            __builtin_amdgcn_fence(__ATOMIC_ACQUIRE, "agent");
            asm volatile("s_waitcnt vmcnt(0)" ::: "memory");
        }
    }
    __syncthreads();
}

constexpr int PH_PER_LAYER = 10, PH_FINAL = 1 + PH_PER_LAYER * DEPTH, N_PHASES = PH_FINAL + 1;
__global__ void __launch_bounds__(NTHR, 2) fwd_kernel(Args args) {
    extern __shared__ __attribute__((aligned(16))) unsigned char lds_raw[];
    Frame F;
    F.lds = (LAS unsigned char*)lds_raw;
    F.tid = threadIdx.x; F.lane = F.tid & 63; F.wave = __builtin_amdgcn_readfirstlane(F.tid >> 6); F.G = gridDim.x; F.blk = blockIdx.x;
    F.out = args.out; F.ws = args.ws; F.ctl = (unsigned*)(args.ws + WS_CTL);
    volatile LAS unsigned* MISC = (volatile LAS unsigned*)(F.lds + MISC_OFF);
    for (int u = F.tid; u < (LDS_BYTES - MISC_OFF) / 4; u += NTHR) ((LAS unsigned*)(F.lds + MISC_OFF))[u] = 0u;
    __syncthreads();
    if (F.tid < 36) ((LAS unsigned*)(F.lds + MISC_OFF + 1024))[F.tid] = ((const unsigned*)__builtin_amdgcn_kernarg_segment_ptr())[F.tid];
    __syncthreads();
    const int lo = args.ph_lo, hi = args.ph_hi;
    XcdBarrier bar; bar.bar = F.ctl + CW_BAR; bar.x = 0; bar.st = nullptr;
    if (hi - lo > 1) bar = xcd_barrier_post(F.ctl + CW_BAR, MISC + 8);
#define SEAM(k) do { if ((k) + 1 < hi) xcd_barrier(bar); } while (0)
    for (int ph = lo; ph < hi; ++ph) {
        { int t_ = threadIdx.x; asm volatile("" : "+v"(t_)); F.tid = t_; F.lane = t_ & 63; F.wave = __builtin_amdgcn_readfirstlane(t_ >> 6);
          unsigned char* w_ = args.ws; asm volatile("" : "+s"(w_)); F.ws = w_; F.ctl = (unsigned*)(w_ + WS_CTL); float* o_ = args.out; asm volatile("" : "+s"(o_)); F.out = o_; }
        if (ph == 0) { phase_prologue(F); }
        else if (ph == PH_FINAL) { phase_rows(F, DEPTH, 2); }
        else {
            const int l = (ph - 1) / PH_PER_LAYER, s = (ph - 1) % PH_PER_LAYER;
            bf16_t* hb = (bf16_t*)(F.ws + WS_H);
            if (s == 0) { phase_rows(F, l, l == 0 ? 0 : 1); }
            else if (s == 1) {
                { pg8::Gemm g{hb, (const bf16_t*)(F.ws + WS_WIN + l * WIN_LAYER)}; pg8::StaticOrder S; S.init(T, NMAIN, F.G, F.blk);
                  EpiIn E{(bf16_t*)(F.ws + WS_QA), (bf16_t*)(F.ws + WS_KA), (bf16_t*)(F.ws + WS_QB), (bf16_t*)(F.ws + WS_QI), (bf16_t*)(F.ws + WS_KB), (bf16_t*)(F.ws + WS_VB), (bf16_t*)(F.ws + WS_KI),
                          (bf16_t*)(F.ws + WS_SGA), (bf16_t*)(F.ws + WS_SGB), (float*)(F.ws + WS_WI), F.in(IN_QNG) + l * 64, F.in(IN_KNG) + l * 64};
                  pg8::gemm_phase<1024, 1024, 1024, EpiIn, pg8::StaticOrder, true>(F.lds, g, S, E); }
                { pg8::Gemm g{(const bf16_t*)(F.ws + WS_WIN + l * WIN_LAYER) + (size_t)NMAIN * 1024, hb}; pg8::StaticOrder S; S.init(512, T, F.G, (F.blk + F.G / 2) % F.G);
                  EpiPlain E{(bf16_t*)(F.ws + WS_VAT), T};
                  pg8::gemm_phase<1024, 1024, 1024, EpiPlain, pg8::StaticOrder, true>(F.lds, g, S, E); }
            }
            else if (s == 2) { phase_sb_naive(F); phase_idx_naive(F); }
            else if (s == 3) { phase_dsa_naive(F); }
            else if (s == 4) {
                const bf16_t* oab = (const bf16_t*)(F.ws + WS_OAB); const bf16_t* wo = (const bf16_t*)(F.ws + WS_WO) + (size_t)l * 1024 * 1024;
                { pg8::Gemm g{oab, wo}; pg8::StaticOrder S; S.init(T, 1024, F.G, F.blk);
                  EpiGate E{(bf16_t*)(F.ws + WS_TMP), (const bf16_t*)(F.ws + WS_SGA), nullptr};
                  pg8::gemm_phase<1024, 1024, 512, EpiGate, pg8::StaticOrder, true>(F.lds, g, S, E); }
                { pg8::Gemm g{oab + 512, wo + 512}; pg8::StaticOrder S; S.init(T, 1024, F.G, F.blk);
                  EpiGate E{(bf16_t*)(F.ws + WS_MERGED), (const bf16_t*)(F.ws + WS_SGB), (const bf16_t*)(F.ws + WS_TMP)};
                  pg8::gemm_phase<1024, 1024, 512, EpiGate, pg8::StaticOrder, true>(F.lds, g, S, E); }
            }
            else if (s == 5) {
                pg8::Gemm g{(const bf16_t*)(F.ws + WS_MERGED), (const bf16_t*)(F.ws + WS_WOUT) + (size_t)l * 1024 * 1024}; pg8::StaticOrder S; S.init(T, 1024, F.G, F.blk);
                EpiOut E{l == 0 ? F.in(IN_X) : F.out, F.out, (const float*)(F.ws + WS_MOD) + (size_t)l * BATCH * NMOD + 2 * DM};
                pg8::gemm_phase<1024, 1024, 1024, EpiOut, pg8::StaticOrder, true>(F.lds, g, S, E);
            }
            else if (s == 6) { phase_h2_route(F, l); }
            else if (s == 7) { phase_gather(F, l); }
            else if (s == 8 || s == 9) {
                LAS int* tile_end = (LAS int*)(F.lds + MISC_OFF + 512);
                const int ntiles = moe_table(F, l, tile_end);
                MoeOrder S{tile_end, ntiles, F.G, F.blk};
                if (s == 8) { pg8::Gemm g{(const bf16_t*)(F.ws + WS_XG), (const bf16_t*)(F.ws + WS_WGU)};
                    EpiMoe1 E{(bf16_t*)(F.ws + WS_HID), (const float*)(F.ws + WS_SLOTW)};
                    pg8::gemm_phase<1024, 1024, 1024, EpiMoe1, MoeOrder, true>(F.lds, g, S, E); }
                else { pg8::Gemm g{(const bf16_t*)(F.ws + WS_HID), (const bf16_t*)(F.ws + WS_WD)};
                    EpiMoe2 E{(bf16_t*)(F.ws + WS_Y), (const int*)(F.ws + WS_SLOTD)};
                    pg8::gemm_phase<512, 512, 512, EpiMoe2, MoeOrder, true>(F.lds, g, S, E); }
            }
        }
        __syncthreads();
        SEAM(ph);
    }
#undef SEAM
}

extern "C" void kernel_launch(void* const* d_in, const int* in_sizes, int n_in, void* d_out, int out_size, void* d_ws, size_t ws_size, hipStream_t stream) {
    static int grid = 0;
    if (grid == 0) {
        if (n_in != 18 || out_size != T * DM || ws_size < WS_END) { fprintf(stderr, "kernel_launch: unexpected problem (n_in %d, out %d, ws %zu)\n", n_in, out_size, ws_size); grid = -1; return; }
        int dev = 0, cus = 0;
        if (hipGetDevice(&dev) != hipSuccess || hipDeviceGetAttribute(&cus, hipDeviceAttributeMultiprocessorCount, dev) != hipSuccess) { grid = -1; return; }
        if (hipFuncSetAttribute((const void*)fwd_kernel, hipFuncAttributeMaxDynamicSharedMemorySize, LDS_BYTES) != hipSuccess) { fprintf(stderr, "kernel_launch: hipFuncSetAttribute failed\n"); grid = -1; return; }
        (void)hipGetLastError();
        grid = cus;
        if (grid != 256) fprintf(stderr, "kernel_launch: %d CUs (built for 256)\n", grid);
    }
    if (grid < 0) return;
    (void)hipMemsetAsync((char*)d_ws + WS_CTL, 0, CTL_ZERO_BYTES, stream);
    Args a{};
    for (int i = 0; i < 18; ++i) a.in[i] = (const float*)d_in[i];
    a.out = (float*)d_out; a.ws = (unsigned char*)d_ws;
#if ONE_LAUNCH
    a.ph_lo = 0; a.ph_hi = N_PHASES;
    hipLaunchKernelGGL(fwd_kernel, dim3(grid), dim3(NTHR), LDS_BYTES, stream, a);
#else
    for (int ph = 0; ph < N_PHASES; ++ph) {
        const int s = ph == 0 || ph == PH_FINAL ? -1 : (ph - 1) % PH_PER_LAYER;
        (void)s;
        a.ph_lo = ph; a.ph_hi = ph + 1;
        hipLaunchKernelGGL(fwd_kernel, dim3(grid), dim3(NTHR), LDS_BYTES, stream, a);
    }
#endif
}
```

```cpp
#include <hip/hip_runtime.h>
#include <cstdio>
#include <cstdint>

#define LAS __attribute__((address_space(3)))
#define GAS __attribute__((address_space(1)))
typedef unsigned short bf16_t;
typedef short bf16x8 __attribute__((ext_vector_type(8)));
typedef float f32x4 __attribute__((ext_vector_type(4)));
typedef float f32x2 __attribute__((ext_vector_type(2)));
typedef unsigned u32x4 __attribute__((ext_vector_type(4)));
typedef unsigned u32x2 __attribute__((ext_vector_type(2)));

constexpr int BATCH = 8, SEQ = 2048, DM = 1024, T = BATCH * SEQ, DEPTH = 2;
constexpr int NIN = 4808, NMOD = 6 * DM;
constexpr int NE = 16, DEXP = 512;
constexpr int NMAIN = 4352;
constexpr int PMAX = 36864;
constexpr float EPS = 1e-6f;
constexpr int NWAVES = 8, NTHR = 512;

#ifndef ONE_LAUNCH
#define ONE_LAUNCH 1
#endif

constexpr size_t MiB = 1u << 20;
constexpr size_t WS_CTL = 0, CTL_ZERO_BYTES = 1 * MiB;
constexpr size_t WS_MOD = 1 * MiB;
constexpr size_t WS_MODP = 2 * MiB;
constexpr size_t WS_ETOK = 8 * MiB, WS_EW = 9 * MiB, WS_EDST = 10 * MiB;
constexpr size_t WS_SLOTW = 11 * MiB, WS_SLOTD = 11 * MiB + 256 * 1024;
constexpr size_t WS_MASK = 12 * MiB;
constexpr size_t WS_WIN = 16 * MiB;
constexpr size_t WIN_LAYER = (size_t)4864 * 1024 * 2;
constexpr size_t WS_WO = 35 * MiB, WS_WOUT = 39 * MiB;
constexpr size_t WS_WGU = 43 * MiB;
constexpr size_t WS_WD = 75 * MiB;
constexpr size_t WS_H = 92 * MiB;
constexpr size_t WS_QA = 124 * MiB, WS_KA = 140 * MiB, WS_VAT = 156 * MiB, WS_QB = 172 * MiB, WS_QI = 188 * MiB;
constexpr size_t WS_KB = 204 * MiB, WS_VBT = 206 * MiB, WS_KI = 208 * MiB, WS_WI = 210 * MiB;
constexpr size_t WS_SGA = 212 * MiB, WS_SGB = 244 * MiB, WS_OAB = 276 * MiB;
constexpr size_t WS_MERGED = 124 * MiB;
constexpr size_t WS_TMP = 156 * MiB;
constexpr size_t WS_XG = 124 * MiB;
constexpr size_t WS_HID = 196 * MiB;
constexpr size_t WS_Y = 232 * MiB;
constexpr size_t WS_END = 308 * MiB;
constexpr int CW_GCNT = 64;
constexpr int CW_BAR = 4096;

#define LDS_WAIT() asm volatile("s_waitcnt lgkmcnt(0)" ::: "memory")
#define VM_WAIT() asm volatile("s_waitcnt vmcnt(0)" ::: "memory")
#define RLX_AGENT __ATOMIC_RELAXED, __HIP_MEMORY_SCOPE_AGENT
__device__ __forceinline__ unsigned f2bf(float f) { unsigned u = __builtin_bit_cast(unsigned, f); return (u + 0x7fffu + ((u >> 16) & 1u)) >> 16; }
__device__ __forceinline__ unsigned pk2(float lo, float hi) { return f2bf(lo) | (f2bf(hi) << 16); }
__device__ __forceinline__ float bflo(unsigned w) { return __builtin_bit_cast(float, w << 16); }
__device__ __forceinline__ float bfhi(unsigned w) { return __builtin_bit_cast(float, w & 0xffff0000u); }
__device__ __forceinline__ float bf2f(bf16_t h) { return __builtin_bit_cast(float, (unsigned)h << 16); }
__device__ __forceinline__ unsigned cvt_pk_bf16(float lo, float hi) { unsigned r; asm volatile("v_cvt_pk_bf16_f32 %0, %1, %2" : "=v"(r) : "v"(lo), "v"(hi)); return r; }
__device__ __forceinline__ u32x4 pack8(f32x4 a, f32x4 b) { u32x4 w; w.x = cvt_pk_bf16(a[0], a[1]); w.y = cvt_pk_bf16(a[2], a[3]); w.z = cvt_pk_bf16(b[0], b[1]); w.w = cvt_pk_bf16(b[2], b[3]); return w; }
__device__ __forceinline__ float sigmoidf_(float x) { return 1.f / (1.f + __expf(-x)); }
__device__ __forceinline__ float wave_sum(float v) {
#pragma unroll
    for (int o = 1; o < 64; o <<= 1) v += __shfl_xor(v, o);
    return v;
}

namespace pg8 {
constexpr int BM = 256, BK = 64, HALF = 128, HTB = HALF * BK * 2, STAGE_BYTES = 8 * HTB, NXCD = 8, WGM = 8;
__host__ __device__ __forceinline__ int lds_byte(int r, int c) { const int st = (r >> 4) * 2 + (c >> 5), rr = r & 15, cc = c & 31, ob = rr * 64 + cc * 2; return st * 1024 + (ob ^ (((ob >> 9) & 1) << 5)); }
__host__ __device__ __forceinline__ void stage_rc(int b, int& R, int& C) { const int st = b / 1024, sb = b % 1024, swz = sb ^ (((sb >> 9) & 1) << 5); R = (st >> 1) * 16 + swz / 64; C = (st & 1) * 32 + (swz % 64) / 2; }
__host__ __device__ __forceinline__ int perm32(int rho) { const int n = rho >> 4, i = rho & 15; return 8 * (i >> 2) + 4 * n + (i & 3); }

struct Unit { int pm, pn; };
struct Gemm { const bf16_t* A; const bf16_t* Bt; };

struct StaticOrder {
    int nM, nN, nwg, G, c;
    __host__ __device__ void init(int M, int N, int G_, int c_) { nM = M / BM; nN = N / BM; nwg = nM * nN; G = G_; c = c_; }
    __host__ __device__ bool next(int i, Unit& u) const {
        const long L = (long)i * G + c; if (L >= nwg) return false;
        int wgid = (int)L; { const int q = nwg / NXCD, r = nwg % NXCD, xcd = wgid % NXCD, off = wgid / NXCD; wgid = (xcd < r ? xcd * (q + 1) : r * (q + 1) + (xcd - r) * q) + off; }
        const int nig = WGM * nN, gid = wgid / nig, fm = gid * WGM, gsz = (nM - fm) < WGM ? (nM - fm) : WGM;
        u.pm = fm + ((wgid % nig) % gsz); u.pn = (wgid % nig) / gsz; return true;
    }
    __device__ __forceinline__ void a_ready(const Unit&) const {}
    __device__ __forceinline__ void done(const Unit&) const {}
};

template <int LDA, int LDB, int KK, class Epi, class Sched, bool ALIGN_EPI>
__device__ __forceinline__ void gemm_phase(LAS unsigned char* lds, const Gemm g, const Sched& S, const Epi& E) {
    int tid = threadIdx.x; asm volatile("" : "+v"(tid));
    const int wid = __builtin_amdgcn_readfirstlane(tid >> 6), lane = tid & 63, wr = wid >> 2, wc = wid & 3, fr = lane & 15, fq = lane >> 4;
    constexpr int nt = KK / BK;
    unsigned voffA[2], voffB[2];
#pragma unroll
    for (int i = 0; i < 2; ++i) { int R, C; stage_rc(tid * 16 + i * 8192, R, C); const int Rb = Epi::PERM ? ((R & ~31) + perm32(R & 31)) : R;
        voffA[i] = (unsigned)(R * LDA + C) * 2u; voffB[i] = (unsigned)(Rb * LDB + C) * 2u; }
    constexpr size_t kstep = (size_t)(BK * 2);
    constexpr size_t hstepA = (size_t)HALF * LDA * 2, hstepB = (size_t)HALF * LDB * 2;
    constexpr size_t tstepA = 2 * hstepA, tstepB = 2 * hstepB;
    const unsigned ldsw = (unsigned)wid * 1024u;
    const int aoff = lds_byte(wr * 64 + fr, fq * 8), boff = lds_byte(wc * 32 + fr, fq * 8);
#define PG8_SA(b, h) (((b) * 2 + (h)) * HTB)
#define PG8_SB(b, h) ((4 + (b) * 2 + (h)) * HTB)
#define PG8_STAGE(bufoff, gbase, voff) do { _Pragma("unroll") for (int _i = 0; _i < 2; ++_i) \
        __builtin_amdgcn_global_load_lds((const unsigned*)((const char*)(gbase) + (voff)[_i]), (LAS unsigned*)(lds + (bufoff) + ldsw + _i * 8192), 16, 0, 0); } while (0)
#define PG8_LDA(dst, b, h) do { _Pragma("unroll") for (int m = 0; m < 4; ++m) _Pragma("unroll") for (int k = 0; k < 2; ++k) dst[m][k] = *(const LAS bf16x8*)(lds + PG8_SA(b, h) + aoff + m * 2048 + k * 1024); } while (0)
#define PG8_LDB(dst, b, h) do { _Pragma("unroll") for (int n = 0; n < 2; ++n) _Pragma("unroll") for (int k = 0; k < 2; ++k) dst[n][k] = *(const LAS bf16x8*)(lds + PG8_SB(b, h) + boff + n * 2048 + k * 1024); } while (0)
#define PG8_MMA(ai, bj, At, Bt) do { __builtin_amdgcn_s_setprio(1); _Pragma("unroll") for (int m = 0; m < 4; ++m) _Pragma("unroll") for (int n = 0; n < 2; ++n) _Pragma("unroll") for (int k = 0; k < 2; ++k) \
        acc[ai][bj][m][n] = __builtin_amdgcn_mfma_f32_16x16x32_bf16(Bt[n][k], At[m][k], acc[ai][bj][m][n], 0, 0, 0); __builtin_amdgcn_s_setprio(0); } while (0)
#define PG8_WAIT_V(n) asm volatile("s_waitcnt vmcnt(" #n ")" ::: "memory")
#define PG8_WAIT_L(n) asm volatile("s_waitcnt lgkmcnt(" #n ")" ::: "memory")
#define PG8_BAR __builtin_amdgcn_s_barrier()
#define PG8_SCHED __builtin_amdgcn_sched_barrier(0)
    Unit cur, nxt; int ui = 0;
    if (!S.next(0, cur)) return;
    f32x4 acc[2][2][4][2];
#pragma unroll
    for (int a = 0; a < 2; ++a)
#pragma unroll
        for (int b = 0; b < 2; ++b)
#pragma unroll
            for (int m = 0; m < 4; ++m)
#pragma unroll
                for (int n = 0; n < 2; ++n) acc[a][b][m][n] = (f32x4){0.f, 0.f, 0.f, 0.f};
    bf16x8 At[4][2], B0[2][2], B1[2][2];
    const char* cA = (const char*)g.A + (size_t)cur.pm * tstepA; const char* cB = (const char*)g.Bt + (size_t)cur.pn * tstepB;
    S.a_ready(cur);
    PG8_STAGE(PG8_SB(0, 0), cB, voffB); PG8_STAGE(PG8_SB(0, 1), cB + hstepB, voffB); PG8_STAGE(PG8_SA(0, 0), cA, voffA); PG8_STAGE(PG8_SA(0, 1), cA + hstepA, voffA);
    if (wr == 1) PG8_BAR;
    PG8_WAIT_V(2); PG8_BAR;
    PG8_STAGE(PG8_SB(1, 0), cB + kstep, voffB); PG8_STAGE(PG8_SA(1, 0), cA + kstep, voffA); PG8_STAGE(PG8_SB(1, 1), cB + hstepB + kstep, voffB);
    PG8_WAIT_V(6); PG8_BAR;
    for (;;) {
        const bool has_next = S.next(ui + 1, nxt);
        const char* nA = has_next ? (const char*)g.A + (size_t)nxt.pm * tstepA : cA; const char* nB = has_next ? (const char*)g.Bt + (size_t)nxt.pn * tstepB : cB;
        for (int t = 0; t < nt; t += 2) {
            const bool last = (t == nt - 2);
            const char* a1 = cA + (size_t)(t + 1) * kstep;
            const char* a2 = last ? nA : cA + (size_t)(t + 2) * kstep; const char* b2 = last ? nB : cB + (size_t)(t + 2) * kstep;
            const char* a3 = a2 + kstep; const char* b3 = b2 + kstep;
            if (last && has_next) S.a_ready(nxt);
            PG8_LDB(B0, 0, 0); PG8_LDB(B1, 0, 1); PG8_SCHED; PG8_LDA(At, 0, 0); PG8_STAGE(PG8_SA(1, 1), a1 + hstepA, voffA);
            PG8_WAIT_V(8); PG8_WAIT_L(0); PG8_BAR; PG8_MMA(0, 0, At, B0); PG8_MMA(0, 1, At, B1); PG8_BAR; PG8_SCHED;
            PG8_LDA(At, 0, 1); PG8_STAGE(PG8_SB(0, 0), b2, voffB); PG8_STAGE(PG8_SB(0, 1), b2 + hstepB, voffB); PG8_STAGE(PG8_SA(0, 0), a2, voffA);
            PG8_WAIT_V(8); PG8_WAIT_L(0); PG8_BAR; PG8_MMA(1, 0, At, B0); PG8_MMA(1, 1, At, B1); PG8_BAR; PG8_SCHED;
            PG8_LDB(B0, 1, 0); PG8_LDB(B1, 1, 1); PG8_SCHED; PG8_LDA(At, 1, 0); PG8_STAGE(PG8_SA(0, 1), a2 + hstepA, voffA);
            PG8_WAIT_V(8); PG8_WAIT_L(0); PG8_BAR; PG8_MMA(0, 0, At, B0); PG8_MMA(0, 1, At, B1); PG8_BAR; PG8_SCHED;
            PG8_LDA(At, 1, 1); PG8_STAGE(PG8_SB(1, 0), b3, voffB); PG8_STAGE(PG8_SB(1, 1), b3 + hstepB, voffB); PG8_STAGE(PG8_SA(1, 0), a3, voffA);
            PG8_WAIT_V(8); PG8_WAIT_L(0); PG8_BAR; PG8_MMA(1, 0, At, B0); PG8_MMA(1, 1, At, B1); PG8_BAR; PG8_SCHED;
        }
        if constexpr (ALIGN_EPI) { if (wr == 0) PG8_BAR; }
        E(acc, cur, wr, wc, fr, fq); S.done(cur);
        if (!has_next) break;
#pragma unroll
        for (int a = 0; a < 2; ++a)
#pragma unroll
            for (int b = 0; b < 2; ++b)
#pragma unroll
                for (int m = 0; m < 4; ++m)
#pragma unroll
                    for (int n = 0; n < 2; ++n) acc[a][b][m][n] = (f32x4){0.f, 0.f, 0.f, 0.f};
        cur = nxt; cA = nA; cB = nB; ++ui;
        if constexpr (ALIGN_EPI) { if (wr == 1) PG8_BAR; }
    }
    PG8_WAIT_V(0);
    if constexpr (!ALIGN_EPI) { if (wr == 0) PG8_BAR; }
    PG8_BAR;
#undef PG8_SA
#undef PG8_SB
#undef PG8_STAGE
#undef PG8_LDA
#undef PG8_LDB
#undef PG8_MMA
#undef PG8_WAIT_V
#undef PG8_WAIT_L
#undef PG8_BAR
#undef PG8_SCHED
}
}
typedef f32x4 AccT[2][2][4][2];

template <int SIG> __device__ __forceinline__ void store_tile_bf16(bf16_t* O, int ld, int colt, float sc, const AccT& acc, int row0, int wc, int fq) {
    const int col0 = colt + wc * 32 + 8 * fq;
#pragma unroll
    for (int ai = 0; ai < 2; ++ai)
#pragma unroll
        for (int m = 0; m < 4; ++m) { bf16_t* rowp = O + (size_t)(row0 + ai * 128 + m * 16) * ld + col0;
#pragma unroll
            for (int bj = 0; bj < 2; ++bj) { f32x4 v0 = acc[ai][bj][m][0] * sc, v1 = acc[ai][bj][m][1] * sc;
                if (SIG) {
#pragma unroll
                    for (int i = 0; i < 4; ++i) { v0[i] = sigmoidf_(v0[i]); v1[i] = sigmoidf_(v1[i]); } }
                *(u32x4*)(rowp + bj * 128) = pack8(v0, v1); } }
}
template <int NORM> __device__ __forceinline__ void store_head64(bf16_t* O, int ld, int cbase, const float* gain, float gsc, const AccT& acc, int row0, int fq) {
    f32x4 gq[2][2];
#pragma unroll
    for (int bj = 0; bj < 2; ++bj)
#pragma unroll
        for (int n = 0; n < 2; ++n) gq[bj][n] = NORM ? *(const f32x4*)(gain + 32 * bj + 8 * fq + 4 * n) * gsc : (f32x4){1.f, 1.f, 1.f, 1.f};
#pragma unroll
    for (int ai = 0; ai < 2; ++ai)
#pragma unroll
        for (int m = 0; m < 4; ++m) {
            float r = 1.f;
            if (NORM) { float ss = 0.f;
#pragma unroll
                for (int bj = 0; bj < 2; ++bj)
#pragma unroll
                    for (int n = 0; n < 2; ++n) { const f32x4 x = acc[ai][bj][m][n]; ss += (x[0] * x[0] + x[1] * x[1]) + (x[2] * x[2] + x[3] * x[3]); }
                ss += __shfl_xor(ss, 16); ss += __shfl_xor(ss, 32);
                r = 1.0f / sqrtf(ss * (1.0f / 64.0f) + EPS); }
            bf16_t* rowp = O + (size_t)(row0 + ai * 128 + m * 16) * ld + cbase + 8 * fq;
#pragma unroll
            for (int bj = 0; bj < 2; ++bj) { const f32x4 v0 = acc[ai][bj][m][0] * r * gq[bj][0], v1 = acc[ai][bj][m][1] * r * gq[bj][1];
                *(u32x4*)(rowp + 32 * bj) = pack8(v0, v1); } }
}
struct EpiIn {
    static constexpr bool PERM = true;
    bf16_t *qa, *ka, *qb, *qi, *kb, *vbT, *ki, *sga, *sgb; float* wi; const float *qg, *kg;
    __device__ __forceinline__ void operator()(const AccT& acc, const pg8::Unit& u, int wr, int wc, int fr, int fq) const {
        asm volatile("" : "+v"(fr), "+v"(fq));
        const int pn = u.pn, row0 = u.pm * 256 + wr * 64 + fr;
        if (pn < 2) store_tile_bf16<0>(qa, 512, pn * 256, 0.125f, acc, row0, wc, fq);
        else if (pn < 4) store_tile_bf16<0>(ka, 512, (pn - 2) * 256, 1.f, acc, row0, wc, fq);
        else if (pn < 6) store_head64<1>(qb, 512, ((pn - 4) * 4 + wc) * 64, qg, 0.125f, acc, row0, fq);
        else if (pn < 8) store_tile_bf16<0>(qi, 512, (pn - 6) * 256, 1.f, acc, row0, wc, fq);
        else if (pn == 8) {
            if (wc == 0) store_head64<1>(kb, 64, 0, kg, 1.f, acc, row0, fq);
            else if (wc == 1) {
#pragma unroll
                for (int ai = 0; ai < 2; ++ai)
#pragma unroll
                    for (int m = 0; m < 4; ++m) { bf16_t* p = vbT + (size_t)(8 * fq) * T + (row0 + ai * 128 + m * 16);
#pragma unroll
                        for (int bj = 0; bj < 2; ++bj)
#pragma unroll
                            for (int n = 0; n < 2; ++n)
#pragma unroll
                                for (int i = 0; i < 4; ++i) p[(size_t)(32 * bj + 4 * n + i) * T] = (bf16_t)f2bf(acc[ai][bj][m][n][i]); } }
            else if (wc == 2) store_head64<0>(ki, 64, 0, nullptr, 1.f, acc, row0, fq);
            else { if (fq == 0) {
#pragma unroll
                for (int ai = 0; ai < 2; ++ai)
#pragma unroll
                    for (int m = 0; m < 4; ++m) { float* p = wi + (size_t)(row0 + ai * 128 + m * 16) * 8; *(f32x4*)p = acc[ai][0][m][0]; *(f32x4*)(p + 4) = acc[ai][0][m][1]; } } }
        }
        else if (pn < 13) store_tile_bf16<1>(sga, 1024, (pn - 9) * 256, 1.f, acc, row0, wc, fq);
        else store_tile_bf16<1>(sgb, 1024, (pn - 13) * 256, 1.f, acc, row0, wc, fq);
    }
};
struct EpiPlain {
    static constexpr bool PERM = true;
    bf16_t* O; int ld;
    __device__ __forceinline__ void operator()(const AccT& acc, const pg8::Unit& u, int wr, int wc, int fr, int fq) const {
        asm volatile("" : "+v"(fr), "+v"(fq));
        store_tile_bf16<0>(O, ld, u.pn * 256, 1.f, acc, u.pm * 256 + wr * 64 + fr, wc, fq);
    }
};
struct EpiGate {
    static constexpr bool PERM = true;
    bf16_t* O; const bf16_t* gate; const bf16_t* add;
    __device__ __forceinline__ void operator()(const AccT& acc, const pg8::Unit& u, int wr, int wc, int fr, int fq) const {
        asm volatile("" : "+v"(fr), "+v"(fq));
        const int row0 = u.pm * 256 + wr * 64 + fr, col0 = u.pn * 256 + wc * 32 + 8 * fq;
#pragma unroll
        for (int ai = 0; ai < 2; ++ai)
#pragma unroll
            for (int m = 0; m < 4; ++m) { const size_t off = (size_t)(row0 + ai * 128 + m * 16) * 1024 + col0;
#pragma unroll
                for (int bj = 0; bj < 2; ++bj) { const u32x4 gw = *(const u32x4*)(gate + off + bj * 128);
                    f32x4 v0 = acc[ai][bj][m][0], v1 = acc[ai][bj][m][1];
                    v0[0] *= bflo(gw.x); v0[1] *= bfhi(gw.x); v0[2] *= bflo(gw.y); v0[3] *= bfhi(gw.y);
                    v1[0] *= bflo(gw.z); v1[1] *= bfhi(gw.z); v1[2] *= bflo(gw.w); v1[3] *= bfhi(gw.w);
                    if (add) { const u32x4 aw = *(const u32x4*)(add + off + bj * 128);
                        v0[0] += bflo(aw.x); v0[1] += bfhi(aw.x); v0[2] += bflo(aw.y); v0[3] += bfhi(aw.y);
                        v1[0] += bflo(aw.z); v1[1] += bfhi(aw.z); v1[2] += bflo(aw.w); v1[3] += bfhi(aw.w); }
                    *(u32x4*)(O + off + bj * 128) = pack8(v0, v1); } }
    }
};
struct EpiOut {
    static constexpr bool PERM = false;
    const float* xin; float* xout; const float* gvec;
    __device__ __forceinline__ void operator()(const AccT& acc, const pg8::Unit& u, int wr, int wc, int fr, int fq) const {
        asm volatile("" : "+v"(fr), "+v"(fq));
        const int row0 = u.pm * 256 + wr * 64 + fr, col0 = u.pn * 256 + wc * 32 + 4 * fq;
        const int b = (u.pm * 256) / SEQ;
        f32x4 gv[2][2];
#pragma unroll
        for (int bj = 0; bj < 2; ++bj)
#pragma unroll
            for (int n = 0; n < 2; ++n) gv[bj][n] = *(const f32x4*)(gvec + (size_t)b * NMOD + col0 + bj * 128 + n * 16);
#pragma unroll
        for (int ai = 0; ai < 2; ++ai)
#pragma unroll
            for (int m = 0; m < 4; ++m) { const size_t off = (size_t)(row0 + ai * 128 + m * 16) * 1024 + col0;
#pragma unroll
                for (int bj = 0; bj < 2; ++bj)
#pragma unroll
                    for (int n = 0; n < 2; ++n) { const f32x4 xi = *(const f32x4*)(xin + off + bj * 128 + n * 16);
                        *(f32x4*)(xout + off + bj * 128 + n * 16) = xi + gv[bj][n] * acc[ai][bj][m][n]; } }
    }
};
struct EpiMoe1 {
    static constexpr bool PERM = true;
    bf16_t* hid; const float* slotw;
    __device__ __forceinline__ void operator()(const AccT& acc, const pg8::Unit& u, int wr, int wc, int fr, int fq) const {
        asm volatile("" : "+v"(fr), "+v"(fq));
        const int row0 = u.pm * 256 + wr * 64 + fr, pnl = u.pn & 3, col0 = 128 * pnl + 16 * wc + 4 * fq;
#pragma unroll
        for (int ai = 0; ai < 2; ++ai)
#pragma unroll
            for (int m = 0; m < 4; ++m) { const int row = row0 + ai * 128 + m * 16; const float cw = slotw[row];
#pragma unroll
                for (int bj = 0; bj < 2; ++bj) { const f32x4 gt = acc[ai][bj][m][0], up = acc[ai][bj][m][1]; f32x4 h;
#pragma unroll
                    for (int i = 0; i < 4; ++i) h[i] = gt[i] * sigmoidf_(gt[i]) * up[i] * cw;
                    u32x2 w; w.x = cvt_pk_bf16(h[0], h[1]); w.y = cvt_pk_bf16(h[2], h[3]);
                    *(u32x2*)(hid + (size_t)row * DEXP + col0 + 64 * bj) = w; } }
    }
};
struct EpiMoe2 {
    static constexpr bool PERM = true;
    bf16_t* y; const int* slotd;
    __device__ __forceinline__ void operator()(const AccT& acc, const pg8::Unit& u, int wr, int wc, int fr, int fq) const {
        asm volatile("" : "+v"(fr), "+v"(fq));
        const int row0 = u.pm * 256 + wr * 64 + fr, col0 = (u.pn & 3) * 256 + wc * 32 + 8 * fq;
#pragma unroll
        for (int ai = 0; ai < 2; ++ai)
#pragma unroll
            for (int m = 0; m < 4; ++m) { const int dst = slotd[row0 + ai * 128 + m * 16];
                if (dst >= 0) { bf16_t* rowp = y + (size_t)dst * 1024 + col0;
#pragma unroll
                    for (int bj = 0; bj < 2; ++bj) *(u32x4*)(rowp + bj * 128) = pack8(acc[ai][bj][m][0], acc[ai][bj][m][1]); } }
    }
};
struct MoeOrder {
    const LAS int* tile_end; int ntiles, G, c;
    __device__ __forceinline__ bool next(int i, pg8::Unit& u) const {
        const int L = i * G + c; if (L >= 4 * ntiles) return false;
        const int rt = L >> 2; int e = 0;
#pragma unroll
        for (int j = 0; j < NE; ++j) e += (rt >= tile_end[j]) ? 1 : 0;
        u.pm = rt; u.pn = __builtin_amdgcn_readfirstlane(e * 4 + (L & 3)); return true;
    }
    __device__ __forceinline__ void a_ready(const pg8::Unit&) const {}
    __device__ __forceinline__ void done(const pg8::Unit&) const {}
};

constexpr int RING_BYTES = 131072, MISC_OFF = 133120, LDS_BYTES = 147456;
struct Args { const float* in[18]; float* out; unsigned char* ws; int ph_lo, ph_hi; };
struct Frame {
    LAS unsigned char* lds; int tid, lane, wave, G, blk;
    float* out; unsigned char* ws; unsigned* ctl;
    __device__ __forceinline__ const float* in(int i) const {
        const LAS unsigned* t = (const LAS unsigned*)(lds + MISC_OFF + 1024) + 2 * i;
        const unsigned lo = __builtin_amdgcn_readfirstlane(t[0]), hi = __builtin_amdgcn_readfirstlane(t[1]);
        return (const float*)(((unsigned long long)hi << 32) | lo);
    }
};
enum { IN_X = 0, IN_C, IN_WADA, IN_BADA, IN_N1G, IN_WIN, IN_QNG, IN_KNG, IN_RELB, IN_WOA, IN_WOB, IN_WOUT, IN_N2G, IN_RW, IN_RB, IN_WG, IN_WU, IN_WDN };

__device__ __forceinline__ int win_src_col(int r) {
    if (r < 1024) return r;
    if (r < 1536) { const int rho = r - 1024, tile = rho >> 8, q = rho & 255, bj = q >> 7, wc = (q >> 5) & 3, j = q & 31; return 1536 + (tile * 4 + wc) * 64 + 32 * bj + j; }
    if (r < 2048) return 2176 + (r - 1536);
    if (r < 2304) { const int q = r - 2048, bj = q >> 7, wc = (q >> 5) & 3, j = q & 31, cs = 32 * bj + j;
        if (wc == 0) return 2048 + cs; if (wc == 1) return 2112 + cs; if (wc == 2) return 2688 + cs; return cs < 8 ? 2752 + cs : -1; }
    if (r < 3328) return 2760 + (r - 2304);
    if (r < 4352) return 3784 + (r - 3328);
    return 1024 + (r - 4352);
}
__device__ __forceinline__ void transpose_item(const float* colp, int ldw, int ksrc0, bf16_t* WT, size_t drow0, int ldk, int kdst0, LAS float* scr, int lane) {
#pragma unroll 8
    for (int i = 0; i < 32; ++i) { const int kk = 2 * i + (lane >> 5); scr[kk * 33 + (lane & 31)] = colp ? colp[(size_t)(ksrc0 + kk) * ldw] : 0.f; }
    LDS_WAIT(); asm volatile("" ::: "memory");
    const int c = lane & 7;
#pragma unroll
    for (int j = 0; j < 4; ++j) { const int n = (lane >> 3) + 8 * j; const LAS float* s = scr + (8 * c) * 33 + n;
        u32x4 o; o.x = pk2(s[0 * 33], s[1 * 33]); o.y = pk2(s[2 * 33], s[3 * 33]); o.z = pk2(s[4 * 33], s[5 * 33]); o.w = pk2(s[6 * 33], s[7 * 33]);
        *(u32x4*)(WT + (drow0 + n) * ldk + kdst0 + 8 * c) = o; }
    LDS_WAIT(); asm volatile("" ::: "memory");
}
constexpr int IT_WIN = 152 * 16, IT_WO = 32 * 16, IT_WOUT = 32 * 16, IT_SMALL = IT_WIN + IT_WO + IT_WOUT;
constexpr int IT_WGU = 16 * 32 * 16, IT_WD = 16 * 32 * 8, IT_EXP = IT_WGU + IT_WD;
__device__ __forceinline__ void convert_small_item(Frame& F, int l, int it, LAS float* scr) {
    const int n31 = F.lane & 31;
    if (it < IT_WIN) { const int rg = it >> 4, kg = it & 15; const int col = win_src_col(rg * 32 + n31);
        transpose_item(col >= 0 ? F.in(IN_WIN) + (size_t)l * DM * NIN + col : nullptr, NIN, kg * 64, (bf16_t*)(F.ws + WS_WIN + l * WIN_LAYER), (size_t)rg * 32, 1024, kg * 64, scr, F.lane); return; }
    it -= IT_WIN;
    if (it < IT_WO) { const int rg = it >> 4, kg = it & 15, k0 = kg * 64; const float* src = (k0 < 512 ? F.in(IN_WOA) : F.in(IN_WOB)) + (size_t)l * 512 * 1024 + rg * 32 + n31;
        transpose_item(src, 1024, k0 & 511, (bf16_t*)(F.ws + WS_WO) + (size_t)l * 1024 * 1024, (size_t)rg * 32, 1024, k0, scr, F.lane); return; }
    it -= IT_WO;
    { const int rg = it >> 4, kg = it & 15; transpose_item(F.in(IN_WOUT) + (size_t)l * 1024 * 1024 + rg * 32 + n31, 1024, kg * 64, (bf16_t*)(F.ws + WS_WOUT) + (size_t)l * 1024 * 1024, (size_t)rg * 32, 1024, kg * 64, scr, F.lane); }
}
__device__ __forceinline__ void convert_expert_item(Frame& F, int l, int it, LAS float* scr) {
    const int n31 = F.lane & 31;
    if (it < IT_WGU) { const int e = it >> 9, r2 = it & 511, rg = r2 >> 4, kg = r2 & 15; const int r = rg * 32 + n31, q = r >> 3, i = r & 7;
        const float* src = (i < 4 ? F.in(IN_WG) : F.in(IN_WU)) + (size_t)(l * NE + e) * DM * DEXP + 4 * q + (i & 3);
        transpose_item(src, DEXP, kg * 64, (bf16_t*)(F.ws + WS_WGU) + (size_t)e * 1024 * 1024, (size_t)rg * 32, 1024, kg * 64, scr, F.lane); return; }
    it -= IT_WGU;
    { const int e = it >> 8, r2 = it & 255, rg = r2 >> 3, kg = r2 & 7;
        transpose_item(F.in(IN_WDN) + (size_t)(l * NE + e) * DEXP * DM + rg * 32 + n31, DM, kg * 64, (bf16_t*)(F.ws + WS_WD) + (size_t)e * 1024 * 512, (size_t)rg * 32, 512, kg * 64, scr, F.lane); }
}

__device__ __forceinline__ void phase_prologue(Frame& F) {
    LAS float* scr = (LAS float*)(F.lds + F.wave * 8448);
    LAS float* sil = (LAS float*)(F.lds + 69632);
    const float* cin = F.in(IN_C); const float* badap = F.in(IN_BADA);
    for (int i = F.tid; i < BATCH * DM; i += NTHR) { const float v = cin[i]; sil[i] = v / (1.f + __expf(-v)); }
    __syncthreads();
    const int gw = F.blk * NWAVES + F.wave, NGW = F.G * NWAVES;
    float* modp = (float*)(F.ws + WS_MODP);
    for (int it = gw; it < 16 * 2 * 96; it += NGW) {
        const int jb = it % 96, l = (it / 96) & 1, kc = it / 192; const int j = jb * 64 + F.lane;
        float a[BATCH];
#pragma unroll
        for (int b = 0; b < BATCH; ++b) a[b] = 0.f;
        const float* wp = F.in(IN_WADA) + ((size_t)l * DM + kc * 64) * NMOD + j;
#pragma unroll 4
        for (int k = 0; k < 64; ++k) { const float w = wp[(size_t)k * NMOD];
#pragma unroll
            for (int b = 0; b < BATCH; ++b) a[b] += sil[b * DM + kc * 64 + k] * w; }
        const float bias = (kc == 0) ? badap[l * NMOD + j] : 0.f;
#pragma unroll
        for (int b = 0; b < BATCH; ++b) modp[(((size_t)kc * 2 + l) * BATCH + b) * NMOD + j] = a[b] + bias;
    }
    for (int it = gw; it < 2 * IT_SMALL; it += NGW) { const int l = it >= IT_SMALL ? 1 : 0; convert_small_item(F, l, it - l * IT_SMALL, scr); }
    for (int it = gw; it < IT_EXP; it += NGW) convert_expert_item(F, 0, it, scr);
}

__device__ __forceinline__ float modsum(const float* modp, int l, int b, int j) {
    float s = 0.f;
#pragma unroll
    for (int kc = 0; kc < 16; ++kc) s += modp[(((size_t)kc * 2 + l) * BATCH + b) * NMOD + j];
    return s;
}
__device__ __forceinline__ void phase_rows(Frame& F, int l, int mode) {
    LAS float* Av = (LAS float*)F.lds; LAS float* Sv = Av + DM; LAS float* Gv = Sv + DM;
    const float* modp = (const float*)(F.ws + WS_MODP);
    float* mod = (float*)(F.ws + WS_MOD);
    const float* n1g = F.in(IN_N1G); const float* xin = F.in(IN_X);
    const int row_base = F.blk * (T / F.G);
    const int b = row_base / SEQ;
    if (mode == 0) {
        const int per = (2 * BATCH * NMOD) / F.G;
        for (int i = F.tid; i < per; i += NTHR) { const int idx = F.blk * per + i; const int ll = idx / (BATCH * NMOD), bb = (idx / NMOD) % BATCH, j = idx % NMOD; mod[idx] = modsum(modp, ll, bb, j); }
    }
    for (int d = F.tid; d < DM; d += NTHR) {
        if (mode != 2) { Av[d] = n1g[l * DM + d] * (1.f + modsum(modp, l, b, 1 * DM + d)); Sv[d] = modsum(modp, l, b, 0 * DM + d); }
        if (mode != 0) Gv[d] = modsum(modp, l - 1, b, 5 * DM + d);
    }
    if (mode == 1) {
        LAS float* scr = (LAS float*)(F.lds + 16384 + F.wave * 8448);
        const int gw = F.blk * NWAVES + F.wave, NGW = F.G * NWAVES;
        for (int it = gw; it < IT_EXP; it += NGW) convert_expert_item(F, l, it, scr);
    }
    __syncthreads();
    const bf16_t* ybuf = (const bf16_t*)(F.ws + WS_Y);
    bf16_t* hb = (bf16_t*)(F.ws + WS_H);
    const int rows_per_wave = (T / F.G) / NWAVES;
    for (int i = 0; i < rows_per_wave; ++i) {
        const int row = row_base + F.wave * rows_per_wave + i;
        f32x4 v[4];
        const float* xr = (mode == 0 ? xin : F.out) + (size_t)row * DM;
#pragma unroll
        for (int j = 0; j < 4; ++j) v[j] = *(const f32x4*)(xr + 4 * F.lane + 256 * j);
        if (mode != 0) {
#pragma unroll
            for (int j = 0; j < 4; ++j) { const int c0 = 4 * F.lane + 256 * j;
                const u32x2 y0 = *(const u32x2*)(ybuf + (size_t)(2 * row) * DM + c0), y1 = *(const u32x2*)(ybuf + (size_t)(2 * row + 1) * DM + c0);
                v[j][0] += Gv[c0 + 0] * (bflo(y0.x) + bflo(y1.x)); v[j][1] += Gv[c0 + 1] * (bfhi(y0.x) + bfhi(y1.x));
                v[j][2] += Gv[c0 + 2] * (bflo(y0.y) + bflo(y1.y)); v[j][3] += Gv[c0 + 3] * (bfhi(y0.y) + bfhi(y1.y));
                *(f32x4*)(F.out + (size_t)row * DM + c0) = v[j]; }
        }
        if (mode != 2) {
            float ss = 0.f;
#pragma unroll
            for (int j = 0; j < 4; ++j) ss += (v[j][0] * v[j][0] + v[j][1] * v[j][1]) + (v[j][2] * v[j][2] + v[j][3] * v[j][3]);
            const float r = 1.0f / sqrtf(wave_sum(ss) * (1.0f / DM) + EPS);
#pragma unroll
            for (int j = 0; j < 4; ++j) { const int c0 = 4 * F.lane + 256 * j; u32x2 w;
                w.x = pk2(v[j][0] * r * Av[c0] + Sv[c0], v[j][1] * r * Av[c0 + 1] + Sv[c0 + 1]);
                w.y = pk2(v[j][2] * r * Av[c0 + 2] + Sv[c0 + 2], v[j][3] * r * Av[c0 + 3] + Sv[c0 + 3]);
                *(u32x2*)(hb + (size_t)row * DM + c0) = w; }
        }
    }
}

typedef float f32x16 __attribute__((ext_vector_type(16)));
__device__ __forceinline__ bf16x8 pack_bf16x8(float a0, float a1, float a2, float a3, float a4, float a5, float a6, float a7) {
    u32x4 w; w.x = cvt_pk_bf16(a0, a1); w.y = cvt_pk_bf16(a2, a3); w.z = cvt_pk_bf16(a4, a5); w.w = cvt_pk_bf16(a6, a7); return __builtin_bit_cast(bf16x8, w);
}
__device__ __forceinline__ void phase_sb(Frame& F) {
    const bf16_t* qa = (const bf16_t*)(F.ws + WS_QA); const bf16_t* ka = (const bf16_t*)(F.ws + WS_KA); const bf16_t* vaT = (const bf16_t*)(F.ws + WS_VAT);
    bf16_t* oab = (bf16_t*)(F.ws + WS_OAB);
    const int lane = F.lane, q32 = lane & 31, hi = lane >> 5;
    const int NGW = F.G * NWAVES;
    for (int wu = F.blk * NWAVES + F.wave; wu < BATCH * 8 * 64; wu += NGW) {
        const int qblk = wu & 63, bh = wu >> 6, b = bh >> 3, h = bh & 7;
        const int qw = qblk * 32, t = qw + q32;
        const size_t rowb = (size_t)b * SEQ;
        bf16x8 qf[4];
#pragma unroll
        for (int ks = 0; ks < 4; ++ks) qf[ks] = *(const bf16x8*)(qa + (rowb + t) * 512 + h * 64 + 16 * ks + 8 * hi);
        f32x16 o0, o1;
#pragma unroll
        for (int r = 0; r < 16; ++r) { o0[r] = 0.f; o1[r] = 0.f; }
        float R = 0.f;
        for (int kb = qw; kb >= 0; kb -= 32) {
            const bf16_t* kp = ka + (rowb + kb + q32) * 512 + h * 64 + 8 * hi;
            bf16x8 kf[4];
#pragma unroll
            for (int ks = 0; ks < 4; ++ks) kf[ks] = *(const bf16x8*)(kp + 16 * ks);
            const bf16_t* vp = vaT + (size_t)(h * 64 + q32) * T + rowb + kb + 4 * hi;
            u32x2 vv[2][2][2];
#pragma unroll
            for (int dt = 0; dt < 2; ++dt)
#pragma unroll
                for (int sx = 0; sx < 2; ++sx)
#pragma unroll
                    for (int hf = 0; hf < 2; ++hf) vv[dt][sx][hf] = *(const u32x2*)(vp + (size_t)dt * 32 * T + 16 * sx + 8 * hf);
            f32x16 z;
#pragma unroll
            for (int r = 0; r < 16; ++r) z[r] = 0.f;
#pragma unroll
            for (int ks = 0; ks < 4; ++ks) z = __builtin_amdgcn_mfma_f32_32x32x16_bf16(kf[ks], qf[ks], z, 0, 0, 0);
            float lv[16], zs[16]; bool vl[16];
#pragma unroll
            for (int r = 0; r < 16; ++r) { const float zz = z[r]; const float sp = fmaxf(zz, 0.f) + __logf(1.f + __expf(-fabsf(zz)));
                vl[r] = (kb + (r & 3) + 8 * (r >> 2) + 4 * hi) < t; lv[r] = vl[r] ? -sp : 0.f; zs[r] = zz - sp; }
            float gs[4], pg[4], tl[4];
#pragma unroll
            for (int k = 0; k < 4; ++k) { gs[k] = (lv[4 * k] + lv[4 * k + 1]) + (lv[4 * k + 2] + lv[4 * k + 3]); pg[k] = __shfl_xor(gs[k], 32); }
            tl[3] = 0.f; tl[2] = gs[3] + pg[3]; tl[1] = tl[2] + (gs[2] + pg[2]); tl[0] = tl[1] + (gs[1] + pg[1]);
            const float tot = tl[0] + (gs[0] + pg[0]);
            float av[16];
#pragma unroll
            for (int k = 0; k < 4; ++k) { const float base = R + tl[k] + (hi == 0 ? pg[k] : 0.f);
                const float s3 = base, s2 = s3 + lv[4 * k + 3], s1 = s2 + lv[4 * k + 2], s0 = s1 + lv[4 * k + 1];
                av[4 * k + 0] = vl[4 * k + 0] ? __expf(zs[4 * k + 0] + s0) : 0.f; av[4 * k + 1] = vl[4 * k + 1] ? __expf(zs[4 * k + 1] + s1) : 0.f;
                av[4 * k + 2] = vl[4 * k + 2] ? __expf(zs[4 * k + 2] + s2) : 0.f; av[4 * k + 3] = vl[4 * k + 3] ? __expf(zs[4 * k + 3] + s3) : 0.f; }
            R += tot;
            const bf16x8 pf0 = pack_bf16x8(av[0], av[1], av[2], av[3], av[4], av[5], av[6], av[7]);
            const bf16x8 pf1 = pack_bf16x8(av[8], av[9], av[10], av[11], av[12], av[13], av[14], av[15]);
#define SB_VF(dt, sx) __builtin_bit_cast(bf16x8, (u32x4){vv[dt][sx][0].x, vv[dt][sx][0].y, vv[dt][sx][1].x, vv[dt][sx][1].y})
            o0 = __builtin_amdgcn_mfma_f32_32x32x16_bf16(SB_VF(0, 0), pf0, o0, 0, 0, 0);
            o0 = __builtin_amdgcn_mfma_f32_32x32x16_bf16(SB_VF(0, 1), pf1, o0, 0, 0, 0);
            o1 = __builtin_amdgcn_mfma_f32_32x32x16_bf16(SB_VF(1, 0), pf0, o1, 0, 0, 0);
            o1 = __builtin_amdgcn_mfma_f32_32x32x16_bf16(SB_VF(1, 1), pf1, o1, 0, 0, 0);
#undef SB_VF
            if (__all(R <= -104.f)) break;
        }
        bf16_t* op = oab + (rowb + t) * 1024 + h * 64 + 4 * hi;
#pragma unroll
        for (int k = 0; k < 4; ++k) { u32x2 w0, w1; w0.x = cvt_pk_bf16(o0[4 * k], o0[4 * k + 1]); w0.y = cvt_pk_bf16(o0[4 * k + 2], o0[4 * k + 3]);
            w1.x = cvt_pk_bf16(o1[4 * k], o1[4 * k + 1]); w1.y = cvt_pk_bf16(o1[4 * k + 2], o1[4 * k + 3]);
            *(u32x2*)(op + 8 * k) = w0; *(u32x2*)(op + 32 + 8 * k) = w1; }
    }
}

__device__ __forceinline__ unsigned sortable(float f) { const unsigned u = __builtin_bit_cast(unsigned, f); return (u & 0x80000000u) ? ~u : (u | 0x80000000u); }
__device__ __forceinline__ void topk_select_store(const unsigned (&key)[32], LAS unsigned* maskrow, int lane) {
    unsigned thr = 0u;
    for (int bit = 31; bit >= 0; --bit) { const unsigned cand = thr | (1u << bit); int cnt = 0;
#pragma unroll
        for (int j = 0; j < 32; ++j) cnt += __popcll(__ballot(key[j] >= cand));
        if (cnt >= 256) thr = cand; }
    int cgt = 0;
#pragma unroll
    for (int j = 0; j < 32; ++j) cgt += __popcll(__ballot(key[j] > thr));
    const int need = 256 - cgt; int run = 0; unsigned myword = 0u;
    const unsigned long long lt = (1ull << lane) - 1ull;
#pragma unroll
    for (int j = 0; j < 32; ++j) {
        const unsigned long long eq = __ballot(key[j] == thr), gt = __ballot(key[j] > thr);
        const bool tie_sel = (key[j] == thr) && (run + __popcll(eq & lt) < need);
        const unsigned long long sel = gt | __ballot(tie_sel);
        run += __popcll(eq);
        if (lane == 2 * j) myword = (unsigned)sel;
        if (lane == 2 * j + 1) myword = (unsigned)(sel >> 32);
    }
    maskrow[lane] = myword;
}
__device__ __forceinline__ int t5_bucket(int d) {
    if (d < 16) return d;
    int bkt = 16;
    bkt += (d >= 19); bkt += (d >= 21); bkt += (d >= 24); bkt += (d >= 27); bkt += (d >= 31); bkt += (d >= 35); bkt += (d >= 40); bkt += (d >= 46);
    bkt += (d >= 52); bkt += (d >= 59); bkt += (d >= 67); bkt += (d >= 77); bkt += (d >= 87); bkt += (d >= 99); bkt += (d >= 113);
    return bkt;
}
constexpr int SC_STRIDE = 2052;
__device__ __forceinline__ void phase_strip(Frame& F) {
    LAS unsigned* SCB = (LAS unsigned*)F.lds;
    LAS unsigned* MSK = (LAS unsigned*)(F.lds + MISC_OFF + 2048);
    LAS float* LUT = (LAS float*)(F.lds + MISC_OFF + 2048 + 4096);
    const bf16_t* qi = (const bf16_t*)(F.ws + WS_QI); const bf16_t* ki = (const bf16_t*)(F.ws + WS_KI); const float* wi = (const float*)(F.ws + WS_WI);
    const bf16_t* qb = (const bf16_t*)(F.ws + WS_QB); const bf16_t* kbp = (const bf16_t*)(F.ws + WS_KB); const bf16_t* vbT = (const bf16_t*)(F.ws + WS_VBT);
    bf16_t* oab = (bf16_t*)(F.ws + WS_OAB);
    const float* relb = F.in(IN_RELB);
    for (int i = F.tid; i < 8 * 114; i += NTHR) { const int h = i / 114, d = i % 114; LUT[i] = relb[t5_bucket(d) * 8 + h]; }
    __syncthreads();
    const int lane = F.lane, q = lane & 15, g = lane >> 4, w = F.wave;
    for (int vc = F.blk; vc < 256; vc += F.G) {
        const int b = vc >> 5, jj = vc & 31; const size_t rowb = (size_t)b * SEQ;
        for (int it = 0; it < 4; ++it) {
            const int si = it == 0 ? jj : (it == 1 ? 63 - jj : (it == 2 ? 64 + jj : 127 - jj)); const int t0 = 16 * si;
            if (si < 16) {
                for (int idx = F.tid; idx < 16 * 64; idx += NTHR) { const int nb = t0 + (idx >> 6) + 1 - 32 * (idx & 63); MSK[idx] = nb >= 32 ? 0xffffffffu : (nb <= 0 ? 0u : ((1u << nb) - 1u)); }
            } else {
                bf16x8 qif[8][2]; float wq[8];
#pragma unroll
                for (int h = 0; h < 8; ++h) { wq[h] = wi[(rowb + t0 + q) * 8 + h];
#pragma unroll
                    for (int ks = 0; ks < 2; ++ks) qif[h][ks] = *(const bf16x8*)(qi + (rowb + t0 + q) * 512 + h * 64 + 32 * ks + 8 * g); }
                const bf16_t* kpb = ki + (rowb + q) * 64 + 8 * g;
                bf16x8 nk0 = *(const bf16x8*)(kpb + (size_t)(16 * w) * 64), nk1 = *(const bf16x8*)(kpb + (size_t)(16 * w) * 64 + 32);
                for (int kt = w; kt <= si; kt += 8) {
                    const bf16x8 kf0 = nk0, kf1 = nk1;
                    if (kt + 8 <= si) { nk0 = *(const bf16x8*)(kpb + (size_t)(16 * (kt + 8)) * 64); nk1 = *(const bf16x8*)(kpb + (size_t)(16 * (kt + 8)) * 64 + 32); }
                    f32x4 sc = (f32x4){0.f, 0.f, 0.f, 0.f};
#pragma unroll
                    for (int h = 0; h < 8; ++h) { f32x4 d = __builtin_amdgcn_mfma_f32_16x16x32_bf16(kf0, qif[h][0], (f32x4){0.f, 0.f, 0.f, 0.f}, 0, 0, 0);
                        d = __builtin_amdgcn_mfma_f32_16x16x32_bf16(kf1, qif[h][1], d, 0, 0, 0);
#pragma unroll
                        for (int i = 0; i < 4; ++i) sc[i] += wq[h] * fmaxf(d[i], 0.f); }
                    u32x4 key;
#pragma unroll
                    for (int i = 0; i < 4; ++i) key[i] = (16 * kt + 4 * g + i <= t0 + q) ? sortable(sc[i] + 0.f) : 0u;
                    *(LAS u32x4*)(SCB + q * SC_STRIDE + 16 * kt + 4 * g) = key;
                }
                __syncthreads();
                const int nk = 16 * (si + 1);
                for (int qq = 2 * w; qq < 2 * w + 2; ++qq) { unsigned key[32];
#pragma unroll
                    for (int j = 0; j < 32; ++j) { const int s = lane + 64 * j; key[j] = (s < nk) ? SCB[qq * SC_STRIDE + s] : 0u; }
                    topk_select_store(key, MSK + qq * 64, lane); }
            }
            __syncthreads();
            {
                const int h = w, t = t0 + q;
                bf16x8 qf[2];
#pragma unroll
                for (int ks = 0; ks < 2; ++ks) qf[ks] = *(const bf16x8*)(qb + (rowb + t) * 512 + h * 64 + 32 * ks + 8 * g);
                f32x4 o[4];
#pragma unroll
                for (int dt = 0; dt < 4; ++dt) o[dt] = (f32x4){0.f, 0.f, 0.f, 0.f};
                float m = -1e30f, l = 0.f;
                const int nch = (t0 + 15) / 32 + 1;
                const bf16_t* kpb = kbp + (rowb + q) * 64 + 8 * g;
                const bf16_t* vpb = vbT + (size_t)q * T + rowb + 4 * g;
                bf16x8 nkf[2][2]; u32x2 nvf[4][2];
#pragma unroll
                for (int tl = 0; tl < 2; ++tl)
#pragma unroll
                    for (int ks = 0; ks < 2; ++ks) nkf[tl][ks] = *(const bf16x8*)(kpb + (size_t)(16 * tl) * 64 + 32 * ks);
#pragma unroll
                for (int dt = 0; dt < 4; ++dt)
#pragma unroll
                    for (int hf = 0; hf < 2; ++hf) nvf[dt][hf] = *(const u32x2*)(vpb + (size_t)(16 * dt) * T + 16 * hf);
                for (int c = 0; c < nch; ++c) {
                    bf16x8 kf[2][2]; u32x2 vf[4][2];
#pragma unroll
                    for (int tl = 0; tl < 2; ++tl)
#pragma unroll
                        for (int ks = 0; ks < 2; ++ks) kf[tl][ks] = nkf[tl][ks];
#pragma unroll
                    for (int dt = 0; dt < 4; ++dt)
#pragma unroll
                        for (int hf = 0; hf < 2; ++hf) vf[dt][hf] = nvf[dt][hf];
                    if (c + 1 < nch) {
#pragma unroll
                        for (int tl = 0; tl < 2; ++tl)
#pragma unroll
                            for (int ks = 0; ks < 2; ++ks) nkf[tl][ks] = *(const bf16x8*)(kpb + (size_t)(32 * (c + 1) + 16 * tl) * 64 + 32 * ks);
#pragma unroll
                        for (int dt = 0; dt < 4; ++dt)
#pragma unroll
                            for (int hf = 0; hf < 2; ++hf) nvf[dt][hf] = *(const u32x2*)(vpb + (size_t)(16 * dt) * T + 32 * (c + 1) + 16 * hf);
                    }
                    const unsigned mw = MSK[q * 64 + c];
                    f32x4 s0 = __builtin_amdgcn_mfma_f32_16x16x32_bf16(kf[0][0], qf[0], (f32x4){0.f, 0.f, 0.f, 0.f}, 0, 0, 0);
                    s0 = __builtin_amdgcn_mfma_f32_16x16x32_bf16(kf[0][1], qf[1], s0, 0, 0, 0);
                    f32x4 s1 = __builtin_amdgcn_mfma_f32_16x16x32_bf16(kf[1][0], qf[0], (f32x4){0.f, 0.f, 0.f, 0.f}, 0, 0, 0);
                    s1 = __builtin_amdgcn_mfma_f32_16x16x32_bf16(kf[1][1], qf[1], s1, 0, 0, 0);
                    float zv[8]; bool bt[8]; float cm = -1e30f;
#pragma unroll
                    for (int i = 0; i < 4; ++i) {
                        const int k0 = 32 * c + 4 * g + i, k1 = k0 + 16;
                        int d0 = t - k0, d1 = t - k1; d0 = d0 < 0 ? 0 : (d0 > 113 ? 113 : d0); d1 = d1 < 0 ? 0 : (d1 > 113 ? 113 : d1);
                        zv[i] = s0[i] + LUT[h * 114 + d0]; zv[4 + i] = s1[i] + LUT[h * 114 + d1];
                        bt[i] = (mw >> (4 * g + i)) & 1u; bt[4 + i] = (mw >> (16 + 4 * g + i)) & 1u;
                        cm = fmaxf(cm, bt[i] ? zv[i] : -1e30f); cm = fmaxf(cm, bt[4 + i] ? zv[4 + i] : -1e30f);
                    }
                    cm = fmaxf(cm, __shfl_xor(cm, 16)); cm = fmaxf(cm, __shfl_xor(cm, 32));
                    const float mn = fmaxf(m, cm), alpha = __expf(m - mn); m = mn;
                    float p[8], ps = 0.f;
#pragma unroll
                    for (int i = 0; i < 8; ++i) { p[i] = bt[i] ? __expf(zv[i] - mn) : 0.f; ps += p[i]; }
                    l = l * alpha + ps;
                    const bf16x8 pf = pack_bf16x8(p[0], p[1], p[2], p[3], p[4], p[5], p[6], p[7]);
#pragma unroll
                    for (int dt = 0; dt < 4; ++dt) { o[dt] = o[dt] * alpha;
                        const bf16x8 vfr = __builtin_bit_cast(bf16x8, (u32x4){vf[dt][0].x, vf[dt][0].y, vf[dt][1].x, vf[dt][1].y});
                        o[dt] = __builtin_amdgcn_mfma_f32_16x16x32_bf16(vfr, pf, o[dt], 0, 0, 0); }
                }
                l += __shfl_xor(l, 16); l += __shfl_xor(l, 32);
                const float il = 1.f / l;
                bf16_t* op = oab + (rowb + t) * 1024 + 512 + h * 64 + 4 * g;
#pragma unroll
                for (int dt = 0; dt < 4; ++dt) { u32x2 wv; wv.x = cvt_pk_bf16(o[dt][0] * il, o[dt][1] * il); wv.y = cvt_pk_bf16(o[dt][2] * il, o[dt][3] * il); *(u32x2*)(op + 16 * dt) = wv; }
            }
            __syncthreads();
        }
    }
}

__device__ __forceinline__ void phase_h2_route(Frame& F, int l) {
    LAS float* Av = (LAS float*)F.lds; LAS float* Sv = Av + DM;
    LAS float* RW = (LAS float*)(F.lds + 8192);
    LAS float* RB = (LAS float*)(F.lds + 73728);
    LAS int* lcnt = (LAS int*)(F.lds + 73728 + 64);
    LAS int* lbase = (LAS int*)(F.lds + 73728 + 128);
    LAS int* rinfo = (LAS int*)(F.lds + 73728 + 256);
    const float* mod = (const float*)(F.ws + WS_MOD) + (size_t)l * BATCH * NMOD;
    const int rows_per_blk = T / F.G, row_base = F.blk * rows_per_blk, b = row_base / SEQ;
    const float* n2g = F.in(IN_N2G); const float* rwp = F.in(IN_RW); const float* rbp = F.in(IN_RB);
    for (int d = F.tid; d < DM; d += NTHR) { Av[d] = n2g[l * DM + d] * (1.f + mod[(size_t)b * NMOD + 4 * DM + d]); Sv[d] = mod[(size_t)b * NMOD + 3 * DM + d]; }
    for (int i = F.tid; i < DM * NE; i += NTHR) RW[i] = rwp[i];
    if (F.tid < NE) { RB[F.tid] = rbp[F.tid]; lcnt[F.tid] = 0; }
    __syncthreads();
    bf16_t* hb = (bf16_t*)(F.ws + WS_H);
    const int rows_per_wave = rows_per_blk / NWAVES;
    for (int i = 0; i < rows_per_wave; ++i) {
        const int lr = F.wave * rows_per_wave + i, row = row_base + lr;
        f32x4 v[4]; float ss = 0.f;
#pragma unroll
        for (int j = 0; j < 4; ++j) { v[j] = *(const f32x4*)(F.out + (size_t)row * DM + 4 * F.lane + 256 * j); ss += (v[j][0] * v[j][0] + v[j][1] * v[j][1]) + (v[j][2] * v[j][2] + v[j][3] * v[j][3]); }
        const float r = 1.0f / sqrtf(wave_sum(ss) * (1.0f / DM) + EPS);
        float lg[NE];
#pragma unroll
        for (int e = 0; e < NE; ++e) lg[e] = 0.f;
#pragma unroll
        for (int j = 0; j < 4; ++j) { const int c0 = 4 * F.lane + 256 * j; u32x2 w;
#pragma unroll
            for (int k = 0; k < 4; ++k) { v[j][k] = v[j][k] * r * Av[c0 + k] + Sv[c0 + k];
#pragma unroll
                for (int e4 = 0; e4 < 4; ++e4) { const f32x4 rw = *(const LAS f32x4*)(RW + (c0 + k) * NE + e4 * 4);
                    lg[e4 * 4 + 0] += v[j][k] * rw[0]; lg[e4 * 4 + 1] += v[j][k] * rw[1]; lg[e4 * 4 + 2] += v[j][k] * rw[2]; lg[e4 * 4 + 3] += v[j][k] * rw[3]; } }
            w.x = pk2(v[j][0], v[j][1]); w.y = pk2(v[j][2], v[j][3]);
            *(u32x2*)(hb + (size_t)row * DM + c0) = w; }
        float mxl = -1e30f;
#pragma unroll
        for (int e = 0; e < NE; ++e) { lg[e] = wave_sum(lg[e]) + RB[e]; mxl = fmaxf(mxl, lg[e]); }
        float pr[NE], den = 0.f;
#pragma unroll
        for (int e = 0; e < NE; ++e) { pr[e] = expf(lg[e] - mxl); den += pr[e]; }
        const float iden = 1.f / den;
#pragma unroll
        for (int e = 0; e < NE; ++e) pr[e] *= iden;
        int bg = 0; float bs = -1.f, bv0 = 0.f, bv1 = 0.f; int bi0 = 0, bi1 = 1;
#pragma unroll
        for (int g = 0; g < 4; ++g) {
            float v0 = pr[4 * g], v1 = -1.f; int i0 = 0, i1 = -1;
#pragma unroll
            for (int k = 1; k < 4; ++k) { const float p = pr[4 * g + k];
                if (p > v0) { v1 = v0; i1 = i0; v0 = p; i0 = k; } else if (p > v1) { v1 = p; i1 = k; } }
            const float gs = v0 + v1;
            if (gs > bs) { bs = gs; bg = g; bv0 = v0; bv1 = v1; bi0 = i0; bi1 = i1; }
        }
        const int e0 = bg * 4 + bi0, e1 = bg * 4 + bi1; const float wsum = bv0 + bv1, w0 = bv0 / wsum, w1 = bv1 / wsum;
        if (F.lane == 0) { const int p0 = __hip_atomic_fetch_add(lcnt + e0, 1, __ATOMIC_RELAXED, __HIP_MEMORY_SCOPE_WORKGROUP), p1 = __hip_atomic_fetch_add(lcnt + e1, 1, __ATOMIC_RELAXED, __HIP_MEMORY_SCOPE_WORKGROUP);
            rinfo[lr * 6 + 0] = e0; rinfo[lr * 6 + 1] = p0; rinfo[lr * 6 + 2] = __float_as_int(w0); rinfo[lr * 6 + 3] = e1; rinfo[lr * 6 + 4] = p1; rinfo[lr * 6 + 5] = __float_as_int(w1); }
    }
    __syncthreads();
    unsigned* gcnt = F.ctl + CW_GCNT + 64 * l;
    if (F.tid < NE) lbase[F.tid] = (int)__hip_atomic_fetch_add(gcnt + F.tid, (unsigned)lcnt[F.tid], RLX_AGENT);
    __syncthreads();
    int* etok = (int*)(F.ws + WS_ETOK); float* ew = (float*)(F.ws + WS_EW); int* edst = (int*)(F.ws + WS_EDST);
    if (F.tid < 2 * rows_per_blk) { const int lr = F.tid >> 1, k = F.tid & 1; const int e = rinfo[lr * 6 + 3 * k], p = rinfo[lr * 6 + 3 * k + 1]; const float w = __int_as_float(rinfo[lr * 6 + 3 * k + 2]);
        const int slot = lbase[e] + p, tok = row_base + lr;
        etok[e * T + slot] = tok; ew[e * T + slot] = w; edst[e * T + slot] = 2 * tok + k; }
}

__device__ __forceinline__ int moe_table(Frame& F, int l, LAS int* tile_end) {
    if (F.tid < 64) { const int e = F.lane & 15; const int n = (int)__hip_atomic_load(F.ctl + CW_GCNT + 64 * l + e, RLX_AGENT); int tiles = (n + 255) >> 8, cum = tiles;
#pragma unroll
        for (int o = 1; o < 16; o <<= 1) { const int v = __shfl_up(cum, o, 16); if (e >= o) cum += v; }
        if (F.lane < 16) { tile_end[e] = cum; tile_end[16 + e] = n; } }
    __syncthreads();
    return tile_end[15];
}
__device__ __forceinline__ void phase_gather(Frame& F, int l) {
    LAS int* tile_end = (LAS int*)(F.lds + MISC_OFF + 512);
    const int ntiles = moe_table(F, l, tile_end);
    const int* etok = (const int*)(F.ws + WS_ETOK); const float* ew = (const float*)(F.ws + WS_EW); const int* edst = (const int*)(F.ws + WS_EDST);
    float* slotw = (float*)(F.ws + WS_SLOTW); int* slotd = (int*)(F.ws + WS_SLOTD);
    const bf16_t* hb = (const bf16_t*)(F.ws + WS_H); bf16_t* xg = (bf16_t*)(F.ws + WS_XG);
    const int NGW = F.G * NWAVES;
    for (int p = F.blk * NWAVES + F.wave; p < ntiles * 256; p += NGW) {
        const int rt = p >> 8; int e = 0;
#pragma unroll
        for (int j = 0; j < NE; ++j) e += (rt >= tile_end[j]) ? 1 : 0;
        const int rbase = (e == 0 ? 0 : tile_end[e - 1]) * 256, idx = p - rbase, n = tile_end[16 + e];
        u32x4 a = (u32x4){0u, 0u, 0u, 0u}, c = a;
        if (idx < n) { const int tok = etok[e * T + idx]; const u32x4* src = (const u32x4*)(hb + (size_t)tok * DM); a = src[F.lane]; c = src[64 + F.lane];
            if (F.lane == 0) { slotw[p] = ew[e * T + idx]; slotd[p] = edst[e * T + idx]; } }
        else if (F.lane == 0) { slotw[p] = 0.f; slotd[p] = -1; }
        u32x4* dst = (u32x4*)(xg + (size_t)p * DM); dst[F.lane] = a; dst[64 + F.lane] = c;
    }
}

#define XB_TMO      128
#define XB_XCNT(j)  (256  + 64 * (j))
#define XB_XSUB(j)  (1280 + 64 * (j))
#define XB_XGEN(j)  (2304 + 64 * (j))
#define XB_TOP      3328
#define XB_TOPGEN   3392
#define XCD_BAR_WORDS 3456
#define XB_SPIN_CAP (1u << 20)
__device__ __forceinline__ unsigned xb_ld(unsigned* p)              { return __hip_atomic_load(p, __ATOMIC_RELAXED, __HIP_MEMORY_SCOPE_AGENT); }
__device__ __forceinline__ unsigned xb_add(unsigned* p, unsigned v) { return __hip_atomic_fetch_add(p, v, __ATOMIC_RELAXED, __HIP_MEMORY_SCOPE_AGENT); }
__device__ __forceinline__ unsigned xb_xcc_id() { return (unsigned)__builtin_amdgcn_s_getreg((3 << 11) | 20) & 0xFu; }
#define XB_SPIN(cond, bar) do { unsigned _sp = 0; while (cond) { __builtin_amdgcn_s_sleep(1); \
    if ((++_sp & 255u) == 0u) { if (xb_ld(&(bar)[XB_TMO])) break; if (_sp > XB_SPIN_CAP) { atomicAdd(&(bar)[XB_TMO], 1u); break; } } } } while (0)
struct XcdBarrier { unsigned* bar; unsigned x; volatile LAS unsigned* st; };
__device__ __forceinline__ XcdBarrier xcd_barrier_post(unsigned* bar, volatile LAS unsigned* st) {
    XcdBarrier b; b.bar = bar; b.x = xb_xcc_id(); b.st = st;
    if (threadIdx.x == 0) (void)xb_add(&bar[XB_XCNT(b.x)], 1u);
    return b;
}
__device__ __forceinline__ void xcd_barrier_complete(unsigned* bar, unsigned x, unsigned& nloc, unsigned& nx) {
    const unsigned G = gridDim.x * gridDim.y * gridDim.z;
    unsigned sum, cnt, mine, sp = 0u;
    for (;;) {
        sum = 0u; cnt = 0u; mine = 0u;
#pragma unroll
        for (unsigned j = 0; j < 16; ++j) { const unsigned c = xb_ld(&bar[XB_XCNT(j)]); sum += c; cnt += (c > 0u) ? 1u : 0u; mine = (j == x) ? c : mine; }
        if (sum == G) break;
        __builtin_amdgcn_s_sleep(1);
        if ((++sp & 255u) == 0u) { if (xb_ld(&bar[XB_TMO])) break; if (sp > XB_SPIN_CAP) { atomicAdd(&bar[XB_TMO], 1u); break; } }
    }
    nloc = mine > 0u ? mine : 1u; nx = cnt > 0u ? cnt : 1u;
}
__device__ __forceinline__ void xcd_barrier(const XcdBarrier& b) {
    asm volatile("s_waitcnt vmcnt(0)" ::: "memory");
    __syncthreads();
    if (threadIdx.x == 0) {
        unsigned* bar = b.bar;
        __builtin_amdgcn_s_waitcnt(0);
        unsigned nloc = b.st[0], nx = b.st[1];
        if (nloc == 0u) { xcd_barrier_complete(bar, b.x, nloc, nx); b.st[0] = nloc; b.st[1] = nx; }
        const unsigned old = xb_add(&bar[XB_XSUB(b.x)], 1u);
        const unsigned gen = old / nloc;
        if (old + 1u == (gen + 1u) * nloc) {
            __builtin_amdgcn_fence(__ATOMIC_RELEASE, "agent");
            asm volatile("s_waitcnt vmcnt(0)" ::: "memory");
            const unsigned og = xb_add(&bar[XB_TOP], 1u);
            const unsigned tg = og / nx;
            if (og + 1u == (tg + 1u) * nx) xb_add(&bar[XB_TOPGEN], 1u);
            else XB_SPIN(xb_ld(&bar[XB_TOPGEN]) == tg, bar);
            __builtin_amdgcn_fence(__ATOMIC_ACQUIRE, "agent");
            xb_add(&bar[XB_XGEN(b.x)], 1u);
            asm volatile("s_waitcnt vmcnt(0)" ::: "memory");
        } else {
            XB_SPIN(xb_ld(&bar[XB_XGEN(b.x)]) == gen, bar);
            __builtin_amdgcn_fence(__ATOMIC_ACQUIRE, "agent");
            asm volatile("s_waitcnt vmcnt(0)" ::: "memory");
        }
    }
    __syncthreads();
}

constexpr int PH_PER_LAYER = 9, PH_FINAL = 1 + PH_PER_LAYER * DEPTH, N_PHASES = PH_FINAL + 1;
__global__ void __launch_bounds__(NTHR, 2) fwd_kernel(Args args) {
    extern __shared__ __attribute__((aligned(16))) unsigned char lds_raw[];
    Frame F;
    F.lds = (LAS unsigned char*)lds_raw;
    F.tid = threadIdx.x; F.lane = F.tid & 63; F.wave = __builtin_amdgcn_readfirstlane(F.tid >> 6); F.G = gridDim.x; F.blk = blockIdx.x;
    F.out = args.out; F.ws = args.ws; F.ctl = (unsigned*)(args.ws + WS_CTL);
    volatile LAS unsigned* MISC = (volatile LAS unsigned*)(F.lds + MISC_OFF);
    for (int u = F.tid; u < (LDS_BYTES - MISC_OFF) / 4; u += NTHR) ((LAS unsigned*)(F.lds + MISC_OFF))[u] = 0u;
    __syncthreads();
    if (F.tid < 36) ((LAS unsigned*)(F.lds + MISC_OFF + 1024))[F.tid] = ((const unsigned*)__builtin_amdgcn_kernarg_segment_ptr())[F.tid];
    __syncthreads();
    const int lo = args.ph_lo, hi = args.ph_hi;
    XcdBarrier bar; bar.bar = F.ctl + CW_BAR; bar.x = 0; bar.st = nullptr;
    if (hi - lo > 1) bar = xcd_barrier_post(F.ctl + CW_BAR, MISC + 8);
#define SEAM(k) do { if ((k) + 1 < hi) xcd_barrier(bar); } while (0)
    for (int ph = lo; ph < hi; ++ph) {
        { int t_ = threadIdx.x; asm volatile("" : "+v"(t_)); F.tid = t_; F.lane = t_ & 63; F.wave = __builtin_amdgcn_readfirstlane(t_ >> 6);
          unsigned char* w_ = args.ws; asm volatile("" : "+s"(w_)); F.ws = w_; F.ctl = (unsigned*)(w_ + WS_CTL); float* o_ = args.out; asm volatile("" : "+s"(o_)); F.out = o_; }
        if (ph == 0) { phase_prologue(F); }
        else if (ph == PH_FINAL) { phase_rows(F, DEPTH, 2); }
        else {
            const int l = (ph - 1) / PH_PER_LAYER, s = (ph - 1) % PH_PER_LAYER;
            bf16_t* hb = (bf16_t*)(F.ws + WS_H);
            if (s == 0) { phase_rows(F, l, l == 0 ? 0 : 1); }
            else if (s == 1) {
                { pg8::Gemm g{hb, (const bf16_t*)(F.ws + WS_WIN + l * WIN_LAYER)}; pg8::StaticOrder S; S.init(T, NMAIN, F.G, F.blk);
                  EpiIn E{(bf16_t*)(F.ws + WS_QA), (bf16_t*)(F.ws + WS_KA), (bf16_t*)(F.ws + WS_QB), (bf16_t*)(F.ws + WS_QI), (bf16_t*)(F.ws + WS_KB), (bf16_t*)(F.ws + WS_VBT), (bf16_t*)(F.ws + WS_KI),
                          (bf16_t*)(F.ws + WS_SGA), (bf16_t*)(F.ws + WS_SGB), (float*)(F.ws + WS_WI), F.in(IN_QNG) + l * 64, F.in(IN_KNG) + l * 64};
                  pg8::gemm_phase<1024, 1024, 1024, EpiIn, pg8::StaticOrder, true>(F.lds, g, S, E); }
                { pg8::Gemm g{(const bf16_t*)(F.ws + WS_WIN + l * WIN_LAYER) + (size_t)NMAIN * 1024, hb}; pg8::StaticOrder S; S.init(512, T, F.G, (F.blk + F.G / 2) % F.G);
                  EpiPlain E{(bf16_t*)(F.ws + WS_VAT), T};
                  pg8::gemm_phase<1024, 1024, 1024, EpiPlain, pg8::StaticOrder, true>(F.lds, g, S, E); }
            }
            else if (s == 2) { phase_strip(F); phase_sb(F); }
            else if (s == 3) {
                const bf16_t* oab = (const bf16_t*)(F.ws + WS_OAB); const bf16_t* wo = (const bf16_t*)(F.ws + WS_WO) + (size_t)l * 1024 * 1024;
                { pg8::Gemm g{oab, wo}; pg8::StaticOrder S; S.init(T, 1024, F.G, F.blk);
                  EpiGate E{(bf16_t*)(F.ws + WS_TMP), (const bf16_t*)(F.ws + WS_SGA), nullptr};
                  pg8::gemm_phase<1024, 1024, 512, EpiGate, pg8::StaticOrder, true>(F.lds, g, S, E); }
                { pg8::Gemm g{oab + 512, wo + 512}; pg8::StaticOrder S; S.init(T, 1024, F.G, F.blk);
                  EpiGate E{(bf16_t*)(F.ws + WS_MERGED), (const bf16_t*)(F.ws + WS_SGB), (const bf16_t*)(F.ws + WS_TMP)};
                  pg8::gemm_phase<1024, 1024, 512, EpiGate, pg8::StaticOrder, true>(F.lds, g, S, E); }
            }
            else if (s == 4) {
                pg8::Gemm g{(const bf16_t*)(F.ws + WS_MERGED), (const bf16_t*)(F.ws + WS_WOUT) + (size_t)l * 1024 * 1024}; pg8::StaticOrder S; S.init(T, 1024, F.G, F.blk);
                EpiOut E{l == 0 ? F.in(IN_X) : F.out, F.out, (const float*)(F.ws + WS_MOD) + (size_t)l * BATCH * NMOD + 2 * DM};
                pg8::gemm_phase<1024, 1024, 1024, EpiOut, pg8::StaticOrder, true>(F.lds, g, S, E);
            }
            else if (s == 5) { phase_h2_route(F, l); }
            else if (s == 6) { phase_gather(F, l); }
            else if (s == 7 || s == 8) {
                LAS int* tile_end = (LAS int*)(F.lds + MISC_OFF + 512);
                const int ntiles = moe_table(F, l, tile_end);
                MoeOrder S{tile_end, ntiles, F.G, F.blk};
                if (s == 7) { pg8::Gemm g{(const bf16_t*)(F.ws + WS_XG), (const bf16_t*)(F.ws + WS_WGU)};
                    EpiMoe1 E{(bf16_t*)(F.ws + WS_HID), (const float*)(F.ws + WS_SLOTW)};
                    pg8::gemm_phase<1024, 1024, 1024, EpiMoe1, MoeOrder, true>(F.lds, g, S, E); }
                else { pg8::Gemm g{(const bf16_t*)(F.ws + WS_HID), (const bf16_t*)(F.ws + WS_WD)};
                    EpiMoe2 E{(bf16_t*)(F.ws + WS_Y), (const int*)(F.ws + WS_SLOTD)};
                    pg8::gemm_phase<512, 512, 512, EpiMoe2, MoeOrder, true>(F.lds, g, S, E); }
            }
        }
        __syncthreads();
        SEAM(ph);
    }
#undef SEAM
}

extern "C" void kernel_launch(void* const* d_in, const int* in_sizes, int n_in, void* d_out, int out_size, void* d_ws, size_t ws_size, hipStream_t stream) {
    static int grid = 0;
    if (grid == 0) {
        if (n_in != 18 || out_size != T * DM || ws_size < WS_END) { fprintf(stderr, "kernel_launch: unexpected problem (n_in %d, out %d, ws %zu)\n", n_in, out_size, ws_size); grid = -1; return; }
        int dev = 0, cus = 0;
        if (hipGetDevice(&dev) != hipSuccess || hipDeviceGetAttribute(&cus, hipDeviceAttributeMultiprocessorCount, dev) != hipSuccess) { grid = -1; return; }
        if (hipFuncSetAttribute((const void*)fwd_kernel, hipFuncAttributeMaxDynamicSharedMemorySize, LDS_BYTES) != hipSuccess) { fprintf(stderr, "kernel_launch: hipFuncSetAttribute failed\n"); grid = -1; return; }
        (void)hipGetLastError();
        grid = cus;
        if (grid != 256) fprintf(stderr, "kernel_launch: %d CUs (built for 256)\n", grid);
    }
    if (grid < 0) return;
    (void)hipMemsetAsync((char*)d_ws + WS_CTL, 0, CTL_ZERO_BYTES, stream);
    Args a{};
    for (int i = 0; i < 18; ++i) a.in[i] = (const float*)d_in[i];
    a.out = (float*)d_out; a.ws = (unsigned char*)d_ws;
#if ONE_LAUNCH
    a.ph_lo = 0; a.ph_hi = N_PHASES;
    hipLaunchKernelGGL(fwd_kernel, dim3(grid), dim3(NTHR), LDS_BYTES, stream, a);
#else
    for (int ph = 0; ph < N_PHASES; ++ph) {
        const int s = ph == 0 || ph == PH_FINAL ? -1 : (ph - 1) % PH_PER_LAYER;
        (void)s;
        a.ph_lo = ph; a.ph_hi = ph + 1;
        hipLaunchKernelGGL(fwd_kernel, dim3(grid), dim3(NTHR), LDS_BYTES, stream, a);
    }
#endif
}
```

```cpp
#include <hip/hip_runtime.h>
#include <cstdio>
#include <cstdint>

#define LAS __attribute__((address_space(3)))
#define GAS __attribute__((address_space(1)))
typedef unsigned short bf16_t;
typedef short bf16x8 __attribute__((ext_vector_type(8)));
typedef float f32x4 __attribute__((ext_vector_type(4)));
typedef float f32x2 __attribute__((ext_vector_type(2)));
typedef unsigned u32x4 __attribute__((ext_vector_type(4)));
typedef unsigned u32x2 __attribute__((ext_vector_type(2)));

constexpr int BATCH = 8, SEQ = 2048, DM = 1024, T = BATCH * SEQ, DEPTH = 2;
constexpr int NIN = 4808, NMOD = 6 * DM;
constexpr int NE = 16, DEXP = 512;
constexpr int NMAIN = 4352;
constexpr int PMAX = 36864;
constexpr float EPS = 1e-6f;
constexpr int NWAVES = 8, NTHR = 512;

#ifndef ONE_LAUNCH
#define ONE_LAUNCH 1
#endif

constexpr size_t MiB = 1u << 20;
constexpr size_t WS_CTL = 0, CTL_ZERO_BYTES = 1 * MiB;
constexpr size_t WS_MOD = 1 * MiB;
constexpr size_t WS_MODP = 2 * MiB;
constexpr size_t WS_ETOK = 8 * MiB, WS_EW = 9 * MiB, WS_EDST = 10 * MiB;
constexpr size_t WS_SLOTW = 11 * MiB, WS_SLOTD = 11 * MiB + 256 * 1024;
constexpr size_t WS_MASK = 12 * MiB;
constexpr size_t WS_WIN = 16 * MiB;
constexpr size_t WIN_LAYER = (size_t)4864 * 1024 * 2;
constexpr size_t WS_WO = 35 * MiB, WS_WOUT = 39 * MiB;
constexpr size_t WS_WGU = 43 * MiB;
constexpr size_t WS_WD = 75 * MiB;
constexpr size_t WS_H = 92 * MiB;
constexpr size_t WS_QA = 124 * MiB, WS_KA = 140 * MiB, WS_VAT = 156 * MiB, WS_QB = 172 * MiB, WS_QI = 188 * MiB;
constexpr size_t WS_KB = 204 * MiB, WS_VBT = 206 * MiB, WS_KI = 208 * MiB, WS_WI = 210 * MiB;
constexpr size_t WS_SGA = 212 * MiB, WS_SGB = 244 * MiB, WS_OAB = 276 * MiB;
constexpr size_t WS_MERGED = 124 * MiB;
constexpr size_t WS_TMP = 156 * MiB;
constexpr size_t WS_XG = 124 * MiB;
constexpr size_t WS_HID = 196 * MiB;
constexpr size_t WS_Y = 232 * MiB;
constexpr size_t WS_END = 308 * MiB;
constexpr int CW_GCNT = 64;
constexpr int CW_BAR = 4096;

#define LDS_WAIT() asm volatile("s_waitcnt lgkmcnt(0)" ::: "memory")
#define VM_WAIT() asm volatile("s_waitcnt vmcnt(0)" ::: "memory")
#define RLX_AGENT __ATOMIC_RELAXED, __HIP_MEMORY_SCOPE_AGENT
__device__ __forceinline__ unsigned f2bf(float f) { unsigned u = __builtin_bit_cast(unsigned, f); return (u + 0x7fffu + ((u >> 16) & 1u)) >> 16; }
__device__ __forceinline__ unsigned pk2(float lo, float hi) { return f2bf(lo) | (f2bf(hi) << 16); }
__device__ __forceinline__ float bflo(unsigned w) { return __builtin_bit_cast(float, w << 16); }
__device__ __forceinline__ float bfhi(unsigned w) { return __builtin_bit_cast(float, w & 0xffff0000u); }
__device__ __forceinline__ float bf2f(bf16_t h) { return __builtin_bit_cast(float, (unsigned)h << 16); }
__device__ __forceinline__ unsigned cvt_pk_bf16(float lo, float hi) { unsigned r; asm volatile("v_cvt_pk_bf16_f32 %0, %1, %2" : "=v"(r) : "v"(lo), "v"(hi)); return r; }
__device__ __forceinline__ u32x4 pack8(f32x4 a, f32x4 b) { u32x4 w; w.x = cvt_pk_bf16(a[0], a[1]); w.y = cvt_pk_bf16(a[2], a[3]); w.z = cvt_pk_bf16(b[0], b[1]); w.w = cvt_pk_bf16(b[2], b[3]); return w; }
__device__ __forceinline__ float sigmoidf_(float x) { return 1.f / (1.f + __expf(-x)); }
__device__ __forceinline__ float wave_sum(float v) {
#pragma unroll
    for (int o = 1; o < 64; o <<= 1) v += __shfl_xor(v, o);
    return v;
}

namespace pg8 {
constexpr int BM = 256, BK = 64, HALF = 128, HTB = HALF * BK * 2, STAGE_BYTES = 8 * HTB, NXCD = 8, WGM = 8;
__host__ __device__ __forceinline__ int lds_byte(int r, int c) { const int st = (r >> 4) * 2 + (c >> 5), rr = r & 15, cc = c & 31, ob = rr * 64 + cc * 2; return st * 1024 + (ob ^ (((ob >> 9) & 1) << 5)); }
__host__ __device__ __forceinline__ void stage_rc(int b, int& R, int& C) { const int st = b / 1024, sb = b % 1024, swz = sb ^ (((sb >> 9) & 1) << 5); R = (st >> 1) * 16 + swz / 64; C = (st & 1) * 32 + (swz % 64) / 2; }
__host__ __device__ __forceinline__ int perm32(int rho) { const int n = rho >> 4, i = rho & 15; return 8 * (i >> 2) + 4 * n + (i & 3); }

struct Unit { int pm, pn; };
struct Gemm { const bf16_t* A; const bf16_t* Bt; };

struct StaticOrder {
    int nM, nN, nwg, G, c;
    __host__ __device__ void init(int M, int N, int G_, int c_) { nM = M / BM; nN = N / BM; nwg = nM * nN; G = G_; c = c_; }
    __host__ __device__ bool next(int i, Unit& u) const {
        const long L = (long)i * G + c; if (L >= nwg) return false;
        int wgid = (int)L; { const int q = nwg / NXCD, r = nwg % NXCD, xcd = wgid % NXCD, off = wgid / NXCD; wgid = (xcd < r ? xcd * (q + 1) : r * (q + 1) + (xcd - r) * q) + off; }
        const int nig = WGM * nN, gid = wgid / nig, fm = gid * WGM, gsz = (nM - fm) < WGM ? (nM - fm) : WGM;
        u.pm = fm + ((wgid % nig) % gsz); u.pn = (wgid % nig) / gsz; return true;
    }
    __device__ __forceinline__ void a_ready(const Unit&) const {}
    __device__ __forceinline__ void done(const Unit&) const {}
};

template <int LDA, int LDB, int KK, class Epi, class Sched, bool ALIGN_EPI>
__device__ __forceinline__ void gemm_phase(LAS unsigned char* lds, const Gemm g, const Sched& S, const Epi& E) {
    int tid = threadIdx.x; asm volatile("" : "+v"(tid));
    const int wid = __builtin_amdgcn_readfirstlane(tid >> 6), lane = tid & 63, wr = wid >> 2, wc = wid & 3, fr = lane & 15, fq = lane >> 4;
    constexpr int nt = KK / BK;
    unsigned voffA[2], voffB[2];
#pragma unroll
    for (int i = 0; i < 2; ++i) { int R, C; stage_rc(tid * 16 + i * 8192, R, C); const int Rb = Epi::PERM ? ((R & ~31) + perm32(R & 31)) : R;
        voffA[i] = (unsigned)(R * LDA + C) * 2u; voffB[i] = (unsigned)(Rb * LDB + C) * 2u; }
    constexpr size_t kstep = (size_t)(BK * 2);
    constexpr size_t hstepA = (size_t)HALF * LDA * 2, hstepB = (size_t)HALF * LDB * 2;
    constexpr size_t tstepA = 2 * hstepA, tstepB = 2 * hstepB;
    const unsigned ldsw = (unsigned)wid * 1024u;
    const int aoff = lds_byte(wr * 64 + fr, fq * 8), boff = lds_byte(wc * 32 + fr, fq * 8);
#define PG8_SA(b, h) (((b) * 2 + (h)) * HTB)
#define PG8_SB(b, h) ((4 + (b) * 2 + (h)) * HTB)
#define PG8_STAGE(bufoff, gbase, voff) do { _Pragma("unroll") for (int _i = 0; _i < 2; ++_i) \
        __builtin_amdgcn_global_load_lds((const unsigned*)((const char*)(gbase) + (voff)[_i]), (LAS unsigned*)(lds + (bufoff) + ldsw + _i * 8192), 16, 0, 0); } while (0)
#define PG8_LDA(dst, b, h) do { _Pragma("unroll") for (int m = 0; m < 4; ++m) _Pragma("unroll") for (int k = 0; k < 2; ++k) dst[m][k] = *(const LAS bf16x8*)(lds + PG8_SA(b, h) + aoff + m * 2048 + k * 1024); } while (0)
#define PG8_LDB(dst, b, h) do { _Pragma("unroll") for (int n = 0; n < 2; ++n) _Pragma("unroll") for (int k = 0; k < 2; ++k) dst[n][k] = *(const LAS bf16x8*)(lds + PG8_SB(b, h) + boff + n * 2048 + k * 1024); } while (0)
#define PG8_MMA(ai, bj, At, Bt) do { __builtin_amdgcn_s_setprio(1); _Pragma("unroll") for (int m = 0; m < 4; ++m) _Pragma("unroll") for (int n = 0; n < 2; ++n) _Pragma("unroll") for (int k = 0; k < 2; ++k) \
        acc[ai][bj][m][n] = __builtin_amdgcn_mfma_f32_16x16x32_bf16(Bt[n][k], At[m][k], acc[ai][bj][m][n], 0, 0, 0); __builtin_amdgcn_s_setprio(0); } while (0)
#define PG8_WAIT_V(n) asm volatile("s_waitcnt vmcnt(" #n ")" ::: "memory")
#define PG8_WAIT_L(n) asm volatile("s_waitcnt lgkmcnt(" #n ")" ::: "memory")
#define PG8_BAR __builtin_amdgcn_s_barrier()
#define PG8_SCHED __builtin_amdgcn_sched_barrier(0)
    Unit cur, nxt; int ui = 0;
    if (!S.next(0, cur)) return;
    f32x4 acc[2][2][4][2];
#pragma unroll
    for (int a = 0; a < 2; ++a)
#pragma unroll
        for (int b = 0; b < 2; ++b)
#pragma unroll
            for (int m = 0; m < 4; ++m)
#pragma unroll
                for (int n = 0; n < 2; ++n) acc[a][b][m][n] = (f32x4){0.f, 0.f, 0.f, 0.f};
    bf16x8 At[4][2], B0[2][2], B1[2][2];
    const char* cA = (const char*)g.A + (size_t)cur.pm * tstepA; const char* cB = (const char*)g.Bt + (size_t)cur.pn * tstepB;
    S.a_ready(cur);
    PG8_STAGE(PG8_SB(0, 0), cB, voffB); PG8_STAGE(PG8_SB(0, 1), cB + hstepB, voffB); PG8_STAGE(PG8_SA(0, 0), cA, voffA); PG8_STAGE(PG8_SA(0, 1), cA + hstepA, voffA);
    if (wr == 1) PG8_BAR;
    PG8_WAIT_V(2); PG8_BAR;
    PG8_STAGE(PG8_SB(1, 0), cB + kstep, voffB); PG8_STAGE(PG8_SA(1, 0), cA + kstep, voffA); PG8_STAGE(PG8_SB(1, 1), cB + hstepB + kstep, voffB);
    PG8_WAIT_V(6); PG8_BAR;
    for (;;) {
        const bool has_next = S.next(ui + 1, nxt);
        const char* nA = has_next ? (const char*)g.A + (size_t)nxt.pm * tstepA : cA; const char* nB = has_next ? (const char*)g.Bt + (size_t)nxt.pn * tstepB : cB;
        for (int t = 0; t < nt; t += 2) {
            const bool last = (t == nt - 2);
            const char* a1 = cA + (size_t)(t + 1) * kstep;
            const char* a2 = last ? nA : cA + (size_t)(t + 2) * kstep; const char* b2 = last ? nB : cB + (size_t)(t + 2) * kstep;
            const char* a3 = a2 + kstep; const char* b3 = b2 + kstep;
            if (last && has_next) S.a_ready(nxt);
            PG8_LDB(B0, 0, 0); PG8_LDB(B1, 0, 1); PG8_SCHED; PG8_LDA(At, 0, 0); PG8_STAGE(PG8_SA(1, 1), a1 + hstepA, voffA);
            PG8_WAIT_V(8); PG8_WAIT_L(0); PG8_BAR; PG8_MMA(0, 0, At, B0); PG8_MMA(0, 1, At, B1); PG8_BAR; PG8_SCHED;
            PG8_LDA(At, 0, 1); PG8_STAGE(PG8_SB(0, 0), b2, voffB); PG8_STAGE(PG8_SB(0, 1), b2 + hstepB, voffB); PG8_STAGE(PG8_SA(0, 0), a2, voffA);
            PG8_WAIT_V(8); PG8_WAIT_L(0); PG8_BAR; PG8_MMA(1, 0, At, B0); PG8_MMA(1, 1, At, B1); PG8_BAR; PG8_SCHED;
            PG8_LDB(B0, 1, 0); PG8_LDB(B1, 1, 1); PG8_SCHED; PG8_LDA(At, 1, 0); PG8_STAGE(PG8_SA(0, 1), a2 + hstepA, voffA);
            PG8_WAIT_V(8); PG8_WAIT_L(0); PG8_BAR; PG8_MMA(0, 0, At, B0); PG8_MMA(0, 1, At, B1); PG8_BAR; PG8_SCHED;
            PG8_LDA(At, 1, 1); PG8_STAGE(PG8_SB(1, 0), b3, voffB); PG8_STAGE(PG8_SB(1, 1), b3 + hstepB, voffB); PG8_STAGE(PG8_SA(1, 0), a3, voffA);
            PG8_WAIT_V(8); PG8_WAIT_L(0); PG8_BAR; PG8_MMA(1, 0, At, B0); PG8_MMA(1, 1, At, B1); PG8_BAR; PG8_SCHED;
        }
        if constexpr (ALIGN_EPI) { if (wr == 0) PG8_BAR; }
        E(acc, cur, wr, wc, fr, fq); S.done(cur);
        if (!has_next) break;
#pragma unroll
        for (int a = 0; a < 2; ++a)
#pragma unroll
            for (int b = 0; b < 2; ++b)
#pragma unroll
                for (int m = 0; m < 4; ++m)
#pragma unroll
                    for (int n = 0; n < 2; ++n) acc[a][b][m][n] = (f32x4){0.f, 0.f, 0.f, 0.f};
        cur = nxt; cA = nA; cB = nB; ++ui;
        if constexpr (ALIGN_EPI) { if (wr == 1) PG8_BAR; }
    }
    PG8_WAIT_V(0);
    if constexpr (!ALIGN_EPI) { if (wr == 0) PG8_BAR; }
    PG8_BAR;
#undef PG8_SA
#undef PG8_SB
#undef PG8_STAGE
#undef PG8_LDA
#undef PG8_LDB
#undef PG8_MMA
#undef PG8_WAIT_V
#undef PG8_WAIT_L
#undef PG8_BAR
#undef PG8_SCHED
}
}
typedef f32x4 AccT[2][2][4][2];

template <int SIG> __device__ __forceinline__ void store_tile_bf16(bf16_t* O, int ld, int colt, float sc, const AccT& acc, int row0, int wc, int fq) {
    const int col0 = colt + wc * 32 + 8 * fq;
#pragma unroll
    for (int ai = 0; ai < 2; ++ai)
#pragma unroll
        for (int m = 0; m < 4; ++m) { bf16_t* rowp = O + (size_t)(row0 + ai * 128 + m * 16) * ld + col0;
#pragma unroll
            for (int bj = 0; bj < 2; ++bj) { f32x4 v0 = acc[ai][bj][m][0] * sc, v1 = acc[ai][bj][m][1] * sc;
                if (SIG) {
#pragma unroll
                    for (int i = 0; i < 4; ++i) { v0[i] = sigmoidf_(v0[i]); v1[i] = sigmoidf_(v1[i]); } }
                *(u32x4*)(rowp + bj * 128) = pack8(v0, v1); } }
}
template <int NORM> __device__ __forceinline__ void store_head64(bf16_t* O, int ld, int cbase, const float* gain, float gsc, const AccT& acc, int row0, int fq) {
    f32x4 gq[2][2];
#pragma unroll
    for (int bj = 0; bj < 2; ++bj)
#pragma unroll
        for (int n = 0; n < 2; ++n) gq[bj][n] = NORM ? *(const f32x4*)(gain + 32 * bj + 8 * fq + 4 * n) * gsc : (f32x4){1.f, 1.f, 1.f, 1.f};
#pragma unroll
    for (int ai = 0; ai < 2; ++ai)
#pragma unroll
        for (int m = 0; m < 4; ++m) {
            float r = 1.f;
            if (NORM) { float ss = 0.f;
#pragma unroll
                for (int bj = 0; bj < 2; ++bj)
#pragma unroll
                    for (int n = 0; n < 2; ++n) { const f32x4 x = acc[ai][bj][m][n]; ss += (x[0] * x[0] + x[1] * x[1]) + (x[2] * x[2] + x[3] * x[3]); }
                ss += __shfl_xor(ss, 16); ss += __shfl_xor(ss, 32);
                r = 1.0f / sqrtf(ss * (1.0f / 64.0f) + EPS); }
            bf16_t* rowp = O + (size_t)(row0 + ai * 128 + m * 16) * ld + cbase + 8 * fq;
#pragma unroll
            for (int bj = 0; bj < 2; ++bj) { const f32x4 v0 = acc[ai][bj][m][0] * r * gq[bj][0], v1 = acc[ai][bj][m][1] * r * gq[bj][1];
                *(u32x4*)(rowp + 32 * bj) = pack8(v0, v1); } }
}
struct EpiIn {
    static constexpr bool PERM = true;
    bf16_t *qa, *ka, *qb, *qi, *kb, *vbT, *ki, *sga, *sgb; float* wi; const float *qg, *kg;
    __device__ __forceinline__ void operator()(const AccT& acc, const pg8::Unit& u, int wr, int wc, int fr, int fq) const {
        asm volatile("" : "+v"(fr), "+v"(fq));
        const int pn = u.pn, row0 = u.pm * 256 + wr * 64 + fr;
        if (pn < 2) store_tile_bf16<0>(qa, 512, pn * 256, 0.125f, acc, row0, wc, fq);
        else if (pn < 4) store_tile_bf16<0>(ka, 512, (pn - 2) * 256, 1.f, acc, row0, wc, fq);
        else if (pn < 6) store_head64<1>(qb, 512, ((pn - 4) * 4 + wc) * 64, qg, 0.125f, acc, row0, fq);
        else if (pn < 8) store_tile_bf16<0>(qi, 512, (pn - 6) * 256, 1.f, acc, row0, wc, fq);
        else if (pn == 8) {
            if (wc == 0) store_head64<1>(kb, 64, 0, kg, 1.f, acc, row0, fq);
            else if (wc == 1) {
#pragma unroll
                for (int ai = 0; ai < 2; ++ai)
#pragma unroll
                    for (int m = 0; m < 4; ++m) { bf16_t* p = vbT + (size_t)(8 * fq) * T + (row0 + ai * 128 + m * 16);
#pragma unroll
                        for (int bj = 0; bj < 2; ++bj)
#pragma unroll
                            for (int n = 0; n < 2; ++n)
#pragma unroll
                                for (int i = 0; i < 4; ++i) p[(size_t)(32 * bj + 4 * n + i) * T] = (bf16_t)f2bf(acc[ai][bj][m][n][i]); } }
            else if (wc == 2) store_head64<0>(ki, 64, 0, nullptr, 1.f, acc, row0, fq);
            else { if (fq == 0) {
#pragma unroll
                for (int ai = 0; ai < 2; ++ai)
#pragma unroll
                    for (int m = 0; m < 4; ++m) { float* p = wi + (size_t)(row0 + ai * 128 + m * 16) * 8; *(f32x4*)p = acc[ai][0][m][0]; *(f32x4*)(p + 4) = acc[ai][0][m][1]; } } }
        }
        else if (pn < 13) store_tile_bf16<1>(sga, 1024, (pn - 9) * 256, 1.f, acc, row0, wc, fq);
        else store_tile_bf16<1>(sgb, 1024, (pn - 13) * 256, 1.f, acc, row0, wc, fq);
    }
};
struct EpiPlain {
    static constexpr bool PERM = true;
    bf16_t* O; int ld;
    __device__ __forceinline__ void operator()(const AccT& acc, const pg8::Unit& u, int wr, int wc, int fr, int fq) const {
        asm volatile("" : "+v"(fr), "+v"(fq));
        store_tile_bf16<0>(O, ld, u.pn * 256, 1.f, acc, u.pm * 256 + wr * 64 + fr, wc, fq);
    }
};
struct EpiGate {
    static constexpr bool PERM = true;
    bf16_t* O; const bf16_t* gate; const bf16_t* add;
    __device__ __forceinline__ void operator()(const AccT& acc, const pg8::Unit& u, int wr, int wc, int fr, int fq) const {
        asm volatile("" : "+v"(fr), "+v"(fq));
        const int row0 = u.pm * 256 + wr * 64 + fr, col0 = u.pn * 256 + wc * 32 + 8 * fq;
#pragma unroll
        for (int ai = 0; ai < 2; ++ai)
#pragma unroll
            for (int m = 0; m < 4; ++m) { const size_t off = (size_t)(row0 + ai * 128 + m * 16) * 1024 + col0;
#pragma unroll
                for (int bj = 0; bj < 2; ++bj) { const u32x4 gw = *(const u32x4*)(gate + off + bj * 128);
                    f32x4 v0 = acc[ai][bj][m][0], v1 = acc[ai][bj][m][1];
                    v0[0] *= bflo(gw.x); v0[1] *= bfhi(gw.x); v0[2] *= bflo(gw.y); v0[3] *= bfhi(gw.y);
                    v1[0] *= bflo(gw.z); v1[1] *= bfhi(gw.z); v1[2] *= bflo(gw.w); v1[3] *= bfhi(gw.w);
                    if (add) { const u32x4 aw = *(const u32x4*)(add + off + bj * 128);
                        v0[0] += bflo(aw.x); v0[1] += bfhi(aw.x); v0[2] += bflo(aw.y); v0[3] += bfhi(aw.y);
                        v1[0] += bflo(aw.z); v1[1] += bfhi(aw.z); v1[2] += bflo(aw.w); v1[3] += bfhi(aw.w); }
                    *(u32x4*)(O + off + bj * 128) = pack8(v0, v1); } }
    }
};
struct EpiOut {
    static constexpr bool PERM = false;
    const float* xin; float* xout; const float* gvec;
    __device__ __forceinline__ void operator()(const AccT& acc, const pg8::Unit& u, int wr, int wc, int fr, int fq) const {
        asm volatile("" : "+v"(fr), "+v"(fq));
        const int row0 = u.pm * 256 + wr * 64 + fr, col0 = u.pn * 256 + wc * 32 + 4 * fq;
        const int b = (u.pm * 256) / SEQ;
        f32x4 gv[2][2];
#pragma unroll
        for (int bj = 0; bj < 2; ++bj)
#pragma unroll
            for (int n = 0; n < 2; ++n) gv[bj][n] = *(const f32x4*)(gvec + (size_t)b * NMOD + col0 + bj * 128 + n * 16);
#pragma unroll
        for (int ai = 0; ai < 2; ++ai)
#pragma unroll
            for (int m = 0; m < 4; ++m) { const size_t off = (size_t)(row0 + ai * 128 + m * 16) * 1024 + col0;
#pragma unroll
                for (int bj = 0; bj < 2; ++bj)
#pragma unroll
                    for (int n = 0; n < 2; ++n) { const f32x4 xi = *(const f32x4*)(xin + off + bj * 128 + n * 16);
                        *(f32x4*)(xout + off + bj * 128 + n * 16) = xi + gv[bj][n] * acc[ai][bj][m][n]; } }
    }
};
struct EpiMoe1 {
    static constexpr bool PERM = true;
    bf16_t* hid; const float* slotw;
    __device__ __forceinline__ void operator()(const AccT& acc, const pg8::Unit& u, int wr, int wc, int fr, int fq) const {
        asm volatile("" : "+v"(fr), "+v"(fq));
        const int row0 = u.pm * 256 + wr * 64 + fr, pnl = u.pn & 3, col0 = 128 * pnl + 16 * wc + 4 * fq;
#pragma unroll
        for (int ai = 0; ai < 2; ++ai)
#pragma unroll
            for (int m = 0; m < 4; ++m) { const int row = row0 + ai * 128 + m * 16; const float cw = slotw[row];
#pragma unroll
                for (int bj = 0; bj < 2; ++bj) { const f32x4 gt = acc[ai][bj][m][0], up = acc[ai][bj][m][1]; f32x4 h;
#pragma unroll
                    for (int i = 0; i < 4; ++i) h[i] = gt[i] * sigmoidf_(gt[i]) * up[i] * cw;
                    u32x2 w; w.x = cvt_pk_bf16(h[0], h[1]); w.y = cvt_pk_bf16(h[2], h[3]);
                    *(u32x2*)(hid + (size_t)row * DEXP + col0 + 64 * bj) = w; } }
    }
};
struct EpiMoe2 {
    static constexpr bool PERM = true;
    bf16_t* y; const int* slotd;
    __device__ __forceinline__ void operator()(const AccT& acc, const pg8::Unit& u, int wr, int wc, int fr, int fq) const {
        asm volatile("" : "+v"(fr), "+v"(fq));
        const int row0 = u.pm * 256 + wr * 64 + fr, col0 = (u.pn & 3) * 256 + wc * 32 + 8 * fq;
#pragma unroll
        for (int ai = 0; ai < 2; ++ai)
#pragma unroll
            for (int m = 0; m < 4; ++m) { const int dst = slotd[row0 + ai * 128 + m * 16];
                if (dst >= 0) { bf16_t* rowp = y + (size_t)dst * 1024 + col0;
#pragma unroll
                    for (int bj = 0; bj < 2; ++bj) *(u32x4*)(rowp + bj * 128) = pack8(acc[ai][bj][m][0], acc[ai][bj][m][1]); } }
    }
};
struct MoeOrder {
    const LAS int* tile_end; int ntiles, G, c;
    __device__ __forceinline__ bool next(int i, pg8::Unit& u) const {
        const int L = i * G + c; if (L >= 4 * ntiles) return false;
        const int rt = L >> 2; int e = 0;
#pragma unroll
        for (int j = 0; j < NE; ++j) e += (rt >= tile_end[j]) ? 1 : 0;
        u.pm = rt; u.pn = __builtin_amdgcn_readfirstlane(e * 4 + (L & 3)); return true;
    }
    __device__ __forceinline__ void a_ready(const pg8::Unit&) const {}
    __device__ __forceinline__ void done(const pg8::Unit&) const {}
};

constexpr int RING_BYTES = 131072, MISC_OFF = 133120, LDS_BYTES = 147456;
struct Args { const float* in[18]; float* out; unsigned char* ws; int ph_lo, ph_hi; };
struct Frame {
    LAS unsigned char* lds; int tid, lane, wave, G, blk;
    float* out; unsigned char* ws; unsigned* ctl;
    __device__ __forceinline__ const float* in(int i) const {
        const LAS unsigned* t = (const LAS unsigned*)(lds + MISC_OFF + 1024) + 2 * i;
        const unsigned lo = __builtin_amdgcn_readfirstlane(t[0]), hi = __builtin_amdgcn_readfirstlane(t[1]);
        return (const float*)(((unsigned long long)hi << 32) | lo);
    }
};
enum { IN_X = 0, IN_C, IN_WADA, IN_BADA, IN_N1G, IN_WIN, IN_QNG, IN_KNG, IN_RELB, IN_WOA, IN_WOB, IN_WOUT, IN_N2G, IN_RW, IN_RB, IN_WG, IN_WU, IN_WDN };

__device__ __forceinline__ int win_src_col(int r) {
    if (r < 1024) return r;
    if (r < 1536) { const int rho = r - 1024, tile = rho >> 8, q = rho & 255, bj = q >> 7, wc = (q >> 5) & 3, j = q & 31; return 1536 + (tile * 4 + wc) * 64 + 32 * bj + j; }
    if (r < 2048) return 2176 + (r - 1536);
    if (r < 2304) { const int q = r - 2048, bj = q >> 7, wc = (q >> 5) & 3, j = q & 31, cs = 32 * bj + j;
        if (wc == 0) return 2048 + cs; if (wc == 1) return 2112 + cs; if (wc == 2) return 2688 + cs; return cs < 8 ? 2752 + cs : -1; }
    if (r < 3328) return 2760 + (r - 2304);
    if (r < 4352) return 3784 + (r - 3328);
    return 1024 + (r - 4352);
}
__device__ __forceinline__ void transpose_item(const float* colp, int ldw, int ksrc0, bf16_t* WT, size_t drow0, int ldk, int kdst0, LAS float* scr, int lane) {
#pragma unroll 8
    for (int i = 0; i < 32; ++i) { const int kk = 2 * i + (lane >> 5); scr[kk * 33 + (lane & 31)] = colp ? colp[(size_t)(ksrc0 + kk) * ldw] : 0.f; }
    LDS_WAIT(); asm volatile("" ::: "memory");
    const int c = lane & 7;
#pragma unroll
    for (int j = 0; j < 4; ++j) { const int n = (lane >> 3) + 8 * j; const LAS float* s = scr + (8 * c) * 33 + n;
        u32x4 o; o.x = pk2(s[0 * 33], s[1 * 33]); o.y = pk2(s[2 * 33], s[3 * 33]); o.z = pk2(s[4 * 33], s[5 * 33]); o.w = pk2(s[6 * 33], s[7 * 33]);
        *(u32x4*)(WT + (drow0 + n) * ldk + kdst0 + 8 * c) = o; }
    LDS_WAIT(); asm volatile("" ::: "memory");
}
constexpr int IT_WIN = 152 * 16, IT_WO = 32 * 16, IT_WOUT = 32 * 16, IT_SMALL = IT_WIN + IT_WO + IT_WOUT;
constexpr int IT_WGU = 16 * 32 * 16, IT_WD = 16 * 32 * 8, IT_EXP = IT_WGU + IT_WD;
__device__ __forceinline__ void convert_small_item(Frame& F, int l, int it, LAS float* scr) {
    const int n31 = F.lane & 31;
    if (it < IT_WIN) { const int rg = it >> 4, kg = it & 15; const int col = win_src_col(rg * 32 + n31);
        transpose_item(col >= 0 ? F.in(IN_WIN) + (size_t)l * DM * NIN + col : nullptr, NIN, kg * 64, (bf16_t*)(F.ws + WS_WIN + l * WIN_LAYER), (size_t)rg * 32, 1024, kg * 64, scr, F.lane); return; }
    it -= IT_WIN;
    if (it < IT_WO) { const int rg = it >> 4, kg = it & 15, k0 = kg * 64; const float* src = (k0 < 512 ? F.in(IN_WOA) : F.in(IN_WOB)) + (size_t)l * 512 * 1024 + rg * 32 + n31;
        transpose_item(src, 1024, k0 & 511, (bf16_t*)(F.ws + WS_WO) + (size_t)l * 1024 * 1024, (size_t)rg * 32, 1024, k0, scr, F.lane); return; }
    it -= IT_WO;
    { const int rg = it >> 4, kg = it & 15; transpose_item(F.in(IN_WOUT) + (size_t)l * 1024 * 1024 + rg * 32 + n31, 1024, kg * 64, (bf16_t*)(F.ws + WS_WOUT) + (size_t)l * 1024 * 1024, (size_t)rg * 32, 1024, kg * 64, scr, F.lane); }
}
__device__ __forceinline__ void convert_expert_item(Frame& F, int l, int it, LAS float* scr) {
    const int n31 = F.lane & 31;
    if (it < IT_WGU) { const int e = it >> 9, r2 = it & 511, rg = r2 >> 4, kg = r2 & 15; const int r = rg * 32 + n31, q = r >> 3, i = r & 7;
        const float* src = (i < 4 ? F.in(IN_WG) : F.in(IN_WU)) + (size_t)(l * NE + e) * DM * DEXP + 4 * q + (i & 3);
        transpose_item(src, DEXP, kg * 64, (bf16_t*)(F.ws + WS_WGU) + (size_t)e * 1024 * 1024, (size_t)rg * 32, 1024, kg * 64, scr, F.lane); return; }
    it -= IT_WGU;
    { const int e = it >> 8, r2 = it & 255, rg = r2 >> 3, kg = r2 & 7;
        transpose_item(F.in(IN_WDN) + (size_t)(l * NE + e) * DEXP * DM + rg * 32 + n31, DM, kg * 64, (bf16_t*)(F.ws + WS_WD) + (size_t)e * 1024 * 512, (size_t)rg * 32, 512, kg * 64, scr, F.lane); }
}

__device__ __forceinline__ void phase_prologue(Frame& F) {
    LAS float* scr = (LAS float*)(F.lds + F.wave * 8448);
    LAS float* sil = (LAS float*)(F.lds + 69632);
    const float* cin = F.in(IN_C); const float* badap = F.in(IN_BADA);
    for (int i = F.tid; i < BATCH * DM; i += NTHR) { const float v = cin[i]; sil[i] = v / (1.f + __expf(-v)); }
    __syncthreads();
    const int gw = F.blk * NWAVES + F.wave, NGW = F.G * NWAVES;
    float* modp = (float*)(F.ws + WS_MODP);
    for (int it = gw; it < 16 * 2 * 96; it += NGW) {
        const int jb = it % 96, l = (it / 96) & 1, kc = it / 192; const int j = jb * 64 + F.lane;
        float a[BATCH];
#pragma unroll
        for (int b = 0; b < BATCH; ++b) a[b] = 0.f;
        const float* wp = F.in(IN_WADA) + ((size_t)l * DM + kc * 64) * NMOD + j;
#pragma unroll 4
        for (int k = 0; k < 64; ++k) { const float w = wp[(size_t)k * NMOD];
#pragma unroll
            for (int b = 0; b < BATCH; ++b) a[b] += sil[b * DM + kc * 64 + k] * w; }
        const float bias = (kc == 0) ? badap[l * NMOD + j] : 0.f;
#pragma unroll
        for (int b = 0; b < BATCH; ++b) modp[(((size_t)kc * 2 + l) * BATCH + b) * NMOD + j] = a[b] + bias;
    }
    for (int it = gw; it < 2 * IT_SMALL; it += NGW) { const int l = it >= IT_SMALL ? 1 : 0; convert_small_item(F, l, it - l * IT_SMALL, scr); }
    for (int it = gw; it < IT_EXP; it += NGW) convert_expert_item(F, 0, it, scr);
}

__device__ __forceinline__ float modsum(const float* modp, int l, int b, int j) {
    float s = 0.f;
#pragma unroll
    for (int kc = 0; kc < 16; ++kc) s += modp[(((size_t)kc * 2 + l) * BATCH + b) * NMOD + j];
    return s;
}
__device__ __forceinline__ void phase_rows(Frame& F, int l, int mode) {
    LAS float* Av = (LAS float*)F.lds; LAS float* Sv = Av + DM; LAS float* Gv = Sv + DM;
    const float* modp = (const float*)(F.ws + WS_MODP);
    float* mod = (float*)(F.ws + WS_MOD);
    const float* n1g = F.in(IN_N1G); const float* xin = F.in(IN_X);
    const int row_base = F.blk * (T / F.G);
    const int b = row_base / SEQ;
    if (mode == 0) {
        const int per = (2 * BATCH * NMOD) / F.G;
        for (int i = F.tid; i < per; i += NTHR) { const int idx = F.blk * per + i; const int ll = idx / (BATCH * NMOD), bb = (idx / NMOD) % BATCH, j = idx % NMOD; mod[idx] = modsum(modp, ll, bb, j); }
    }
    for (int d = F.tid; d < DM; d += NTHR) {
        if (mode != 2) { Av[d] = n1g[l * DM + d] * (1.f + modsum(modp, l, b, 1 * DM + d)); Sv[d] = modsum(modp, l, b, 0 * DM + d); }
        if (mode != 0) Gv[d] = modsum(modp, l - 1, b, 5 * DM + d);
    }
    if (mode == 1) {
        LAS float* scr = (LAS float*)(F.lds + 16384 + F.wave * 8448);
        const int gw = F.blk * NWAVES + F.wave, NGW = F.G * NWAVES;
        for (int it = gw; it < IT_EXP; it += NGW) convert_expert_item(F, l, it, scr);
    }
    __syncthreads();
    const bf16_t* ybuf = (const bf16_t*)(F.ws + WS_Y);
    bf16_t* hb = (bf16_t*)(F.ws + WS_H);
    const int rows_per_wave = (T / F.G) / NWAVES;
    for (int i = 0; i < rows_per_wave; ++i) {
        const int row = row_base + F.wave * rows_per_wave + i;
        f32x4 v[4];
        const float* xr = (mode == 0 ? xin : F.out) + (size_t)row * DM;
#pragma unroll
        for (int j = 0; j < 4; ++j) v[j] = *(const f32x4*)(xr + 4 * F.lane + 256 * j);
        if (mode != 0) {
#pragma unroll
            for (int j = 0; j < 4; ++j) { const int c0 = 4 * F.lane + 256 * j;
                const u32x2 y0 = *(const u32x2*)(ybuf + (size_t)(2 * row) * DM + c0), y1 = *(const u32x2*)(ybuf + (size_t)(2 * row + 1) * DM + c0);
                v[j][0] += Gv[c0 + 0] * (bflo(y0.x) + bflo(y1.x)); v[j][1] += Gv[c0 + 1] * (bfhi(y0.x) + bfhi(y1.x));
                v[j][2] += Gv[c0 + 2] * (bflo(y0.y) + bflo(y1.y)); v[j][3] += Gv[c0 + 3] * (bfhi(y0.y) + bfhi(y1.y));
                *(f32x4*)(F.out + (size_t)row * DM + c0) = v[j]; }
        }
        if (mode != 2) {
            float ss = 0.f;
#pragma unroll
            for (int j = 0; j < 4; ++j) ss += (v[j][0] * v[j][0] + v[j][1] * v[j][1]) + (v[j][2] * v[j][2] + v[j][3] * v[j][3]);
            const float r = 1.0f / sqrtf(wave_sum(ss) * (1.0f / DM) + EPS);
#pragma unroll
            for (int j = 0; j < 4; ++j) { const int c0 = 4 * F.lane + 256 * j; u32x2 w;
                w.x = pk2(v[j][0] * r * Av[c0] + Sv[c0], v[j][1] * r * Av[c0 + 1] + Sv[c0 + 1]);
                w.y = pk2(v[j][2] * r * Av[c0 + 2] + Sv[c0 + 2], v[j][3] * r * Av[c0 + 3] + Sv[c0 + 3]);
                *(u32x2*)(hb + (size_t)row * DM + c0) = w; }
        }
    }
}

typedef float f32x16 __attribute__((ext_vector_type(16)));
__device__ __forceinline__ bf16x8 pack_bf16x8(float a0, float a1, float a2, float a3, float a4, float a5, float a6, float a7) {
    u32x4 w; w.x = cvt_pk_bf16(a0, a1); w.y = cvt_pk_bf16(a2, a3); w.z = cvt_pk_bf16(a4, a5); w.w = cvt_pk_bf16(a6, a7); return __builtin_bit_cast(bf16x8, w);
}
__device__ __forceinline__ void phase_sb(Frame& F) {
    const bf16_t* qa = (const bf16_t*)(F.ws + WS_QA); const bf16_t* ka = (const bf16_t*)(F.ws + WS_KA); const bf16_t* vaT = (const bf16_t*)(F.ws + WS_VAT);
    bf16_t* oab = (bf16_t*)(F.ws + WS_OAB);
    const int lane = F.lane, q32 = lane & 31, hi = lane >> 5;
    const int NGW = F.G * NWAVES;
    for (int wu = F.blk * NWAVES + F.wave; wu < BATCH * 8 * 64; wu += NGW) {
        const int qblk = wu & 63, bh = wu >> 6, b = bh >> 3, h = bh & 7;
        const int qw = qblk * 32, t = qw + q32;
        const size_t rowb = (size_t)b * SEQ;
        bf16x8 qf[4];
#pragma unroll
        for (int ks = 0; ks < 4; ++ks) qf[ks] = *(const bf16x8*)(qa + (rowb + t) * 512 + h * 64 + 16 * ks + 8 * hi);
        f32x16 o0, o1;
#pragma unroll
        for (int r = 0; r < 16; ++r) { o0[r] = 0.f; o1[r] = 0.f; }
        float R = 0.f;
        for (int kb = qw; kb >= 0; kb -= 32) {
            const bf16_t* kp = ka + (rowb + kb + q32) * 512 + h * 64 + 8 * hi;
            bf16x8 kf[4];
#pragma unroll
            for (int ks = 0; ks < 4; ++ks) kf[ks] = *(const bf16x8*)(kp + 16 * ks);
            const bf16_t* vp = vaT + (size_t)(h * 64 + q32) * T + rowb + kb + 4 * hi;
            u32x2 vv[2][2][2];
#pragma unroll
            for (int dt = 0; dt < 2; ++dt)
#pragma unroll
                for (int sx = 0; sx < 2; ++sx)
#pragma unroll
                    for (int hf = 0; hf < 2; ++hf) vv[dt][sx][hf] = *(const u32x2*)(vp + (size_t)dt * 32 * T + 16 * sx + 8 * hf);
            f32x16 z;
#pragma unroll
            for (int r = 0; r < 16; ++r) z[r] = 0.f;
#pragma unroll
            for (int ks = 0; ks < 4; ++ks) z = __builtin_amdgcn_mfma_f32_32x32x16_bf16(kf[ks], qf[ks], z, 0, 0, 0);
            float lv[16], zs[16]; bool vl[16];
#pragma unroll
            for (int r = 0; r < 16; ++r) { const float zz = z[r]; const float sp = fmaxf(zz, 0.f) + __logf(1.f + __expf(-fabsf(zz)));
                vl[r] = (kb + (r & 3) + 8 * (r >> 2) + 4 * hi) < t; lv[r] = vl[r] ? -sp : 0.f; zs[r] = zz - sp; }
            float gs[4], pg[4], tl[4];
#pragma unroll
            for (int k = 0; k < 4; ++k) { gs[k] = (lv[4 * k] + lv[4 * k + 1]) + (lv[4 * k + 2] + lv[4 * k + 3]); pg[k] = __shfl_xor(gs[k], 32); }
            tl[3] = 0.f; tl[2] = gs[3] + pg[3]; tl[1] = tl[2] + (gs[2] + pg[2]); tl[0] = tl[1] + (gs[1] + pg[1]);
            const float tot = tl[0] + (gs[0] + pg[0]);
            float av[16];
#pragma unroll
            for (int k = 0; k < 4; ++k) { const float base = R + tl[k] + (hi == 0 ? pg[k] : 0.f);
                const float s3 = base, s2 = s3 + lv[4 * k + 3], s1 = s2 + lv[4 * k + 2], s0 = s1 + lv[4 * k + 1];
                av[4 * k + 0] = vl[4 * k + 0] ? __expf(zs[4 * k + 0] + s0) : 0.f; av[4 * k + 1] = vl[4 * k + 1] ? __expf(zs[4 * k + 1] + s1) : 0.f;
                av[4 * k + 2] = vl[4 * k + 2] ? __expf(zs[4 * k + 2] + s2) : 0.f; av[4 * k + 3] = vl[4 * k + 3] ? __expf(zs[4 * k + 3] + s3) : 0.f; }
            R += tot;
            const bf16x8 pf0 = pack_bf16x8(av[0], av[1], av[2], av[3], av[4], av[5], av[6], av[7]);
            const bf16x8 pf1 = pack_bf16x8(av[8], av[9], av[10], av[11], av[12], av[13], av[14], av[15]);
#define SB_VF(dt, sx) __builtin_bit_cast(bf16x8, (u32x4){vv[dt][sx][0].x, vv[dt][sx][0].y, vv[dt][sx][1].x, vv[dt][sx][1].y})
            o0 = __builtin_amdgcn_mfma_f32_32x32x16_bf16(SB_VF(0, 0), pf0, o0, 0, 0, 0);
            o0 = __builtin_amdgcn_mfma_f32_32x32x16_bf16(SB_VF(0, 1), pf1, o0, 0, 0, 0);
            o1 = __builtin_amdgcn_mfma_f32_32x32x16_bf16(SB_VF(1, 0), pf0, o1, 0, 0, 0);
            o1 = __builtin_amdgcn_mfma_f32_32x32x16_bf16(SB_VF(1, 1), pf1, o1, 0, 0, 0);
#undef SB_VF
            if (__all(R <= -104.f)) break;
        }
        bf16_t* op = oab + (rowb + t) * 1024 + h * 64 + 4 * hi;
#pragma unroll
        for (int k = 0; k < 4; ++k) { u32x2 w0, w1; w0.x = cvt_pk_bf16(o0[4 * k], o0[4 * k + 1]); w0.y = cvt_pk_bf16(o0[4 * k + 2], o0[4 * k + 3]);
            w1.x = cvt_pk_bf16(o1[4 * k], o1[4 * k + 1]); w1.y = cvt_pk_bf16(o1[4 * k + 2], o1[4 * k + 3]);
            *(u32x2*)(op + 8 * k) = w0; *(u32x2*)(op + 32 + 8 * k) = w1; }
    }
}

__device__ __forceinline__ unsigned sortable(float f) { const unsigned u = __builtin_bit_cast(unsigned, f); return (u & 0x80000000u) ? ~u : (u | 0x80000000u); }
__device__ __forceinline__ int wave_total(int v) {
    v += __builtin_amdgcn_update_dpp(0, v, 0xB1, 0xf, 0xf, true);
    v += __builtin_amdgcn_update_dpp(0, v, 0x4E, 0xf, 0xf, true);
    v += __builtin_amdgcn_update_dpp(0, v, 0x141, 0xf, 0xf, true);
    v += __builtin_amdgcn_update_dpp(0, v, 0x140, 0xf, 0xf, true);
    return __builtin_amdgcn_readlane(v, 0) + __builtin_amdgcn_readlane(v, 16) + __builtin_amdgcn_readlane(v, 32) + __builtin_amdgcn_readlane(v, 48);
}
__device__ __forceinline__ void topk_emit(const unsigned (&key)[32], unsigned thr, LAS unsigned* maskrow, int lane) {
    int cg = 0, ce = 0;
#pragma unroll
    for (int j = 0; j < 32; ++j) { cg += (key[j] > thr) ? 1 : 0; ce += (key[j] == thr) ? 1 : 0; }
    const int need = 256 - wave_total(cg), neq = wave_total(ce);
    unsigned myword = 0u;
    if (neq <= need) {
#pragma unroll
        for (int j = 0; j < 32; ++j) { const unsigned long long sel = __ballot(key[j] >= thr);
            if (lane == 2 * j) myword = (unsigned)sel;
            if (lane == 2 * j + 1) myword = (unsigned)(sel >> 32); }
    } else {
        int run = 0; const unsigned long long lt = (1ull << lane) - 1ull;
#pragma unroll
        for (int j = 0; j < 32; ++j) {
            const unsigned long long eq = __ballot(key[j] == thr), gt = __ballot(key[j] > thr);
            const bool tie_sel = (key[j] == thr) && (run + __popcll(eq & lt) < need);
            const unsigned long long sel = gt | __ballot(tie_sel);
            run += __popcll(eq);
            if (lane == 2 * j) myword = (unsigned)sel;
            if (lane == 2 * j + 1) myword = (unsigned)(sel >> 32);
        }
    }
    maskrow[lane] = myword;
}
__device__ __forceinline__ void topk_select2(const unsigned (&ka)[32], const unsigned (&kb)[32], LAS unsigned* maska, LAS unsigned* maskb, int lane) {
    unsigned ta = 0u, tb = 0u;
    for (int bit = 31; bit >= 0; --bit) {
        const unsigned ca = ta | (1u << bit), cb = tb | (1u << bit); int na = 0, nb = 0;
#pragma unroll
        for (int j = 0; j < 32; ++j) { na += (ka[j] >= ca) ? 1 : 0; nb += (kb[j] >= cb) ? 1 : 0; }
        if (wave_total(na) >= 256) ta = ca;
        if (wave_total(nb) >= 256) tb = cb;
    }
    topk_emit(ka, ta, maska, lane); topk_emit(kb, tb, maskb, lane);
}
__device__ __forceinline__ int t5_bucket(int d) {
    if (d < 16) return d;
    int bkt = 16;
    bkt += (d >= 19); bkt += (d >= 21); bkt += (d >= 24); bkt += (d >= 27); bkt += (d >= 31); bkt += (d >= 35); bkt += (d >= 40); bkt += (d >= 46);
    bkt += (d >= 52); bkt += (d >= 59); bkt += (d >= 67); bkt += (d >= 77); bkt += (d >= 87); bkt += (d >= 99); bkt += (d >= 113);
    return bkt;
}
constexpr int SC_STRIDE = 2052;
__device__ __forceinline__ void phase_strip(Frame& F, int l) {
    LAS unsigned* SCB = (LAS unsigned*)F.lds;
    LAS unsigned* MSK = (LAS unsigned*)(F.lds + MISC_OFF + 2048);
    LAS float* LUT = (LAS float*)(F.lds + MISC_OFF + 2048 + 4096);
    LAS float* MB = (LAS float*)(F.lds + MISC_OFF + 2048 + 4096 + 3712);
    const bf16_t* qi = (const bf16_t*)(F.ws + WS_QI); const bf16_t* ki = (const bf16_t*)(F.ws + WS_KI); const float* wi = (const float*)(F.ws + WS_WI);
    const bf16_t* qb = (const bf16_t*)(F.ws + WS_QB); const bf16_t* kbp = (const bf16_t*)(F.ws + WS_KB); const bf16_t* vbT = (const bf16_t*)(F.ws + WS_VBT);
    bf16_t* oab = (bf16_t*)(F.ws + WS_OAB);
    const float* relb = F.in(IN_RELB);
    for (int i = F.tid; i < 8 * 114; i += NTHR) { const int h = i / 114, d = i % 114; LUT[i] = relb[t5_bucket(d) * 8 + h]; }
    if (F.tid < 8) { const float* qg = F.in(IN_QNG) + l * 64; const float* kg = F.in(IN_KNG) + l * 64; float gq = 0.f, gk = 0.f, bm = -1e30f;
        for (int d = 0; d < 64; ++d) { gq = fmaxf(gq, fabsf(qg[d])); gk = fmaxf(gk, fabsf(kg[d])); }
        for (int k = 0; k < 32; ++k) bm = fmaxf(bm, relb[k * 8 + F.tid]);
        MB[F.tid] = 8.1f * gq * gk + bm; }
    __syncthreads();
    const int w = F.wave;
    for (int vc = F.blk; vc < 256; vc += F.G) {
        const int b = vc & 7, jj = vc >> 3; const size_t rowb = (size_t)b * SEQ;
        for (int it = 0; it < 4; ++it) {
            int lane = F.lane; asm volatile("" : "+v"(lane)); const int q = lane & 15, g = lane >> 4;
            const int si = it == 0 ? jj : (it == 1 ? 63 - jj : (it == 2 ? 64 + jj : 127 - jj)); const int t0 = 16 * si;
            if (si < 16) {
                for (int idx = F.tid; idx < 16 * 64; idx += NTHR) { const int nb = t0 + (idx >> 6) + 1 - 32 * (idx & 63); MSK[idx] = nb >= 32 ? 0xffffffffu : (nb <= 0 ? 0u : ((1u << nb) - 1u)); }
            } else {
                bf16x8 qif[8][2]; float wq[8];
#pragma unroll
                for (int h = 0; h < 8; ++h) { wq[h] = wi[(rowb + t0 + q) * 8 + h];
#pragma unroll
                    for (int ks = 0; ks < 2; ++ks) qif[h][ks] = *(const bf16x8*)(qi + (rowb + t0 + q) * 512 + h * 64 + 32 * ks + 8 * g); }
                const bf16_t* kpb = ki + (rowb + 16 * w + q) * 64 + 8 * g;
                const int ntw = (si - w) / 8 + 1;
                bf16x8 ka0, ka1, kb0, kb1, kc0, kc1;
#define IDX_LOAD(K0, K1, n) do { K0 = *(const bf16x8*)(kpb + (size_t)(128 * (n)) * 64); K1 = *(const bf16x8*)(kpb + (size_t)(128 * (n)) * 64 + 32); } while (0)
#define IDX_TILE(K0, K1, n) do { const bf16x8 kf0 = K0, kf1 = K1; const int kt = w + 8 * (n); if ((n) + 3 < ntw) IDX_LOAD(K0, K1, (n) + 3); \
                    f32x4 sc = (f32x4){0.f, 0.f, 0.f, 0.f}; \
                    _Pragma("unroll") for (int h = 0; h < 8; ++h) { f32x4 d = __builtin_amdgcn_mfma_f32_16x16x32_bf16(kf0, qif[h][0], (f32x4){0.f, 0.f, 0.f, 0.f}, 0, 0, 0); \
                        d = __builtin_amdgcn_mfma_f32_16x16x32_bf16(kf1, qif[h][1], d, 0, 0, 0); \
                        _Pragma("unroll") for (int i = 0; i < 4; ++i) sc[i] += wq[h] * fmaxf(d[i], 0.f); } \
                    u32x4 key; \
                    _Pragma("unroll") for (int i = 0; i < 4; ++i) key[i] = (16 * kt + 4 * g + i <= t0 + q) ? sortable(sc[i] + 0.f) : 0u; \
                    *(LAS u32x4*)(SCB + q * SC_STRIDE + 16 * kt + 4 * g) = key; } while (0)
                IDX_LOAD(ka0, ka1, 0); if (1 < ntw) IDX_LOAD(kb0, kb1, 1); if (2 < ntw) IDX_LOAD(kc0, kc1, 2);
                for (int n = 0; n < ntw; n += 3) { IDX_TILE(ka0, ka1, n); if (n + 1 < ntw) IDX_TILE(kb0, kb1, n + 1); if (n + 2 < ntw) IDX_TILE(kc0, kc1, n + 2); }
#undef IDX_LOAD
#undef IDX_TILE
                __syncthreads();
                const int nk = 16 * (si + 1);
                { unsigned kA[32], kB[32];
#pragma unroll
                    for (int j = 0; j < 32; ++j) { const int sx = lane + 64 * j; kA[j] = (sx < nk) ? SCB[(2 * w) * SC_STRIDE + sx] : 0u; kB[j] = (sx < nk) ? SCB[(2 * w + 1) * SC_STRIDE + sx] : 0u; }
                    topk_select2(kA, kB, MSK + (2 * w) * 64, MSK + (2 * w + 1) * 64, lane); }
            }
            __syncthreads();
            {
                const int h = w, t = t0 + q;
                bf16x8 qf[2];
#pragma unroll
                for (int ks = 0; ks < 2; ++ks) qf[ks] = *(const bf16x8*)(qb + (rowb + t) * 512 + h * 64 + 32 * ks + 8 * g);
                f32x4 o[4];
#pragma unroll
                for (int dt = 0; dt < 4; ++dt) o[dt] = (f32x4){0.f, 0.f, 0.f, 0.f};
                float l = 0.f;
                const float mb = MB[h], cfar = LUT[h * 114 + 113] - mb;
                const int nch = (t0 + 15) / 32 + 1, nst = (t0 + 15) / 128 + 1;
                constexpr int STG = 35840, VOFF = 18432;
                const bf16_t* gk0 = kbp + (rowb + (F.tid >> 3)) * 64 + 8 * (F.tid & 7);
                const bf16_t* gv0 = vbT + (size_t)(F.tid >> 4) * T + rowb + 8 * (F.tid & 15);
                const int dk0 = (F.tid >> 3) * 144 + (F.tid & 7) * 16, dv0 = VOFF + (F.tid >> 4) * 272 + (F.tid & 15) * 16;
                u32x4 ra[4], rb4[4];
#define DSA_LOAD(R, st) do { R[0] = *(const u32x4*)(gk0 + (size_t)(128 * (st)) * 64); R[1] = *(const u32x4*)(gk0 + (size_t)(128 * (st) + 64) * 64); \
                    R[2] = *(const u32x4*)(gv0 + 128 * (st)); R[3] = *(const u32x4*)(gv0 + (size_t)32 * T + 128 * (st)); } while (0)
#define DSA_PUT(R, st) do { LAS unsigned char* sp_ = F.lds + ((st) % 3) * STG; *(LAS u32x4*)(sp_ + dk0) = R[0]; *(LAS u32x4*)(sp_ + dk0 + 64 * 144) = R[1]; \
                    *(LAS u32x4*)(sp_ + dv0) = R[2]; *(LAS u32x4*)(sp_ + dv0 + 32 * 272) = R[3]; } while (0)
                DSA_LOAD(ra, 0); if (nst > 1) DSA_LOAD(rb4, 1);
                DSA_PUT(ra, 0); if (nst > 2) DSA_LOAD(ra, 2);
                asm volatile("s_waitcnt lgkmcnt(0)" ::: "memory"); __builtin_amdgcn_s_barrier(); asm volatile("" ::: "memory");
#define DSA_STAGE(st, RN) do { \
                    if ((st) + 1 < nst) { DSA_PUT(RN, (st) + 1); if ((st) + 3 < nst) DSA_LOAD(RN, (st) + 3); } \
                    const LAS unsigned char* stg = F.lds + ((st) % 3) * STG; \
                    _Pragma("unroll") for (int cc = 0; cc < 4; ++cc) { const int c = 4 * (st) + cc; if (c < nch) { \
                        bf16x8 kf[2][2]; u32x2 vf[4][2]; \
                        _Pragma("unroll") for (int tl = 0; tl < 2; ++tl) _Pragma("unroll") for (int ks = 0; ks < 2; ++ks) kf[tl][ks] = *(const LAS bf16x8*)(stg + (32 * cc + 16 * tl + q) * 144 + 16 * g + 64 * ks); \
                        _Pragma("unroll") for (int dt = 0; dt < 4; ++dt) _Pragma("unroll") for (int hf = 0; hf < 2; ++hf) vf[dt][hf] = *(const LAS u32x2*)(stg + VOFF + (16 * dt + q) * 272 + 64 * cc + 8 * g + 32 * hf); \
                        const unsigned mw = MSK[q * 64 + c]; \
                        const bool farc = (t0 - (32 * c + 31)) >= 113; \
                        const float ci = farc ? cfar : -mb; \
                        f32x4 s0 = __builtin_amdgcn_mfma_f32_16x16x32_bf16(kf[0][0], qf[0], (f32x4){ci, ci, ci, ci}, 0, 0, 0); \
                        s0 = __builtin_amdgcn_mfma_f32_16x16x32_bf16(kf[0][1], qf[1], s0, 0, 0, 0); \
                        f32x4 s1 = __builtin_amdgcn_mfma_f32_16x16x32_bf16(kf[1][0], qf[0], (f32x4){ci, ci, ci, ci}, 0, 0, 0); \
                        s1 = __builtin_amdgcn_mfma_f32_16x16x32_bf16(kf[1][1], qf[1], s1, 0, 0, 0); \
                        if (!farc) { \
                            _Pragma("unroll") for (int i = 0; i < 4; ++i) { const int k0 = 32 * c + 4 * g + i, k1 = k0 + 16; \
                                int d0 = t - k0, d1 = t - k1; d0 = d0 < 0 ? 0 : (d0 > 113 ? 113 : d0); d1 = d1 < 0 ? 0 : (d1 > 113 ? 113 : d1); \
                                s0[i] += LUT[h * 114 + d0]; s1[i] += LUT[h * 114 + d1]; } } \
                        float p[8]; \
                        _Pragma("unroll") for (int i = 0; i < 4; ++i) { p[i] = ((mw >> (4 * g + i)) & 1u) ? __expf(s0[i]) : 0.f; p[4 + i] = ((mw >> (16 + 4 * g + i)) & 1u) ? __expf(s1[i]) : 0.f; } \
                        l += ((p[0] + p[1]) + (p[2] + p[3])) + ((p[4] + p[5]) + (p[6] + p[7])); \
                        const bf16x8 pf = pack_bf16x8(p[0], p[1], p[2], p[3], p[4], p[5], p[6], p[7]); \
                        _Pragma("unroll") for (int dt = 0; dt < 4; ++dt) { \
                            const bf16x8 vfr = __builtin_bit_cast(bf16x8, (u32x4){vf[dt][0].x, vf[dt][0].y, vf[dt][1].x, vf[dt][1].y}); \
                            o[dt] = __builtin_amdgcn_mfma_f32_16x16x32_bf16(vfr, pf, o[dt], 0, 0, 0); } } } \
                    asm volatile("s_waitcnt lgkmcnt(0)" ::: "memory"); __builtin_amdgcn_s_barrier(); asm volatile("" ::: "memory"); } while (0)
                for (int st = 0; st < nst; st += 2) { DSA_STAGE(st, rb4); if (st + 1 < nst) DSA_STAGE(st + 1, ra); }
#undef DSA_STAGE
#undef DSA_LOAD
#undef DSA_PUT
                l += __shfl_xor(l, 16); l += __shfl_xor(l, 32);
                const float il = 1.f / l;
                bf16_t* op = oab + (rowb + t) * 1024 + 512 + h * 64 + 4 * g;
#pragma unroll
                for (int dt = 0; dt < 4; ++dt) { u32x2 wv; wv.x = cvt_pk_bf16(o[dt][0] * il, o[dt][1] * il); wv.y = cvt_pk_bf16(o[dt][2] * il, o[dt][3] * il); *(u32x2*)(op + 16 * dt) = wv; }
            }
            __syncthreads();
        }
    }
}

__device__ __forceinline__ void phase_h2_route(Frame& F, int l) {
    LAS float* Av = (LAS float*)F.lds; LAS float* Sv = Av + DM;
    LAS float* RW = (LAS float*)(F.lds + 8192);
    LAS float* RB = (LAS float*)(F.lds + 73728);
    LAS int* lcnt = (LAS int*)(F.lds + 73728 + 64);
    LAS int* lbase = (LAS int*)(F.lds + 73728 + 128);
    LAS int* rinfo = (LAS int*)(F.lds + 73728 + 256);
    const float* mod = (const float*)(F.ws + WS_MOD) + (size_t)l * BATCH * NMOD;
    const int rows_per_blk = T / F.G, row_base = F.blk * rows_per_blk, b = row_base / SEQ;
    const float* n2g = F.in(IN_N2G); const float* rwp = F.in(IN_RW); const float* rbp = F.in(IN_RB);
    for (int d = F.tid; d < DM; d += NTHR) { Av[d] = n2g[l * DM + d] * (1.f + mod[(size_t)b * NMOD + 4 * DM + d]); Sv[d] = mod[(size_t)b * NMOD + 3 * DM + d]; }
    for (int i = F.tid; i < DM * NE; i += NTHR) RW[(i & 15) * DM + (i >> 4)] = rwp[i];
    if (F.tid < NE) { RB[F.tid] = rbp[F.tid]; lcnt[F.tid] = 0; }
    __syncthreads();
    bf16_t* hb = (bf16_t*)(F.ws + WS_H);
    const int rows_per_wave = rows_per_blk / NWAVES;
    for (int i = 0; i < rows_per_wave; ++i) {
        const int lr = F.wave * rows_per_wave + i, row = row_base + lr;
        f32x4 v[4]; float ss = 0.f;
#pragma unroll
        for (int j = 0; j < 4; ++j) { v[j] = *(const f32x4*)(F.out + (size_t)row * DM + 4 * F.lane + 256 * j); ss += (v[j][0] * v[j][0] + v[j][1] * v[j][1]) + (v[j][2] * v[j][2] + v[j][3] * v[j][3]); }
        const float r = 1.0f / sqrtf(wave_sum(ss) * (1.0f / DM) + EPS);
        float lg[NE];
#pragma unroll
        for (int e = 0; e < NE; ++e) lg[e] = 0.f;
#pragma unroll
        for (int j = 0; j < 4; ++j) { const int c0 = 4 * F.lane + 256 * j; u32x2 w;
#pragma unroll
            for (int k = 0; k < 4; ++k) v[j][k] = v[j][k] * r * Av[c0 + k] + Sv[c0 + k];
#pragma unroll
            for (int e = 0; e < NE; ++e) { const f32x4 rw = *(const LAS f32x4*)(RW + e * DM + c0);
                lg[e] += (v[j][0] * rw[0] + v[j][1] * rw[1]) + (v[j][2] * rw[2] + v[j][3] * rw[3]); }
            w.x = pk2(v[j][0], v[j][1]); w.y = pk2(v[j][2], v[j][3]);
            *(u32x2*)(hb + (size_t)row * DM + c0) = w; }
        float mxl = -1e30f;
#pragma unroll
        for (int e = 0; e < NE; ++e) { lg[e] = wave_sum(lg[e]) + RB[e]; mxl = fmaxf(mxl, lg[e]); }
        float pr[NE], den = 0.f;
#pragma unroll
        for (int e = 0; e < NE; ++e) { pr[e] = expf(lg[e] - mxl); den += pr[e]; }
        const float iden = 1.f / den;
#pragma unroll
        for (int e = 0; e < NE; ++e) pr[e] *= iden;
        int bg = 0; float bs = -1.f, bv0 = 0.f, bv1 = 0.f; int bi0 = 0, bi1 = 1;
#pragma unroll
        for (int g = 0; g < 4; ++g) {
            float v0 = pr[4 * g], v1 = -1.f; int i0 = 0, i1 = -1;
#pragma unroll
            for (int k = 1; k < 4; ++k) { const float p = pr[4 * g + k];
                if (p > v0) { v1 = v0; i1 = i0; v0 = p; i0 = k; } else if (p > v1) { v1 = p; i1 = k; } }
            const float gs = v0 + v1;
            if (gs > bs) { bs = gs; bg = g; bv0 = v0; bv1 = v1; bi0 = i0; bi1 = i1; }
        }
        const int e0 = bg * 4 + bi0, e1 = bg * 4 + bi1; const float wsum = bv0 + bv1, w0 = bv0 / wsum, w1 = bv1 / wsum;
        if (F.lane == 0) { const int p0 = __hip_atomic_fetch_add(lcnt + e0, 1, __ATOMIC_RELAXED, __HIP_MEMORY_SCOPE_WORKGROUP), p1 = __hip_atomic_fetch_add(lcnt + e1, 1, __ATOMIC_RELAXED, __HIP_MEMORY_SCOPE_WORKGROUP);
            rinfo[lr * 6 + 0] = e0; rinfo[lr * 6 + 1] = p0; rinfo[lr * 6 + 2] = __float_as_int(w0); rinfo[lr * 6 + 3] = e1; rinfo[lr * 6 + 4] = p1; rinfo[lr * 6 + 5] = __float_as_int(w1); }
    }
    __syncthreads();
    unsigned* gcnt = F.ctl + CW_GCNT + 64 * l;
    if (F.tid < NE) lbase[F.tid] = (int)__hip_atomic_fetch_add(gcnt + F.tid, (unsigned)lcnt[F.tid], RLX_AGENT);
    __syncthreads();
    int* etok = (int*)(F.ws + WS_ETOK); float* ew = (float*)(F.ws + WS_EW); int* edst = (int*)(F.ws + WS_EDST);
    if (F.tid < 2 * rows_per_blk) { const int lr = F.tid >> 1, k = F.tid & 1; const int e = rinfo[lr * 6 + 3 * k], p = rinfo[lr * 6 + 3 * k + 1]; const float w = __int_as_float(rinfo[lr * 6 + 3 * k + 2]);
        const int slot = lbase[e] + p, tok = row_base + lr;
        etok[e * T + slot] = tok; ew[e * T + slot] = w; edst[e * T + slot] = 2 * tok + k; }
}

__device__ __forceinline__ int moe_table(Frame& F, int l, LAS int* tile_end) {
    if (F.tid < 64) { const int e = F.lane & 15; const int n = (int)__hip_atomic_load(F.ctl + CW_GCNT + 64 * l + e, RLX_AGENT); int tiles = (n + 255) >> 8, cum = tiles;
#pragma unroll
        for (int o = 1; o < 16; o <<= 1) { const int v = __shfl_up(cum, o, 16); if (e >= o) cum += v; }
        if (F.lane < 16) { tile_end[e] = cum; tile_end[16 + e] = n; } }
    __syncthreads();
    return tile_end[15];
}
__device__ __forceinline__ void phase_gather(Frame& F, int l) {
    LAS int* tile_end = (LAS int*)(F.lds + MISC_OFF + 512);
    const int ntiles = moe_table(F, l, tile_end);
    const int* etok = (const int*)(F.ws + WS_ETOK); const float* ew = (const float*)(F.ws + WS_EW); const int* edst = (const int*)(F.ws + WS_EDST);
    float* slotw = (float*)(F.ws + WS_SLOTW); int* slotd = (int*)(F.ws + WS_SLOTD);
    const bf16_t* hb = (const bf16_t*)(F.ws + WS_H); bf16_t* xg = (bf16_t*)(F.ws + WS_XG);
    const int NGW = F.G * NWAVES;
    for (int p = F.blk * NWAVES + F.wave; p < ntiles * 256; p += NGW) {
        const int rt = p >> 8; int e = 0;
#pragma unroll
        for (int j = 0; j < NE; ++j) e += (rt >= tile_end[j]) ? 1 : 0;
        const int rbase = (e == 0 ? 0 : tile_end[e - 1]) * 256, idx = p - rbase, n = tile_end[16 + e];
        u32x4 a = (u32x4){0u, 0u, 0u, 0u}, c = a;
        if (idx < n) { const int tok = etok[e * T + idx]; const u32x4* src = (const u32x4*)(hb + (size_t)tok * DM); a = src[F.lane]; c = src[64 + F.lane];
            if (F.lane == 0) { slotw[p] = ew[e * T + idx]; slotd[p] = edst[e * T + idx]; } }
        else if (F.lane == 0) { slotw[p] = 0.f; slotd[p] = -1; }
        u32x4* dst = (u32x4*)(xg + (size_t)p * DM); dst[F.lane] = a; dst[64 + F.lane] = c;
    }
}

#define XB_TMO      128
#define XB_XCNT(j)  (256  + 64 * (j))
#define XB_XSUB(j)  (1280 + 64 * (j))
#define XB_XGEN(j)  (2304 + 64 * (j))
#define XB_TOP      3328
#define XB_TOPGEN   3392
#define XCD_BAR_WORDS 3456
#define XB_SPIN_CAP (1u << 20)
__device__ __forceinline__ unsigned xb_ld(unsigned* p)              { return __hip_atomic_load(p, __ATOMIC_RELAXED, __HIP_MEMORY_SCOPE_AGENT); }
__device__ __forceinline__ unsigned xb_add(unsigned* p, unsigned v) { return __hip_atomic_fetch_add(p, v, __ATOMIC_RELAXED, __HIP_MEMORY_SCOPE_AGENT); }
__device__ __forceinline__ unsigned xb_xcc_id() { return (unsigned)__builtin_amdgcn_s_getreg((3 << 11) | 20) & 0xFu; }
#define XB_SPIN(cond, bar) do { unsigned _sp = 0; while (cond) { __builtin_amdgcn_s_sleep(1); \
    if ((++_sp & 255u) == 0u) { if (xb_ld(&(bar)[XB_TMO])) break; if (_sp > XB_SPIN_CAP) { atomicAdd(&(bar)[XB_TMO], 1u); break; } } } } while (0)
struct XcdBarrier { unsigned* bar; unsigned x; volatile LAS unsigned* st; };
__device__ __forceinline__ XcdBarrier xcd_barrier_post(unsigned* bar, volatile LAS unsigned* st) {
    XcdBarrier b; b.bar = bar; b.x = xb_xcc_id(); b.st = st;
    if (threadIdx.x == 0) (void)xb_add(&bar[XB_XCNT(b.x)], 1u);
    return b;
}
__device__ __forceinline__ void xcd_barrier_complete(unsigned* bar, unsigned x, unsigned& nloc, unsigned& nx) {
    const unsigned G = gridDim.x * gridDim.y * gridDim.z;
    unsigned sum, cnt, mine, sp = 0u;
    for (;;) {
        sum = 0u; cnt = 0u; mine = 0u;
#pragma unroll
        for (unsigned j = 0; j < 16; ++j) { const unsigned c = xb_ld(&bar[XB_XCNT(j)]); sum += c; cnt += (c > 0u) ? 1u : 0u; mine = (j == x) ? c : mine; }
        if (sum == G) break;
        __builtin_amdgcn_s_sleep(1);
        if ((++sp & 255u) == 0u) { if (xb_ld(&bar[XB_TMO])) break; if (sp > XB_SPIN_CAP) { atomicAdd(&bar[XB_TMO], 1u); break; } }
    }
    nloc = mine > 0u ? mine : 1u; nx = cnt > 0u ? cnt : 1u;
}
__device__ __forceinline__ void xcd_barrier(const XcdBarrier& b) {
    asm volatile("s_waitcnt vmcnt(0)" ::: "memory");
    __syncthreads();
    if (threadIdx.x == 0) {
        unsigned* bar = b.bar;
        __builtin_amdgcn_s_waitcnt(0);
        unsigned nloc = b.st[0], nx = b.st[1];
        if (nloc == 0u) { xcd_barrier_complete(bar, b.x, nloc, nx); b.st[0] = nloc; b.st[1] = nx; }
        const unsigned old = xb_add(&bar[XB_XSUB(b.x)], 1u);
        const unsigned gen = old / nloc;
        if (old + 1u == (gen + 1u) * nloc) {
            __builtin_amdgcn_fence(__ATOMIC_RELEASE, "agent");
            asm volatile("s_waitcnt vmcnt(0)" ::: "memory");
            const unsigned og = xb_add(&bar[XB_TOP], 1u);
            const unsigned tg = og / nx;
            if (og + 1u == (tg + 1u) * nx) xb_add(&bar[XB_TOPGEN], 1u);
            else XB_SPIN(xb_ld(&bar[XB_TOPGEN]) == tg, bar);
            __builtin_amdgcn_fence(__ATOMIC_ACQUIRE, "agent");
            xb_add(&bar[XB_XGEN(b.x)], 1u);
            asm volatile("s_waitcnt vmcnt(0)" ::: "memory");
        } else {
            XB_SPIN(xb_ld(&bar[XB_XGEN(b.x)]) == gen, bar);
            __builtin_amdgcn_fence(__ATOMIC_ACQUIRE, "agent");
            asm volatile("s_waitcnt vmcnt(0)" ::: "memory");
        }
    }
    __syncthreads();
}

constexpr int PH_PER_LAYER = 9, PH_FINAL = 1 + PH_PER_LAYER * DEPTH, N_PHASES = PH_FINAL + 1;
__global__ void __launch_bounds__(NTHR, 2) fwd_kernel(Args args) {
    extern __shared__ __attribute__((aligned(16))) unsigned char lds_raw[];
    Frame F;
    F.lds = (LAS unsigned char*)lds_raw;
    F.tid = threadIdx.x; F.lane = F.tid & 63; F.wave = __builtin_amdgcn_readfirstlane(F.tid >> 6); F.G = gridDim.x; F.blk = blockIdx.x;
    F.out = args.out; F.ws = args.ws; F.ctl = (unsigned*)(args.ws + WS_CTL);
    volatile LAS unsigned* MISC = (volatile LAS unsigned*)(F.lds + MISC_OFF);
    for (int u = F.tid; u < (LDS_BYTES - MISC_OFF) / 4; u += NTHR) ((LAS unsigned*)(F.lds + MISC_OFF))[u] = 0u;
    __syncthreads();
    if (F.tid < 36) ((LAS unsigned*)(F.lds + MISC_OFF + 1024))[F.tid] = ((const unsigned*)__builtin_amdgcn_kernarg_segment_ptr())[F.tid];
    __syncthreads();
    const int lo = args.ph_lo, hi = args.ph_hi;
    XcdBarrier bar; bar.bar = F.ctl + CW_BAR; bar.x = 0; bar.st = nullptr;
    if (hi - lo > 1) bar = xcd_barrier_post(F.ctl + CW_BAR, MISC + 8);
#define SEAM(k) do { if ((k) + 1 < hi) xcd_barrier(bar); } while (0)
    for (int ph = lo; ph < hi; ++ph) {
        { int t_ = threadIdx.x; asm volatile("" : "+v"(t_)); F.tid = t_; F.lane = t_ & 63; F.wave = __builtin_amdgcn_readfirstlane(t_ >> 6);
          unsigned char* w_ = args.ws; asm volatile("" : "+s"(w_)); F.ws = w_; F.ctl = (unsigned*)(w_ + WS_CTL); float* o_ = args.out; asm volatile("" : "+s"(o_)); F.out = o_; }
        if (ph == 0) { phase_prologue(F); }
        else if (ph == PH_FINAL) { phase_rows(F, DEPTH, 2); }
        else {
            const int l = (ph - 1) / PH_PER_LAYER, s = (ph - 1) % PH_PER_LAYER;
            bf16_t* hb = (bf16_t*)(F.ws + WS_H);
            if (s == 0) { phase_rows(F, l, l == 0 ? 0 : 1); }
            else if (s == 1) {
                { pg8::Gemm g{hb, (const bf16_t*)(F.ws + WS_WIN + l * WIN_LAYER)}; pg8::StaticOrder S; S.init(T, NMAIN, F.G, F.blk);
                  EpiIn E{(bf16_t*)(F.ws + WS_QA), (bf16_t*)(F.ws + WS_KA), (bf16_t*)(F.ws + WS_QB), (bf16_t*)(F.ws + WS_QI), (bf16_t*)(F.ws + WS_KB), (bf16_t*)(F.ws + WS_VBT), (bf16_t*)(F.ws + WS_KI),
                          (bf16_t*)(F.ws + WS_SGA), (bf16_t*)(F.ws + WS_SGB), (float*)(F.ws + WS_WI), F.in(IN_QNG) + l * 64, F.in(IN_KNG) + l * 64};
                  pg8::gemm_phase<1024, 1024, 1024, EpiIn, pg8::StaticOrder, true>(F.lds, g, S, E); }
                { pg8::Gemm g{(const bf16_t*)(F.ws + WS_WIN + l * WIN_LAYER) + (size_t)NMAIN * 1024, hb}; pg8::StaticOrder S; S.init(512, T, F.G, (F.blk + F.G / 2) % F.G);
                  EpiPlain E{(bf16_t*)(F.ws + WS_VAT), T};
                  pg8::gemm_phase<1024, 1024, 1024, EpiPlain, pg8::StaticOrder, true>(F.lds, g, S, E); }
            }
            else if (s == 2) { phase_strip(F, l); phase_sb(F); }
            else if (s == 3) {
                const bf16_t* oab = (const bf16_t*)(F.ws + WS_OAB); const bf16_t* wo = (const bf16_t*)(F.ws + WS_WO) + (size_t)l * 1024 * 1024;
                { pg8::Gemm g{oab, wo}; pg8::StaticOrder S; S.init(T, 1024, F.G, F.blk);
                  EpiGate E{(bf16_t*)(F.ws + WS_TMP), (const bf16_t*)(F.ws + WS_SGA), nullptr};
                  pg8::gemm_phase<1024, 1024, 512, EpiGate, pg8::StaticOrder, true>(F.lds, g, S, E); }
                { pg8::Gemm g{oab + 512, wo + 512}; pg8::StaticOrder S; S.init(T, 1024, F.G, F.blk);
                  EpiGate E{(bf16_t*)(F.ws + WS_MERGED), (const bf16_t*)(F.ws + WS_SGB), (const bf16_t*)(F.ws + WS_TMP)};
                  pg8::gemm_phase<1024, 1024, 512, EpiGate, pg8::StaticOrder, true>(F.lds, g, S, E); }
            }
            else if (s == 4) {
                pg8::Gemm g{(const bf16_t*)(F.ws + WS_MERGED), (const bf16_t*)(F.ws + WS_WOUT) + (size_t)l * 1024 * 1024}; pg8::StaticOrder S; S.init(T, 1024, F.G, F.blk);
                EpiOut E{l == 0 ? F.in(IN_X) : F.out, F.out, (const float*)(F.ws + WS_MOD) + (size_t)l * BATCH * NMOD + 2 * DM};
                pg8::gemm_phase<1024, 1024, 1024, EpiOut, pg8::StaticOrder, true>(F.lds, g, S, E);
            }
            else if (s == 5) { phase_h2_route(F, l); }
            else if (s == 6) { phase_gather(F, l); }
            else if (s == 7 || s == 8) {
                LAS int* tile_end = (LAS int*)(F.lds + MISC_OFF + 512);
                const int ntiles = moe_table(F, l, tile_end);
                MoeOrder S{tile_end, ntiles, F.G, F.blk};
                if (s == 7) { pg8::Gemm g{(const bf16_t*)(F.ws + WS_XG), (const bf16_t*)(F.ws + WS_WGU)};
                    EpiMoe1 E{(bf16_t*)(F.ws + WS_HID), (const float*)(F.ws + WS_SLOTW)};
                    pg8::gemm_phase<1024, 1024, 1024, EpiMoe1, MoeOrder, true>(F.lds, g, S, E); }
                else { pg8::Gemm g{(const bf16_t*)(F.ws + WS_HID), (const bf16_t*)(F.ws + WS_WD)};
                    EpiMoe2 E{(bf16_t*)(F.ws + WS_Y), (const int*)(F.ws + WS_SLOTD)};
                    pg8::gemm_phase<512, 512, 512, EpiMoe2, MoeOrder, true>(F.lds, g, S, E); }
            }
        }
        __syncthreads();
        SEAM(ph);
    }
#undef SEAM
}

extern "C" void kernel_launch(void* const* d_in, const int* in_sizes, int n_in, void* d_out, int out_size, void* d_ws, size_t ws_size, hipStream_t stream) {
    static int grid = 0;
    if (grid == 0) {
        if (n_in != 18 || out_size != T * DM || ws_size < WS_END) { fprintf(stderr, "kernel_launch: unexpected problem (n_in %d, out %d, ws %zu)\n", n_in, out_size, ws_size); grid = -1; return; }
        int dev = 0, cus = 0;
        if (hipGetDevice(&dev) != hipSuccess || hipDeviceGetAttribute(&cus, hipDeviceAttributeMultiprocessorCount, dev) != hipSuccess) { grid = -1; return; }
        if (hipFuncSetAttribute((const void*)fwd_kernel, hipFuncAttributeMaxDynamicSharedMemorySize, LDS_BYTES) != hipSuccess) { fprintf(stderr, "kernel_launch: hipFuncSetAttribute failed\n"); grid = -1; return; }
        (void)hipGetLastError();
        grid = cus;
        if (grid != 256) fprintf(stderr, "kernel_launch: %d CUs (built for 256)\n", grid);
    }
    if (grid < 0) return;
    (void)hipMemsetAsync((char*)d_ws + WS_CTL, 0, CTL_ZERO_BYTES, stream);
    Args a{};
    for (int i = 0; i < 18; ++i) a.in[i] = (const float*)d_in[i];
    a.out = (float*)d_out; a.ws = (unsigned char*)d_ws;
#if ONE_LAUNCH
    a.ph_lo = 0; a.ph_hi = N_PHASES;
    hipLaunchKernelGGL(fwd_kernel, dim3(grid), dim3(NTHR), LDS_BYTES, stream, a);
#else
    for (int ph = 0; ph < N_PHASES; ++ph) {
        const int s = ph == 0 || ph == PH_FINAL ? -1 : (ph - 1) % PH_PER_LAYER;
        (void)s;
        a.ph_lo = ph; a.ph_hi = ph + 1;
        hipLaunchKernelGGL(fwd_kernel, dim3(grid), dim3(NTHR), LDS_BYTES, stream, a);
    }
#endif
}
```

```cpp
#include <hip/hip_runtime.h>
#include <cstdio>
#include <cstdint>

#define LAS __attribute__((address_space(3)))
#define GAS __attribute__((address_space(1)))
typedef unsigned short bf16_t;
typedef short bf16x8 __attribute__((ext_vector_type(8)));
typedef float f32x4 __attribute__((ext_vector_type(4)));
typedef float f32x2 __attribute__((ext_vector_type(2)));
typedef unsigned u32x4 __attribute__((ext_vector_type(4)));
typedef unsigned u32x2 __attribute__((ext_vector_type(2)));

constexpr int BATCH = 8, SEQ = 2048, DM = 1024, T = BATCH * SEQ, DEPTH = 2;
constexpr int NIN = 4808, NMOD = 6 * DM;
constexpr int NE = 16, DEXP = 512;
constexpr int NMAIN = 4352;
constexpr int PMAX = 36864;
constexpr float EPS = 1e-6f;
constexpr int NWAVES = 8, NTHR = 512;

#ifndef ONE_LAUNCH
#define ONE_LAUNCH 1
#endif

constexpr size_t MiB = 1u << 20;
constexpr size_t WS_CTL = 0, CTL_ZERO_BYTES = 1 * MiB;
constexpr size_t WS_MOD = 1 * MiB;
constexpr size_t WS_MODP = 2 * MiB;
constexpr size_t WS_ETOK = 8 * MiB, WS_EW = 9 * MiB, WS_EDST = 10 * MiB;
constexpr size_t WS_SLOTW = 11 * MiB, WS_SLOTD = 11 * MiB + 256 * 1024;
constexpr size_t WS_MASK = 12 * MiB;
constexpr size_t WS_WIN = 16 * MiB;
constexpr size_t WIN_LAYER = (size_t)4864 * 1024 * 2;
constexpr size_t WS_WO = 35 * MiB, WS_WOUT = 39 * MiB;
constexpr size_t WS_WGU = 43 * MiB;
constexpr size_t WS_WD = 75 * MiB;
constexpr size_t WS_H = 92 * MiB;
constexpr size_t WS_QA = 124 * MiB, WS_KA = 140 * MiB, WS_VAT = 156 * MiB, WS_QB = 172 * MiB, WS_QI = 188 * MiB;
constexpr size_t WS_KB = 204 * MiB, WS_VBT = 206 * MiB, WS_KI = 208 * MiB, WS_WI = 210 * MiB;
constexpr size_t WS_SGA = 212 * MiB, WS_SGB = 244 * MiB, WS_OAB = 276 * MiB;
constexpr size_t WS_MERGED = 124 * MiB;
constexpr size_t WS_TMP = 156 * MiB;
constexpr size_t WS_XG = 124 * MiB;
constexpr size_t WS_HID = 196 * MiB;
constexpr size_t WS_Y = 232 * MiB;
constexpr size_t WS_END = 308 * MiB;
constexpr int CW_GCNT = 64;
constexpr int CW_BAR = 4096;

#define LDS_WAIT() asm volatile("s_waitcnt lgkmcnt(0)" ::: "memory")
#define VM_WAIT() asm volatile("s_waitcnt vmcnt(0)" ::: "memory")
#define RLX_AGENT __ATOMIC_RELAXED, __HIP_MEMORY_SCOPE_AGENT
__device__ __forceinline__ unsigned f2bf(float f) { unsigned u = __builtin_bit_cast(unsigned, f); return (u + 0x7fffu + ((u >> 16) & 1u)) >> 16; }
__device__ __forceinline__ unsigned pk2(float lo, float hi) { return f2bf(lo) | (f2bf(hi) << 16); }
__device__ __forceinline__ float bflo(unsigned w) { return __builtin_bit_cast(float, w << 16); }
__device__ __forceinline__ float bfhi(unsigned w) { return __builtin_bit_cast(float, w & 0xffff0000u); }
__device__ __forceinline__ float bf2f(bf16_t h) { return __builtin_bit_cast(float, (unsigned)h << 16); }
__device__ __forceinline__ unsigned cvt_pk_bf16(float lo, float hi) { unsigned r; asm volatile("v_cvt_pk_bf16_f32 %0, %1, %2" : "=v"(r) : "v"(lo), "v"(hi)); return r; }
__device__ __forceinline__ u32x4 pack8(f32x4 a, f32x4 b) { u32x4 w; w.x = cvt_pk_bf16(a[0], a[1]); w.y = cvt_pk_bf16(a[2], a[3]); w.z = cvt_pk_bf16(b[0], b[1]); w.w = cvt_pk_bf16(b[2], b[3]); return w; }
__device__ __forceinline__ float sigmoidf_(float x) { return 1.f / (1.f + __expf(-x)); }
__device__ __forceinline__ float wave_sum(float v) {
#pragma unroll
    for (int o = 1; o < 64; o <<= 1) v += __shfl_xor(v, o);
    return v;
}

namespace pg8 {
constexpr int BM = 256, BK = 64, HALF = 128, HTB = HALF * BK * 2, STAGE_BYTES = 8 * HTB, NXCD = 8, WGM = 8;
__host__ __device__ __forceinline__ int lds_byte(int r, int c) { const int st = (r >> 4) * 2 + (c >> 5), rr = r & 15, cc = c & 31, ob = rr * 64 + cc * 2; return st * 1024 + (ob ^ (((ob >> 9) & 1) << 5)); }
__host__ __device__ __forceinline__ void stage_rc(int b, int& R, int& C) { const int st = b / 1024, sb = b % 1024, swz = sb ^ (((sb >> 9) & 1) << 5); R = (st >> 1) * 16 + swz / 64; C = (st & 1) * 32 + (swz % 64) / 2; }
__host__ __device__ __forceinline__ int perm32(int rho) { const int n = rho >> 4, i = rho & 15; return 8 * (i >> 2) + 4 * n + (i & 3); }

struct Unit { int pm, pn, aux, nv; };
struct Gemm { const bf16_t* A; const bf16_t* Bt; const int* rowidx; };

struct StaticOrder {
    int nM, nN, nwg, G, c;
    __host__ __device__ void init(int M, int N, int G_, int c_) { nM = M / BM; nN = N / BM; nwg = nM * nN; G = G_; c = c_; }
    __host__ __device__ bool next(int i, Unit& u) const {
        const long L = (long)i * G + c; if (L >= nwg) return false;
        int wgid = (int)L; { const int q = nwg / NXCD, r = nwg % NXCD, xcd = wgid % NXCD, off = wgid / NXCD; wgid = (xcd < r ? xcd * (q + 1) : r * (q + 1) + (xcd - r) * q) + off; }
        const int nig = WGM * nN, gid = wgid / nig, fm = gid * WGM, gsz = (nM - fm) < WGM ? (nM - fm) : WGM;
        u.pm = fm + ((wgid % nig) % gsz); u.pn = (wgid % nig) / gsz; return true;
    }
    __device__ __forceinline__ void a_ready(const Unit&) const {}
    __device__ __forceinline__ void done(const Unit&) const {}
};

template <int LDA, int LDB, int KK, class Epi, class Sched, bool ALIGN_EPI, bool GATHER = false, bool MIDHOOK = false>
__device__ __forceinline__ void gemm_phase(LAS unsigned char* lds, const Gemm g, const Sched& S, const Epi& E) {
    int tid = threadIdx.x; asm volatile("" : "+v"(tid));
    const int wid = __builtin_amdgcn_readfirstlane(tid >> 6), lane = tid & 63, wr = wid >> 2, wc = wid & 3, fr = lane & 15, fq = lane >> 4;
    constexpr int nt = KK / BK;
    unsigned voffA[2], voffB[2];
#pragma unroll
    for (int i = 0; i < 2; ++i) { int R, C; stage_rc(tid * 16 + i * 8192, R, C); const int Rb = Epi::PERM ? ((R & ~31) + perm32(R & 31)) : R;
        voffA[i] = (unsigned)(R * LDA + C) * 2u; voffB[i] = (unsigned)(Rb * LDB + C) * 2u; }
    constexpr size_t kstep = (size_t)(BK * 2);
    constexpr size_t hstepA = (size_t)HALF * LDA * 2, hstepB = (size_t)HALF * LDB * 2;
    constexpr size_t tstepA = 2 * hstepA, tstepB = 2 * hstepB;
    const unsigned ldsw = (unsigned)wid * 1024u;
    const int aoff = lds_byte(wr * 64 + fr, fq * 8), boff = lds_byte(wc * 32 + fr, fq * 8);
#define PG8_SA(b, h) (((b) * 2 + (h)) * HTB)
#define PG8_SB(b, h) ((4 + (b) * 2 + (h)) * HTB)
#define PG8_STAGE(bufoff, gbase, voff) do { _Pragma("unroll") for (int _i = 0; _i < 2; ++_i) \
        __builtin_amdgcn_global_load_lds((const unsigned*)((const char*)(gbase) + (voff)[_i]), (LAS unsigned*)(lds + (bufoff) + ldsw + _i * 8192), 16, 0, 0); } while (0)
    unsigned gaC[2][2], gaN[2][2];
#define PG8_SETGA(ga, u) do { if constexpr (GATHER) { _Pragma("unroll") for (int h_ = 0; h_ < 2; ++h_) _Pragma("unroll") for (int i_ = 0; i_ < 2; ++i_) { int R_, C_; stage_rc(tid * 16 + i_ * 8192, R_, C_); \
        const int idx_ = h_ * HALF + R_; const int tok_ = idx_ < (u).nv ? g.rowidx[(u).aux + idx_] : 0; ga[h_][i_] = (unsigned)tok_ * (unsigned)(LDA * 2) + (unsigned)(C_ * 2); } } } while (0)
#define PG8_STAGE_A(bufoff, ngbase, gkoff, isn, h) do { if constexpr (GATHER) { unsigned vo_[2]; vo_[0] = (isn) ? gaN[h][0] : gaC[h][0]; vo_[1] = (isn) ? gaN[h][1] : gaC[h][1]; \
        PG8_STAGE(bufoff, (const char*)g.A + (gkoff), vo_); } else { PG8_STAGE(bufoff, ngbase, voffA); } } while (0)
#define PG8_LDA(dst, b, h) do { _Pragma("unroll") for (int m = 0; m < 4; ++m) _Pragma("unroll") for (int k = 0; k < 2; ++k) dst[m][k] = *(const LAS bf16x8*)(lds + PG8_SA(b, h) + aoff + m * 2048 + k * 1024); } while (0)
#define PG8_LDB(dst, b, h) do { _Pragma("unroll") for (int n = 0; n < 2; ++n) _Pragma("unroll") for (int k = 0; k < 2; ++k) dst[n][k] = *(const LAS bf16x8*)(lds + PG8_SB(b, h) + boff + n * 2048 + k * 1024); } while (0)
#define PG8_MMA(ai, bj, At, Bt) do { __builtin_amdgcn_s_setprio(1); _Pragma("unroll") for (int m = 0; m < 4; ++m) _Pragma("unroll") for (int n = 0; n < 2; ++n) _Pragma("unroll") for (int k = 0; k < 2; ++k) \
        acc[ai][bj][m][n] = __builtin_amdgcn_mfma_f32_16x16x32_bf16(Bt[n][k], At[m][k], acc[ai][bj][m][n], 0, 0, 0); __builtin_amdgcn_s_setprio(0); } while (0)
#define PG8_WAIT_V(n) asm volatile("s_waitcnt vmcnt(" #n ")" ::: "memory")
#define PG8_WAIT_L(n) asm volatile("s_waitcnt lgkmcnt(" #n ")" ::: "memory")
#define PG8_BAR __builtin_amdgcn_s_barrier()
#define PG8_SCHED __builtin_amdgcn_sched_barrier(0)
    Unit cur, nxt; int ui = 0;
    if (!S.next(0, cur)) return;
    f32x4 acc[2][2][4][2];
#pragma unroll
    for (int a = 0; a < 2; ++a)
#pragma unroll
        for (int b = 0; b < 2; ++b)
#pragma unroll
            for (int m = 0; m < 4; ++m)
#pragma unroll
                for (int n = 0; n < 2; ++n) acc[a][b][m][n] = (f32x4){0.f, 0.f, 0.f, 0.f};
    bf16x8 At[4][2], B0[2][2], B1[2][2];
    const char* cA = (const char*)g.A + (size_t)cur.pm * tstepA; const char* cB = (const char*)g.Bt + (size_t)cur.pn * tstepB;
    S.a_ready(cur);
    PG8_SETGA(gaC, cur);
    if constexpr (GATHER) {
#pragma unroll
        for (int h_ = 0; h_ < 2; ++h_)
#pragma unroll
            for (int i_ = 0; i_ < 2; ++i_) gaN[h_][i_] = gaC[h_][i_]; }
    PG8_STAGE(PG8_SB(0, 0), cB, voffB); PG8_STAGE(PG8_SB(0, 1), cB + hstepB, voffB); PG8_STAGE_A(PG8_SA(0, 0), cA, 0, false, 0); PG8_STAGE_A(PG8_SA(0, 1), cA + hstepA, 0, false, 1);
    if (wr == 1) PG8_BAR;
    PG8_WAIT_V(2); PG8_BAR;
    PG8_STAGE(PG8_SB(1, 0), cB + kstep, voffB); PG8_STAGE_A(PG8_SA(1, 0), cA + kstep, kstep, false, 0); PG8_STAGE(PG8_SB(1, 1), cB + hstepB + kstep, voffB);
    PG8_WAIT_V(6); PG8_BAR;
    for (;;) {
        const bool has_next = S.next(ui + 1, nxt);
        const char* nA = has_next ? (const char*)g.A + (size_t)nxt.pm * tstepA : cA; const char* nB = has_next ? (const char*)g.Bt + (size_t)nxt.pn * tstepB : cB;
        if (has_next) PG8_SETGA(gaN, nxt);
        for (int t = 0; t < nt; t += 2) {
            const bool last = (t == nt - 2);
            const char* a1 = cA + (size_t)(t + 1) * kstep;
            const char* a2 = last ? nA : cA + (size_t)(t + 2) * kstep; const char* b2 = last ? nB : cB + (size_t)(t + 2) * kstep;
            const char* a3 = a2 + kstep; const char* b3 = b2 + kstep;
            const size_t k2 = last ? 0 : (size_t)(t + 2) * kstep;
            if (last && has_next) S.a_ready(nxt);
            if constexpr (MIDHOOK) { if (t == nt / 2) E.mid(acc, cur, wr, wc, fr, fq); }
            PG8_LDB(B0, 0, 0); PG8_LDB(B1, 0, 1); PG8_SCHED; PG8_LDA(At, 0, 0); PG8_STAGE_A(PG8_SA(1, 1), a1 + hstepA, (size_t)(t + 1) * kstep, false, 1);
            PG8_WAIT_V(8); PG8_WAIT_L(0); PG8_BAR; PG8_MMA(0, 0, At, B0); PG8_MMA(0, 1, At, B1); PG8_BAR; PG8_SCHED;
            PG8_LDA(At, 0, 1); PG8_STAGE(PG8_SB(0, 0), b2, voffB); PG8_STAGE(PG8_SB(0, 1), b2 + hstepB, voffB); PG8_STAGE_A(PG8_SA(0, 0), a2, k2, last, 0);
            PG8_WAIT_V(8); PG8_WAIT_L(0); PG8_BAR; PG8_MMA(1, 0, At, B0); PG8_MMA(1, 1, At, B1); PG8_BAR; PG8_SCHED;
            PG8_LDB(B0, 1, 0); PG8_LDB(B1, 1, 1); PG8_SCHED; PG8_LDA(At, 1, 0); PG8_STAGE_A(PG8_SA(0, 1), a2 + hstepA, k2, last, 1);
            PG8_WAIT_V(8); PG8_WAIT_L(0); PG8_BAR; PG8_MMA(0, 0, At, B0); PG8_MMA(0, 1, At, B1); PG8_BAR; PG8_SCHED;
            PG8_LDA(At, 1, 1); PG8_STAGE(PG8_SB(1, 0), b3, voffB); PG8_STAGE(PG8_SB(1, 1), b3 + hstepB, voffB); PG8_STAGE_A(PG8_SA(1, 0), a3, k2 + kstep, last, 0);
            PG8_WAIT_V(8); PG8_WAIT_L(0); PG8_BAR; PG8_MMA(1, 0, At, B0); PG8_MMA(1, 1, At, B1); PG8_BAR; PG8_SCHED;
        }
        if constexpr (ALIGN_EPI) { if (wr == 0) PG8_BAR; }
        E(acc, cur, wr, wc, fr, fq); S.done(cur);
        if (!has_next) break;
#pragma unroll
        for (int a = 0; a < 2; ++a)
#pragma unroll
            for (int b = 0; b < 2; ++b)
#pragma unroll
                for (int m = 0; m < 4; ++m)
#pragma unroll
                    for (int n = 0; n < 2; ++n) acc[a][b][m][n] = (f32x4){0.f, 0.f, 0.f, 0.f};
        cur = nxt; cA = nA; cB = nB; ++ui;
        if constexpr (GATHER) {
#pragma unroll
            for (int h_ = 0; h_ < 2; ++h_)
#pragma unroll
                for (int i_ = 0; i_ < 2; ++i_) gaC[h_][i_] = gaN[h_][i_]; }
        if constexpr (ALIGN_EPI) { if (wr == 1) PG8_BAR; }
    }
    PG8_WAIT_V(0);
    if constexpr (!ALIGN_EPI) { if (wr == 0) PG8_BAR; }
    PG8_BAR;
#undef PG8_SA
#undef PG8_SB
#undef PG8_STAGE
#undef PG8_STAGE_A
#undef PG8_SETGA
#undef PG8_LDA
#undef PG8_LDB
#undef PG8_MMA
#undef PG8_WAIT_V
#undef PG8_WAIT_L
#undef PG8_BAR
#undef PG8_SCHED
}
}
typedef f32x4 AccT[2][2][4][2];

template <int SIG> __device__ __forceinline__ void store_tile_bf16(bf16_t* O, int ld, int colt, float sc, const AccT& acc, int row0, int wc, int fq) {
    const int col0 = colt + wc * 32 + 8 * fq;
#pragma unroll
    for (int ai = 0; ai < 2; ++ai)
#pragma unroll
        for (int m = 0; m < 4; ++m) { bf16_t* rowp = O + (size_t)(row0 + ai * 128 + m * 16) * ld + col0;
#pragma unroll
            for (int bj = 0; bj < 2; ++bj) { f32x4 v0 = acc[ai][bj][m][0] * sc, v1 = acc[ai][bj][m][1] * sc;
                if (SIG) {
#pragma unroll
                    for (int i = 0; i < 4; ++i) { v0[i] = sigmoidf_(v0[i]); v1[i] = sigmoidf_(v1[i]); } }
                *(u32x4*)(rowp + bj * 128) = pack8(v0, v1); } }
}
template <int NORM> __device__ __forceinline__ void store_head64(bf16_t* O, int ld, int cbase, const float* gain, float gsc, const AccT& acc, int row0, int fq) {
    f32x4 gq[2][2];
#pragma unroll
    for (int bj = 0; bj < 2; ++bj)
#pragma unroll
        for (int n = 0; n < 2; ++n) gq[bj][n] = NORM ? *(const f32x4*)(gain + 32 * bj + 8 * fq + 4 * n) * gsc : (f32x4){1.f, 1.f, 1.f, 1.f};
#pragma unroll
    for (int ai = 0; ai < 2; ++ai)
#pragma unroll
        for (int m = 0; m < 4; ++m) {
            float r = 1.f;
            if (NORM) { float ss = 0.f;
#pragma unroll
                for (int bj = 0; bj < 2; ++bj)
#pragma unroll
                    for (int n = 0; n < 2; ++n) { const f32x4 x = acc[ai][bj][m][n]; ss += (x[0] * x[0] + x[1] * x[1]) + (x[2] * x[2] + x[3] * x[3]); }
                ss += __shfl_xor(ss, 16); ss += __shfl_xor(ss, 32);
                r = 1.0f / sqrtf(ss * (1.0f / 64.0f) + EPS); }
            bf16_t* rowp = O + (size_t)(row0 + ai * 128 + m * 16) * ld + cbase + 8 * fq;
#pragma unroll
            for (int bj = 0; bj < 2; ++bj) { const f32x4 v0 = acc[ai][bj][m][0] * r * gq[bj][0], v1 = acc[ai][bj][m][1] * r * gq[bj][1];
                *(u32x4*)(rowp + 32 * bj) = pack8(v0, v1); } }
}
struct EpiIn {
    static constexpr bool PERM = true;
    bf16_t *qa, *ka, *qb, *qi, *kb, *vbT, *ki, *sga, *sgb; float* wi; const float *qg, *kg;
    __device__ __forceinline__ void operator()(const AccT& acc, const pg8::Unit& u, int wr, int wc, int fr, int fq) const {
        asm volatile("" : "+v"(fr), "+v"(fq));
        const int pn = u.pn, row0 = u.pm * 256 + wr * 64 + fr;
        if (pn < 2) store_tile_bf16<0>(qa, 512, pn * 256, 0.125f, acc, row0, wc, fq);
        else if (pn < 4) store_tile_bf16<0>(ka, 512, (pn - 2) * 256, 1.f, acc, row0, wc, fq);
        else if (pn < 6) store_head64<1>(qb, 512, ((pn - 4) * 4 + wc) * 64, qg, 0.125f, acc, row0, fq);
        else if (pn < 8) store_tile_bf16<0>(qi, 512, (pn - 6) * 256, 1.f, acc, row0, wc, fq);
        else if (pn == 8) {
            if (wc == 0) store_head64<1>(kb, 64, 0, kg, 1.f, acc, row0, fq);
            else if (wc == 1) {
#pragma unroll
                for (int ai = 0; ai < 2; ++ai)
#pragma unroll
                    for (int m = 0; m < 4; ++m) { bf16_t* p = vbT + (size_t)(8 * fq) * T + (row0 + ai * 128 + m * 16);
#pragma unroll
                        for (int bj = 0; bj < 2; ++bj)
#pragma unroll
                            for (int n = 0; n < 2; ++n)
#pragma unroll
                                for (int i = 0; i < 4; ++i) p[(size_t)(32 * bj + 4 * n + i) * T] = (bf16_t)f2bf(acc[ai][bj][m][n][i]); } }
            else if (wc == 2) store_head64<0>(ki, 64, 0, nullptr, 1.f, acc, row0, fq);
            else { if (fq == 0) {
#pragma unroll
                for (int ai = 0; ai < 2; ++ai)
#pragma unroll
                    for (int m = 0; m < 4; ++m) { float* p = wi + (size_t)(row0 + ai * 128 + m * 16) * 8; *(f32x4*)p = acc[ai][0][m][0]; *(f32x4*)(p + 4) = acc[ai][0][m][1]; } } }
        }
        else if (pn < 13) store_tile_bf16<1>(sga, 1024, (pn - 9) * 256, 1.f, acc, row0, wc, fq);
        else store_tile_bf16<1>(sgb, 1024, (pn - 13) * 256, 1.f, acc, row0, wc, fq);
    }
};
struct EpiPlain {
    static constexpr bool PERM = true;
    bf16_t* O; int ld;
    __device__ __forceinline__ void operator()(const AccT& acc, const pg8::Unit& u, int wr, int wc, int fr, int fq) const {
        asm volatile("" : "+v"(fr), "+v"(fq));
        store_tile_bf16<0>(O, ld, u.pn * 256, 1.f, acc, u.pm * 256 + wr * 64 + fr, wc, fq);
    }
};
struct EpiMerge {
    static constexpr bool PERM = true;
    bf16_t* O; const bf16_t* sga; const bf16_t* sgb;
    __device__ __forceinline__ void mid(AccT& acc, const pg8::Unit& u, int wr, int wc, int fr, int fq) const {
        asm volatile("" : "+v"(fr), "+v"(fq));
        const int row0 = u.pm * 256 + wr * 64 + fr, col0 = u.pn * 256 + wc * 32 + 8 * fq;
#pragma unroll
        for (int ai = 0; ai < 2; ++ai)
#pragma unroll
            for (int m = 0; m < 4; ++m) { const size_t off = (size_t)(row0 + ai * 128 + m * 16) * 1024 + col0;
#pragma unroll
                for (int bj = 0; bj < 2; ++bj) { const u32x4 a = *(const u32x4*)(sga + off + bj * 128), b = *(const u32x4*)(sgb + off + bj * 128);
                    f32x4& v0 = acc[ai][bj][m][0]; f32x4& v1 = acc[ai][bj][m][1];
                    v0[0] *= bflo(a.x) * __builtin_amdgcn_rcpf(bflo(b.x)); v0[1] *= bfhi(a.x) * __builtin_amdgcn_rcpf(bfhi(b.x)); v0[2] *= bflo(a.y) * __builtin_amdgcn_rcpf(bflo(b.y)); v0[3] *= bfhi(a.y) * __builtin_amdgcn_rcpf(bfhi(b.y));
                    v1[0] *= bflo(a.z) * __builtin_amdgcn_rcpf(bflo(b.z)); v1[1] *= bfhi(a.z) * __builtin_amdgcn_rcpf(bfhi(b.z)); v1[2] *= bflo(a.w) * __builtin_amdgcn_rcpf(bflo(b.w)); v1[3] *= bfhi(a.w) * __builtin_amdgcn_rcpf(bfhi(b.w)); } }
    }
    __device__ __forceinline__ void operator()(const AccT& acc, const pg8::Unit& u, int wr, int wc, int fr, int fq) const {
        asm volatile("" : "+v"(fr), "+v"(fq));
        const int row0 = u.pm * 256 + wr * 64 + fr, col0 = u.pn * 256 + wc * 32 + 8 * fq;
#pragma unroll
        for (int ai = 0; ai < 2; ++ai)
#pragma unroll
            for (int m = 0; m < 4; ++m) { const size_t off = (size_t)(row0 + ai * 128 + m * 16) * 1024 + col0;
#pragma unroll
                for (int bj = 0; bj < 2; ++bj) { const u32x4 gw = *(const u32x4*)(sgb + off + bj * 128);
                    f32x4 v0 = acc[ai][bj][m][0], v1 = acc[ai][bj][m][1];
                    v0[0] *= bflo(gw.x); v0[1] *= bfhi(gw.x); v0[2] *= bflo(gw.y); v0[3] *= bfhi(gw.y);
                    v1[0] *= bflo(gw.z); v1[1] *= bfhi(gw.z); v1[2] *= bflo(gw.w); v1[3] *= bfhi(gw.w);
                    *(u32x4*)(O + off + bj * 128) = pack8(v0, v1); } }
    }
};
struct EpiOut {
    static constexpr bool PERM = false;
    const float* xin; float* xout; const float* gvec;
    __device__ __forceinline__ void operator()(const AccT& acc, const pg8::Unit& u, int wr, int wc, int fr, int fq) const {
        asm volatile("" : "+v"(fr), "+v"(fq));
        const int row0 = u.pm * 256 + wr * 64 + fr, col0 = u.pn * 256 + wc * 32 + 4 * fq;
        const int b = (u.pm * 256) / SEQ;
        f32x4 gv[2][2];
#pragma unroll
        for (int bj = 0; bj < 2; ++bj)
#pragma unroll
            for (int n = 0; n < 2; ++n) gv[bj][n] = *(const f32x4*)(gvec + (size_t)b * NMOD + col0 + bj * 128 + n * 16);
#pragma unroll
        for (int ai = 0; ai < 2; ++ai)
#pragma unroll
            for (int m = 0; m < 4; ++m) { const size_t off = (size_t)(row0 + ai * 128 + m * 16) * 1024 + col0;
#pragma unroll
                for (int bj = 0; bj < 2; ++bj)
#pragma unroll
                    for (int n = 0; n < 2; ++n) { const f32x4 xi = *(const f32x4*)(xin + off + bj * 128 + n * 16);
                        *(f32x4*)(xout + off + bj * 128 + n * 16) = xi + gv[bj][n] * acc[ai][bj][m][n]; } }
    }
};
struct EpiMoe1 {
    static constexpr bool PERM = true;
    bf16_t* hid; const float* ew;
    __device__ __forceinline__ void operator()(const AccT& acc, const pg8::Unit& u, int wr, int wc, int fr, int fq) const {
        asm volatile("" : "+v"(fr), "+v"(fq));
        const int r0 = wr * 64 + fr, pnl = u.pn & 3, col0 = 128 * pnl + 16 * wc + 4 * fq;
#pragma unroll
        for (int ai = 0; ai < 2; ++ai)
#pragma unroll
            for (int m = 0; m < 4; ++m) { const int r = r0 + ai * 128 + m * 16; const float cw = r < u.nv ? ew[u.aux + r] : 0.f;
#pragma unroll
                for (int bj = 0; bj < 2; ++bj) { const f32x4 gt = acc[ai][bj][m][0], up = acc[ai][bj][m][1]; f32x4 h;
#pragma unroll
                    for (int i = 0; i < 4; ++i) h[i] = gt[i] * sigmoidf_(gt[i]) * up[i] * cw;
                    u32x2 w; w.x = cvt_pk_bf16(h[0], h[1]); w.y = cvt_pk_bf16(h[2], h[3]);
                    *(u32x2*)(hid + (size_t)(u.pm * 256 + r) * DEXP + col0 + 64 * bj) = w; } }
    }
};
struct EpiMoe2 {
    static constexpr bool PERM = true;
    bf16_t* y; const int* edst;
    __device__ __forceinline__ void operator()(const AccT& acc, const pg8::Unit& u, int wr, int wc, int fr, int fq) const {
        asm volatile("" : "+v"(fr), "+v"(fq));
        const int r0 = wr * 64 + fr, col0 = (u.pn & 3) * 256 + wc * 32 + 8 * fq;
#pragma unroll
        for (int ai = 0; ai < 2; ++ai)
#pragma unroll
            for (int m = 0; m < 4; ++m) { const int r = r0 + ai * 128 + m * 16;
                if (r < u.nv) { const int dst = edst[u.aux + r]; bf16_t* rowp = y + (size_t)dst * 1024 + col0;
#pragma unroll
                    for (int bj = 0; bj < 2; ++bj) *(u32x4*)(rowp + bj * 128) = pack8(acc[ai][bj][m][0], acc[ai][bj][m][1]); } }
    }
};
struct MoeOrder {
    const LAS int* tile_end; int ntiles, G, c;
    __device__ __forceinline__ bool next(int i, pg8::Unit& u) const {
        const int L = i * G + c; if (L >= 4 * ntiles) return false;
        const int rt = L >> 2; int e = 0;
#pragma unroll
        for (int j = 0; j < NE; ++j) e += (rt >= tile_end[j]) ? 1 : 0;
        e = __builtin_amdgcn_readfirstlane(e);
        const int ts = e == 0 ? 0 : __builtin_amdgcn_readfirstlane(tile_end[e - 1]), ne = __builtin_amdgcn_readfirstlane(tile_end[16 + e]);
        u.pm = rt; u.pn = e * 4 + (L & 3); u.aux = e * T + (rt - ts) * 256; u.nv = ne - (rt - ts) * 256; return true;
    }
    __device__ __forceinline__ void a_ready(const pg8::Unit&) const {}
    __device__ __forceinline__ void done(const pg8::Unit&) const {}
};

constexpr int RING_BYTES = 131072, MISC_OFF = 133120, LDS_BYTES = 147456;
struct Args { const float* in[18]; float* out; unsigned char* ws; int ph_lo, ph_hi; };
struct Frame {
    LAS unsigned char* lds; int tid, lane, wave, G, blk;
    float* out; unsigned char* ws; unsigned* ctl;
    __device__ __forceinline__ const float* in(int i) const {
        const LAS unsigned* t = (const LAS unsigned*)(lds + MISC_OFF + 1024) + 2 * i;
        const unsigned lo = __builtin_amdgcn_readfirstlane(t[0]), hi = __builtin_amdgcn_readfirstlane(t[1]);
        return (const float*)(((unsigned long long)hi << 32) | lo);
    }
};
enum { IN_X = 0, IN_C, IN_WADA, IN_BADA, IN_N1G, IN_WIN, IN_QNG, IN_KNG, IN_RELB, IN_WOA, IN_WOB, IN_WOUT, IN_N2G, IN_RW, IN_RB, IN_WG, IN_WU, IN_WDN };

__device__ __forceinline__ int win_src_col(int r) {
    if (r < 1024) return r;
    if (r < 1536) { const int rho = r - 1024, tile = rho >> 8, q = rho & 255, bj = q >> 7, wc = (q >> 5) & 3, j = q & 31; return 1536 + (tile * 4 + wc) * 64 + 32 * bj + j; }
    if (r < 2048) return 2176 + (r - 1536);
    if (r < 2304) { const int q = r - 2048, bj = q >> 7, wc = (q >> 5) & 3, j = q & 31, cs = 32 * bj + j;
        if (wc == 0) return 2048 + cs; if (wc == 1) return 2112 + cs; if (wc == 2) return 2688 + cs; return cs < 8 ? 2752 + cs : -1; }
    if (r < 3328) return 2760 + (r - 2304);
    if (r < 4352) return 3784 + (r - 3328);
    return 1024 + (r - 4352);
}
__device__ __forceinline__ void transpose_item(const float* colp, int ldw, int ksrc0, bf16_t* WT, size_t drow0, int ldk, int kdst0, LAS float* scr, int lane) {
    float tv[32];
    const float* cp = colp ? colp + (size_t)(ksrc0 + (lane >> 5)) * ldw : nullptr;
#pragma unroll
    for (int i = 0; i < 32; ++i) tv[i] = cp ? cp[(size_t)(2 * i) * ldw] : 0.f;
#pragma unroll
    for (int i = 0; i < 32; ++i) scr[(2 * i + (lane >> 5)) * 33 + (lane & 31)] = tv[i];
    LDS_WAIT(); asm volatile("" ::: "memory");
    const int c = lane & 7;
#pragma unroll
    for (int j = 0; j < 4; ++j) { const int n = (lane >> 3) + 8 * j; const LAS float* s = scr + (8 * c) * 33 + n;
        u32x4 o; o.x = pk2(s[0 * 33], s[1 * 33]); o.y = pk2(s[2 * 33], s[3 * 33]); o.z = pk2(s[4 * 33], s[5 * 33]); o.w = pk2(s[6 * 33], s[7 * 33]);
        *(u32x4*)(WT + (drow0 + n) * ldk + kdst0 + 8 * c) = o; }
    LDS_WAIT(); asm volatile("" ::: "memory");
}
constexpr int IT_WIN = 152 * 16, IT_WO = 32 * 16, IT_WOUT = 32 * 16, IT_SMALL = IT_WIN + IT_WO + IT_WOUT;
constexpr int IT_WGU = 16 * 32 * 16, IT_WD = 16 * 32 * 8, IT_EXP = IT_WGU + IT_WD;
__device__ __forceinline__ void convert_small_item(Frame& F, int l, int it, LAS float* scr) {
    const int n31 = F.lane & 31;
    if (it < IT_WIN) { const int rg = it >> 4, kg = it & 15; const int col = win_src_col(rg * 32 + n31);
        transpose_item(col >= 0 ? F.in(IN_WIN) + (size_t)l * DM * NIN + col : nullptr, NIN, kg * 64, (bf16_t*)(F.ws + WS_WIN + l * WIN_LAYER), (size_t)rg * 32, 1024, kg * 64, scr, F.lane); return; }
    it -= IT_WIN;
    if (it < IT_WO) { const int rg = it >> 4, kg = it & 15, k0 = kg * 64; const float* src = (k0 < 512 ? F.in(IN_WOA) : F.in(IN_WOB)) + (size_t)l * 512 * 1024 + rg * 32 + n31;
        transpose_item(src, 1024, k0 & 511, (bf16_t*)(F.ws + WS_WO) + (size_t)l * 1024 * 1024, (size_t)rg * 32, 1024, k0, scr, F.lane); return; }
    it -= IT_WO;
    { const int rg = it >> 4, kg = it & 15; transpose_item(F.in(IN_WOUT) + (size_t)l * 1024 * 1024 + rg * 32 + n31, 1024, kg * 64, (bf16_t*)(F.ws + WS_WOUT) + (size_t)l * 1024 * 1024, (size_t)rg * 32, 1024, kg * 64, scr, F.lane); }
}
__device__ __forceinline__ void convert_expert_item(Frame& F, int l, int it, LAS float* scr) {
    const int n31 = F.lane & 31;
    if (it < IT_WGU) { const int e = it >> 9, r2 = it & 511, rg = r2 >> 4, kg = r2 & 15; const int r = rg * 32 + n31, q = r >> 3, i = r & 7;
        const float* src = (i < 4 ? F.in(IN_WG) : F.in(IN_WU)) + (size_t)(l * NE + e) * DM * DEXP + 4 * q + (i & 3);
        transpose_item(src, DEXP, kg * 64, (bf16_t*)(F.ws + WS_WGU) + (size_t)e * 1024 * 1024, (size_t)rg * 32, 1024, kg * 64, scr, F.lane); return; }
    it -= IT_WGU;
    { const int e = it >> 8, r2 = it & 255, rg = r2 >> 3, kg = r2 & 7;
        transpose_item(F.in(IN_WDN) + (size_t)(l * NE + e) * DEXP * DM + rg * 32 + n31, DM, kg * 64, (bf16_t*)(F.ws + WS_WD) + (size_t)e * 1024 * 512, (size_t)rg * 32, 512, kg * 64, scr, F.lane); }
}

__device__ __forceinline__ void phase_prologue(Frame& F) {
    LAS float* scr = (LAS float*)(F.lds + F.wave * 8448);
    LAS float* sil = (LAS float*)(F.lds + 69632);
    const float* cin = F.in(IN_C); const float* badap = F.in(IN_BADA);
    for (int i = F.tid; i < BATCH * DM; i += NTHR) { const float v = cin[i]; sil[i] = v / (1.f + __expf(-v)); }
    __syncthreads();
    const int gw = F.blk * NWAVES + F.wave, NGW = F.G * NWAVES;
    float* modp = (float*)(F.ws + WS_MODP);
    for (int it = gw; it < 16 * 2 * 96; it += NGW) {
        const int jb = it % 96, l = (it / 96) & 1, kc = it / 192; const int j = jb * 64 + F.lane;
        float a[BATCH];
#pragma unroll
        for (int b = 0; b < BATCH; ++b) a[b] = 0.f;
        const float* wp = F.in(IN_WADA) + ((size_t)l * DM + kc * 64) * NMOD + j;
        for (int k0 = 0; k0 < 64; k0 += 16) { float wv[16];
#pragma unroll
            for (int k = 0; k < 16; ++k) wv[k] = wp[(size_t)(k0 + k) * NMOD];
#pragma unroll
            for (int k = 0; k < 16; ++k)
#pragma unroll
                for (int b = 0; b < BATCH; ++b) a[b] += sil[b * DM + kc * 64 + k0 + k] * wv[k]; }
        const float bias = (kc == 0) ? badap[l * NMOD + j] : 0.f;
#pragma unroll
        for (int b = 0; b < BATCH; ++b) modp[(((size_t)kc * 2 + l) * BATCH + b) * NMOD + j] = a[b] + bias;
    }
    for (int it = gw; it < 2 * IT_SMALL; it += NGW) { const int l = it >= IT_SMALL ? 1 : 0; convert_small_item(F, l, it - l * IT_SMALL, scr); }
    for (int it = gw; it < IT_EXP; it += NGW) convert_expert_item(F, 0, it, scr);
}

__device__ __forceinline__ float modsum(const float* modp, int l, int b, int j) {
    float s = 0.f;
#pragma unroll
    for (int kc = 0; kc < 16; ++kc) s += modp[(((size_t)kc * 2 + l) * BATCH + b) * NMOD + j];
    return s;
}
__device__ __forceinline__ void phase_rows(Frame& F, int l, int mode) {
    LAS float* Av = (LAS float*)F.lds; LAS float* Sv = Av + DM; LAS float* Gv = Sv + DM;
    const float* modp = (const float*)(F.ws + WS_MODP);
    float* mod = (float*)(F.ws + WS_MOD);
    const float* n1g = F.in(IN_N1G); const float* xin = F.in(IN_X);
    const int row_base = F.blk * (T / F.G);
    const int b = row_base / SEQ;
    if (mode == 0) {
        const int per = (2 * BATCH * NMOD) / F.G;
        for (int i = F.tid; i < per; i += NTHR) { const int idx = F.blk * per + i; const int ll = idx / (BATCH * NMOD), bb = (idx / NMOD) % BATCH, j = idx % NMOD; mod[idx] = modsum(modp, ll, bb, j); }
    }
    for (int d = F.tid; d < DM; d += NTHR) {
        if (mode != 2) { Av[d] = n1g[l * DM + d] * (1.f + modsum(modp, l, b, 1 * DM + d)); Sv[d] = modsum(modp, l, b, 0 * DM + d); }
        if (mode != 0) Gv[d] = modsum(modp, l - 1, b, 5 * DM + d);
    }
    if (mode == 1) {
        LAS float* scr = (LAS float*)(F.lds + 16384 + F.wave * 8448);
        const int gw = F.blk * NWAVES + F.wave, NGW = F.G * NWAVES;
        for (int it = gw; it < IT_EXP; it += NGW) convert_expert_item(F, l, it, scr);
    }
    __syncthreads();
    const bf16_t* ybuf = (const bf16_t*)(F.ws + WS_Y);
    bf16_t* hb = (bf16_t*)(F.ws + WS_H);
    const int rows_per_wave = (T / F.G) / NWAVES;
    for (int i = 0; i < rows_per_wave; ++i) {
        const int row = row_base + F.wave * rows_per_wave + i;
        f32x4 v[4];
        const float* xr = (mode == 0 ? xin : F.out) + (size_t)row * DM;
#pragma unroll
        for (int j = 0; j < 4; ++j) v[j] = *(const f32x4*)(xr + 4 * F.lane + 256 * j);
        if (mode != 0) {
#pragma unroll
            for (int j = 0; j < 4; ++j) { const int c0 = 4 * F.lane + 256 * j;
                const u32x2 y0 = *(const u32x2*)(ybuf + (size_t)(2 * row) * DM + c0), y1 = *(const u32x2*)(ybuf + (size_t)(2 * row + 1) * DM + c0);
                v[j][0] += Gv[c0 + 0] * (bflo(y0.x) + bflo(y1.x)); v[j][1] += Gv[c0 + 1] * (bfhi(y0.x) + bfhi(y1.x));
                v[j][2] += Gv[c0 + 2] * (bflo(y0.y) + bflo(y1.y)); v[j][3] += Gv[c0 + 3] * (bfhi(y0.y) + bfhi(y1.y));
                *(f32x4*)(F.out + (size_t)row * DM + c0) = v[j]; }
        }
        if (mode != 2) {
            float ss = 0.f;
#pragma unroll
            for (int j = 0; j < 4; ++j) ss += (v[j][0] * v[j][0] + v[j][1] * v[j][1]) + (v[j][2] * v[j][2] + v[j][3] * v[j][3]);
            const float r = 1.0f / sqrtf(wave_sum(ss) * (1.0f / DM) + EPS);
#pragma unroll
            for (int j = 0; j < 4; ++j) { const int c0 = 4 * F.lane + 256 * j; u32x2 w;
                w.x = pk2(v[j][0] * r * Av[c0] + Sv[c0], v[j][1] * r * Av[c0 + 1] + Sv[c0 + 1]);
                w.y = pk2(v[j][2] * r * Av[c0 + 2] + Sv[c0 + 2], v[j][3] * r * Av[c0 + 3] + Sv[c0 + 3]);
                *(u32x2*)(hb + (size_t)row * DM + c0) = w; }
        }
    }
}

typedef float f32x16 __attribute__((ext_vector_type(16)));
__device__ __forceinline__ bf16x8 pack_bf16x8(float a0, float a1, float a2, float a3, float a4, float a5, float a6, float a7) {
    u32x4 w; w.x = cvt_pk_bf16(a0, a1); w.y = cvt_pk_bf16(a2, a3); w.z = cvt_pk_bf16(a4, a5); w.w = cvt_pk_bf16(a6, a7); return __builtin_bit_cast(bf16x8, w);
}
__device__ __forceinline__ void phase_sb(Frame& F) {
    const bf16_t* qa = (const bf16_t*)(F.ws + WS_QA); const bf16_t* ka = (const bf16_t*)(F.ws + WS_KA); const bf16_t* vaT = (const bf16_t*)(F.ws + WS_VAT);
    bf16_t* oab = (bf16_t*)(F.ws + WS_OAB);
    const int lane = F.lane, q32 = lane & 31, hi = lane >> 5;
    const int NGW = F.G * NWAVES;
    for (int wu = F.blk * NWAVES + F.wave; wu < BATCH * 8 * 64; wu += NGW) {
        const int qblk = wu & 63, bh = wu >> 6, b = bh >> 3, h = bh & 7;
        const int qw = qblk * 32, t = qw + q32;
        const size_t rowb = (size_t)b * SEQ;
        bf16x8 qf[4];
#pragma unroll
        for (int ks = 0; ks < 4; ++ks) qf[ks] = *(const bf16x8*)(qa + (rowb + t) * 512 + h * 64 + 16 * ks + 8 * hi);
        f32x16 o0, o1;
#pragma unroll
        for (int r = 0; r < 16; ++r) { o0[r] = 0.f; o1[r] = 0.f; }
        float R = 0.f;
        for (int kb = qw; kb >= 0; kb -= 32) {
            const bf16_t* kp = ka + (rowb + kb + q32) * 512 + h * 64 + 8 * hi;
            bf16x8 kf[4];
#pragma unroll
            for (int ks = 0; ks < 4; ++ks) kf[ks] = *(const bf16x8*)(kp + 16 * ks);
            const bf16_t* vp = vaT + (size_t)(h * 64 + q32) * T + rowb + kb + 4 * hi;
            u32x2 vv[2][2][2];
#pragma unroll
            for (int dt = 0; dt < 2; ++dt)
#pragma unroll
                for (int sx = 0; sx < 2; ++sx)
#pragma unroll
                    for (int hf = 0; hf < 2; ++hf) vv[dt][sx][hf] = *(const u32x2*)(vp + (size_t)dt * 32 * T + 16 * sx + 8 * hf);
            f32x16 z;
#pragma unroll
            for (int r = 0; r < 16; ++r) z[r] = 0.f;
#pragma unroll
            for (int ks = 0; ks < 4; ++ks) z = __builtin_amdgcn_mfma_f32_32x32x16_bf16(kf[ks], qf[ks], z, 0, 0, 0);
            float lv[16], zs[16]; bool vl[16];
#pragma unroll
            for (int r = 0; r < 16; ++r) { const float zz = z[r]; const float sp = fmaxf(zz, 0.f) + __logf(1.f + __expf(-fabsf(zz)));
                vl[r] = (kb + (r & 3) + 8 * (r >> 2) + 4 * hi) < t; lv[r] = vl[r] ? -sp : 0.f; zs[r] = zz - sp; }
            float gs[4], pg[4], tl[4];
#pragma unroll
            for (int k = 0; k < 4; ++k) { gs[k] = (lv[4 * k] + lv[4 * k + 1]) + (lv[4 * k + 2] + lv[4 * k + 3]); pg[k] = __shfl_xor(gs[k], 32); }
            tl[3] = 0.f; tl[2] = gs[3] + pg[3]; tl[1] = tl[2] + (gs[2] + pg[2]); tl[0] = tl[1] + (gs[1] + pg[1]);
            const float tot = tl[0] + (gs[0] + pg[0]);
            float av[16];
#pragma unroll
            for (int k = 0; k < 4; ++k) { const float base = R + tl[k] + (hi == 0 ? pg[k] : 0.f);
                const float s3 = base, s2 = s3 + lv[4 * k + 3], s1 = s2 + lv[4 * k + 2], s0 = s1 + lv[4 * k + 1];
                av[4 * k + 0] = vl[4 * k + 0] ? __expf(zs[4 * k + 0] + s0) : 0.f; av[4 * k + 1] = vl[4 * k + 1] ? __expf(zs[4 * k + 1] + s1) : 0.f;
                av[4 * k + 2] = vl[4 * k + 2] ? __expf(zs[4 * k + 2] + s2) : 0.f; av[4 * k + 3] = vl[4 * k + 3] ? __expf(zs[4 * k + 3] + s3) : 0.f; }
            R += tot;
            const bf16x8 pf0 = pack_bf16x8(av[0], av[1], av[2], av[3], av[4], av[5], av[6], av[7]);
            const bf16x8 pf1 = pack_bf16x8(av[8], av[9], av[10], av[11], av[12], av[13], av[14], av[15]);
#define SB_VF(dt, sx) __builtin_bit_cast(bf16x8, (u32x4){vv[dt][sx][0].x, vv[dt][sx][0].y, vv[dt][sx][1].x, vv[dt][sx][1].y})
            o0 = __builtin_amdgcn_mfma_f32_32x32x16_bf16(SB_VF(0, 0), pf0, o0, 0, 0, 0);
            o0 = __builtin_amdgcn_mfma_f32_32x32x16_bf16(SB_VF(0, 1), pf1, o0, 0, 0, 0);
            o1 = __builtin_amdgcn_mfma_f32_32x32x16_bf16(SB_VF(1, 0), pf0, o1, 0, 0, 0);
            o1 = __builtin_amdgcn_mfma_f32_32x32x16_bf16(SB_VF(1, 1), pf1, o1, 0, 0, 0);
#undef SB_VF
            if (__all(R <= -104.f)) break;
        }
        bf16_t* op = oab + (rowb + t) * 1024 + h * 64 + 4 * hi;
#pragma unroll
        for (int k = 0; k < 4; ++k) { u32x2 w0, w1; w0.x = cvt_pk_bf16(o0[4 * k], o0[4 * k + 1]); w0.y = cvt_pk_bf16(o0[4 * k + 2], o0[4 * k + 3]);
            w1.x = cvt_pk_bf16(o1[4 * k], o1[4 * k + 1]); w1.y = cvt_pk_bf16(o1[4 * k + 2], o1[4 * k + 3]);
            *(u32x2*)(op + 8 * k) = w0; *(u32x2*)(op + 32 + 8 * k) = w1; }
    }
}

__device__ __forceinline__ unsigned sortable(float f) { const unsigned u = __builtin_bit_cast(unsigned, f); return (u & 0x80000000u) ? ~u : (u | 0x80000000u); }
__device__ __forceinline__ int wave_total(int v) {
    v += __builtin_amdgcn_update_dpp(0, v, 0xB1, 0xf, 0xf, true);
    v += __builtin_amdgcn_update_dpp(0, v, 0x4E, 0xf, 0xf, true);
    v += __builtin_amdgcn_update_dpp(0, v, 0x141, 0xf, 0xf, true);
    v += __builtin_amdgcn_update_dpp(0, v, 0x140, 0xf, 0xf, true);
    return __builtin_amdgcn_readlane(v, 0) + __builtin_amdgcn_readlane(v, 16) + __builtin_amdgcn_readlane(v, 32) + __builtin_amdgcn_readlane(v, 48);
}
__device__ __forceinline__ void topk_emit(const unsigned (&key)[32], unsigned thr, LAS unsigned* maskrow, int lane) {
    int cg = 0, ce = 0;
#pragma unroll
    for (int j = 0; j < 32; ++j) { cg += (key[j] > thr) ? 1 : 0; ce += (key[j] == thr) ? 1 : 0; }
    const int need = 256 - wave_total(cg), neq = wave_total(ce);
    unsigned myword = 0u;
    if (neq <= need) {
#pragma unroll
        for (int j = 0; j < 32; ++j) { const unsigned long long sel = __ballot(key[j] >= thr);
            if (lane == 2 * j) myword = (unsigned)sel;
            if (lane == 2 * j + 1) myword = (unsigned)(sel >> 32); }
    } else {
        int run = 0; const unsigned long long lt = (1ull << lane) - 1ull;
#pragma unroll
        for (int j = 0; j < 32; ++j) {
            const unsigned long long eq = __ballot(key[j] == thr), gt = __ballot(key[j] > thr);
            const bool tie_sel = (key[j] == thr) && (run + __popcll(eq & lt) < need);
            const unsigned long long sel = gt | __ballot(tie_sel);
            run += __popcll(eq);
            if (lane == 2 * j) myword = (unsigned)sel;
            if (lane == 2 * j + 1) myword = (unsigned)(sel >> 32);
        }
    }
    maskrow[lane] = myword;
}
__device__ __forceinline__ void topk_select2(const unsigned (&ka)[32], const unsigned (&kb)[32], LAS unsigned* maska, LAS unsigned* maskb, int lane) {
    unsigned ta = 0u, tb = 0u;
    for (int bit = 31; bit >= 0; --bit) {
        const unsigned ca = ta | (1u << bit), cb = tb | (1u << bit); int na = 0, nb = 0;
#pragma unroll
        for (int j = 0; j < 32; ++j) { na += (ka[j] >= ca) ? 1 : 0; nb += (kb[j] >= cb) ? 1 : 0; }
        if (wave_total(na) >= 256) ta = ca;
        if (wave_total(nb) >= 256) tb = cb;
    }
    topk_emit(ka, ta, maska, lane); topk_emit(kb, tb, maskb, lane);
}
__device__ __forceinline__ int t5_bucket(int d) {
    if (d < 16) return d;
    int bkt = 16;
    bkt += (d >= 19); bkt += (d >= 21); bkt += (d >= 24); bkt += (d >= 27); bkt += (d >= 31); bkt += (d >= 35); bkt += (d >= 40); bkt += (d >= 46);
    bkt += (d >= 52); bkt += (d >= 59); bkt += (d >= 67); bkt += (d >= 77); bkt += (d >= 87); bkt += (d >= 99); bkt += (d >= 113);
    return bkt;
}
constexpr int SC_STRIDE = 2052;
__device__ __forceinline__ void phase_strip(Frame& F, int l) {
    LAS unsigned* SCB = (LAS unsigned*)F.lds;
    LAS unsigned* MSK = (LAS unsigned*)(F.lds + MISC_OFF + 2048);
    LAS float* LUT = (LAS float*)(F.lds + MISC_OFF + 2048 + 4224);
    LAS float* MB = (LAS float*)(F.lds + MISC_OFF + 2048 + 4224 + 3712);
    const bf16_t* qi = (const bf16_t*)(F.ws + WS_QI); const bf16_t* ki = (const bf16_t*)(F.ws + WS_KI); const float* wi = (const float*)(F.ws + WS_WI);
    const bf16_t* qb = (const bf16_t*)(F.ws + WS_QB); const bf16_t* kbp = (const bf16_t*)(F.ws + WS_KB); const bf16_t* vbT = (const bf16_t*)(F.ws + WS_VBT);
    bf16_t* oab = (bf16_t*)(F.ws + WS_OAB);
    const float* relb = F.in(IN_RELB);
    for (int i = F.tid; i < 8 * 114; i += NTHR) { const int h = i / 114, d = i % 114; LUT[i] = relb[t5_bucket(d) * 8 + h]; }
    if (F.tid < 8) { const float* qg = F.in(IN_QNG) + l * 64; const float* kg = F.in(IN_KNG) + l * 64; float gq = 0.f, gk = 0.f, bm = -1e30f;
        for (int d = 0; d < 64; ++d) { gq = fmaxf(gq, fabsf(qg[d])); gk = fmaxf(gk, fabsf(kg[d])); }
        for (int k = 0; k < 32; ++k) bm = fmaxf(bm, relb[k * 8 + F.tid]);
        MB[F.tid] = 8.1f * gq * gk + bm; }
    __syncthreads();
    const int w = F.wave;
    for (int vc = F.blk; vc < 256; vc += F.G) {
        const int b = vc & 7, jj = vc >> 3; const size_t rowb = (size_t)b * SEQ;
        for (int it = 0; it < 4; ++it) {
            int lane = F.lane; asm volatile("" : "+v"(lane)); const int q = lane & 15, g = lane >> 4;
            const int si = it == 0 ? jj : (it == 1 ? 63 - jj : (it == 2 ? 64 + jj : 127 - jj)); const int t0 = 16 * si;
            if (si < 16) {
                for (int idx = F.tid; idx < 16 * 64; idx += NTHR) { const int nb = t0 + (idx >> 6) + 1 - 32 * (idx & 63); MSK[(idx >> 6) * 65 + (idx & 63)] = nb >= 32 ? 0xffffffffu : (nb <= 0 ? 0u : ((1u << nb) - 1u)); }
            } else {
                bf16x8 qif[8][2]; float wq[8];
#pragma unroll
                for (int h = 0; h < 8; ++h) { wq[h] = wi[(rowb + t0 + q) * 8 + h];
#pragma unroll
                    for (int ks = 0; ks < 2; ++ks) qif[h][ks] = *(const bf16x8*)(qi + (rowb + t0 + q) * 512 + h * 64 + 32 * ks + 8 * g); }
                const bf16_t* kpb = ki + (rowb + 16 * w + q) * 64 + 8 * g;
                const int ntw = (si - w) / 8 + 1;
                bf16x8 ka0, ka1, kb0, kb1, kc0, kc1;
#define IDX_LOAD(K0, K1, n) do { K0 = *(const bf16x8*)(kpb + (size_t)(128 * (n)) * 64); K1 = *(const bf16x8*)(kpb + (size_t)(128 * (n)) * 64 + 32); } while (0)
#define IDX_TILE(K0, K1, n) do { const bf16x8 kf0 = K0, kf1 = K1; const int kt = w + 8 * (n); if ((n) + 3 < ntw) IDX_LOAD(K0, K1, (n) + 3); \
                    f32x4 sc = (f32x4){0.f, 0.f, 0.f, 0.f}; \
                    _Pragma("unroll") for (int h = 0; h < 8; ++h) { f32x4 d = __builtin_amdgcn_mfma_f32_16x16x32_bf16(kf0, qif[h][0], (f32x4){0.f, 0.f, 0.f, 0.f}, 0, 0, 0); \
                        d = __builtin_amdgcn_mfma_f32_16x16x32_bf16(kf1, qif[h][1], d, 0, 0, 0); \
                        _Pragma("unroll") for (int i = 0; i < 4; ++i) sc[i] += wq[h] * fmaxf(d[i], 0.f); } \
                    u32x4 key; \
                    _Pragma("unroll") for (int i = 0; i < 4; ++i) key[i] = (16 * kt + 4 * g + i <= t0 + q) ? sortable(sc[i] + 0.f) : 0u; \
                    *(LAS u32x4*)(SCB + q * SC_STRIDE + 16 * kt + 4 * g) = key; } while (0)
                IDX_LOAD(ka0, ka1, 0); if (1 < ntw) IDX_LOAD(kb0, kb1, 1); if (2 < ntw) IDX_LOAD(kc0, kc1, 2);
                for (int n = 0; n < ntw; n += 3) { IDX_TILE(ka0, ka1, n); if (n + 1 < ntw) IDX_TILE(kb0, kb1, n + 1); if (n + 2 < ntw) IDX_TILE(kc0, kc1, n + 2); }
#undef IDX_LOAD
#undef IDX_TILE
                __syncthreads();
                const int nk = 16 * (si + 1);
                { unsigned kA[32], kB[32];
#pragma unroll
                    for (int j = 0; j < 32; ++j) { const int sx = lane + 64 * j; kA[j] = (sx < nk) ? SCB[(2 * w) * SC_STRIDE + sx] : 0u; kB[j] = (sx < nk) ? SCB[(2 * w + 1) * SC_STRIDE + sx] : 0u; }
                    topk_select2(kA, kB, MSK + (2 * w) * 65, MSK + (2 * w + 1) * 65, lane); }
            }
            __syncthreads();
            {
                const int h = w, t = t0 + q;
                bf16x8 qf[2];
#pragma unroll
                for (int ks = 0; ks < 2; ++ks) qf[ks] = *(const bf16x8*)(qb + (rowb + t) * 512 + h * 64 + 32 * ks + 8 * g);
                f32x4 o[4];
#pragma unroll
                for (int dt = 0; dt < 4; ++dt) o[dt] = (f32x4){0.f, 0.f, 0.f, 0.f};
                float l = 0.f;
                const float mb = MB[h], cfar = LUT[h * 114 + 113] - mb;
                const int nch = (t0 + 15) / 32 + 1, nst = (t0 + 15) / 128 + 1;
                constexpr int STG = 35840, VOFF = 18432;
                const bf16_t* gk0 = kbp + (rowb + (F.tid >> 3)) * 64 + 8 * (F.tid & 7);
                const bf16_t* gv0 = vbT + (size_t)(F.tid >> 4) * T + rowb + 8 * (F.tid & 15);
                const int dk0 = (F.tid >> 3) * 144 + (F.tid & 7) * 16, dv0 = VOFF + (F.tid >> 4) * 272 + (F.tid & 15) * 16;
                u32x4 ra[4], rb4[4];
#define DSA_LOAD(R, st) do { R[0] = *(const u32x4*)(gk0 + (size_t)(128 * (st)) * 64); R[1] = *(const u32x4*)(gk0 + (size_t)(128 * (st) + 64) * 64); \
                    R[2] = *(const u32x4*)(gv0 + 128 * (st)); R[3] = *(const u32x4*)(gv0 + (size_t)32 * T + 128 * (st)); } while (0)
#define DSA_PUT(R, st) do { LAS unsigned char* sp_ = F.lds + ((st) % 3) * STG; *(LAS u32x4*)(sp_ + dk0) = R[0]; *(LAS u32x4*)(sp_ + dk0 + 64 * 144) = R[1]; \
                    *(LAS u32x4*)(sp_ + dv0) = R[2]; *(LAS u32x4*)(sp_ + dv0 + 32 * 272) = R[3]; } while (0)
                DSA_LOAD(ra, 0); if (nst > 1) DSA_LOAD(rb4, 1);
                DSA_PUT(ra, 0); if (nst > 2) DSA_LOAD(ra, 2);
                asm volatile("s_waitcnt lgkmcnt(0)" ::: "memory"); __builtin_amdgcn_s_barrier(); asm volatile("" ::: "memory");
#define DSA_STAGE(st, RN) do { \
                    if ((st) + 1 < nst) { DSA_PUT(RN, (st) + 1); if ((st) + 3 < nst) DSA_LOAD(RN, (st) + 3); } \
                    const LAS unsigned char* stg = F.lds + ((st) % 3) * STG; \
                    _Pragma("unroll") for (int cc = 0; cc < 4; ++cc) { const int c = 4 * (st) + cc; if (c < nch) { \
                        bf16x8 kf[2][2]; u32x2 vf[4][2]; \
                        _Pragma("unroll") for (int tl = 0; tl < 2; ++tl) _Pragma("unroll") for (int ks = 0; ks < 2; ++ks) kf[tl][ks] = *(const LAS bf16x8*)(stg + (32 * cc + 16 * tl + q) * 144 + 16 * g + 64 * ks); \
                        _Pragma("unroll") for (int dt = 0; dt < 4; ++dt) _Pragma("unroll") for (int hf = 0; hf < 2; ++hf) vf[dt][hf] = *(const LAS u32x2*)(stg + VOFF + (16 * dt + q) * 272 + 64 * cc + 8 * g + 32 * hf); \
                        const unsigned mw = MSK[q * 65 + c]; \
                        const bool farc = (t0 - (32 * c + 31)) >= 113; \
                        const float ci = farc ? cfar : -mb; \
                        f32x4 s0 = __builtin_amdgcn_mfma_f32_16x16x32_bf16(kf[0][0], qf[0], (f32x4){ci, ci, ci, ci}, 0, 0, 0); \
                        s0 = __builtin_amdgcn_mfma_f32_16x16x32_bf16(kf[0][1], qf[1], s0, 0, 0, 0); \
                        f32x4 s1 = __builtin_amdgcn_mfma_f32_16x16x32_bf16(kf[1][0], qf[0], (f32x4){ci, ci, ci, ci}, 0, 0, 0); \
                        s1 = __builtin_amdgcn_mfma_f32_16x16x32_bf16(kf[1][1], qf[1], s1, 0, 0, 0); \
                        if (!farc) { \
                            _Pragma("unroll") for (int i = 0; i < 4; ++i) { const int k0 = 32 * c + 4 * g + i, k1 = k0 + 16; \
                                int d0 = t - k0, d1 = t - k1; d0 = d0 < 0 ? 0 : (d0 > 113 ? 113 : d0); d1 = d1 < 0 ? 0 : (d1 > 113 ? 113 : d1); \
                                s0[i] += LUT[h * 114 + d0]; s1[i] += LUT[h * 114 + d1]; } } \
                        float p[8]; \
                        _Pragma("unroll") for (int i = 0; i < 4; ++i) { p[i] = ((mw >> (4 * g + i)) & 1u) ? __expf(s0[i]) : 0.f; p[4 + i] = ((mw >> (16 + 4 * g + i)) & 1u) ? __expf(s1[i]) : 0.f; } \
                        l += ((p[0] + p[1]) + (p[2] + p[3])) + ((p[4] + p[5]) + (p[6] + p[7])); \
                        const bf16x8 pf = pack_bf16x8(p[0], p[1], p[2], p[3], p[4], p[5], p[6], p[7]); \
                        _Pragma("unroll") for (int dt = 0; dt < 4; ++dt) { \
                            const bf16x8 vfr = __builtin_bit_cast(bf16x8, (u32x4){vf[dt][0].x, vf[dt][0].y, vf[dt][1].x, vf[dt][1].y}); \
                            o[dt] = __builtin_amdgcn_mfma_f32_16x16x32_bf16(vfr, pf, o[dt], 0, 0, 0); } } } \
                    asm volatile("s_waitcnt lgkmcnt(0)" ::: "memory"); __builtin_amdgcn_s_barrier(); asm volatile("" ::: "memory"); } while (0)
                for (int st = 0; st < nst; st += 2) { DSA_STAGE(st, rb4); if (st + 1 < nst) DSA_STAGE(st + 1, ra); }
#undef DSA_STAGE
#undef DSA_LOAD
#undef DSA_PUT
                l += __shfl_xor(l, 16); l += __shfl_xor(l, 32);
                const float il = 1.f / l;
                bf16_t* op = oab + (rowb + t) * 1024 + 512 + h * 64 + 4 * g;
#pragma unroll
                for (int dt = 0; dt < 4; ++dt) { u32x2 wv; wv.x = cvt_pk_bf16(o[dt][0] * il, o[dt][1] * il); wv.y = cvt_pk_bf16(o[dt][2] * il, o[dt][3] * il); *(u32x2*)(op + 16 * dt) = wv; }
            }
            __syncthreads();
        }
    }
}

__device__ __forceinline__ void phase_h2_route(Frame& F, int l) {
    LAS float* Av = (LAS float*)F.lds; LAS float* Sv = Av + DM;
    LAS float* RW = (LAS float*)(F.lds + 8192);
    LAS float* RB = (LAS float*)(F.lds + 73728);
    LAS int* lcnt = (LAS int*)(F.lds + 73728 + 64);
    LAS int* lbase = (LAS int*)(F.lds + 73728 + 128);
    LAS int* rinfo = (LAS int*)(F.lds + 73728 + 256);
    const float* mod = (const float*)(F.ws + WS_MOD) + (size_t)l * BATCH * NMOD;
    const int rows_per_blk = T / F.G, row_base = F.blk * rows_per_blk, b = row_base / SEQ;
    const float* n2g = F.in(IN_N2G); const float* rwp = F.in(IN_RW); const float* rbp = F.in(IN_RB);
    for (int d = F.tid; d < DM; d += NTHR) { Av[d] = n2g[l * DM + d] * (1.f + mod[(size_t)b * NMOD + 4 * DM + d]); Sv[d] = mod[(size_t)b * NMOD + 3 * DM + d]; }
    for (int i = F.tid; i < DM * NE; i += NTHR) RW[(i & 15) * DM + (i >> 4)] = rwp[i];
    if (F.tid < NE) { RB[F.tid] = rbp[F.tid]; lcnt[F.tid] = 0; }
    __syncthreads();
    bf16_t* hb = (bf16_t*)(F.ws + WS_H);
    const int rows_per_wave = rows_per_blk / NWAVES;
    for (int i = 0; i < rows_per_wave; ++i) {
        const int lr = F.wave * rows_per_wave + i, row = row_base + lr;
        f32x4 v[4]; float ss = 0.f;
#pragma unroll
        for (int j = 0; j < 4; ++j) { v[j] = *(const f32x4*)(F.out + (size_t)row * DM + 4 * F.lane + 256 * j); ss += (v[j][0] * v[j][0] + v[j][1] * v[j][1]) + (v[j][2] * v[j][2] + v[j][3] * v[j][3]); }
        const float r = 1.0f / sqrtf(wave_sum(ss) * (1.0f / DM) + EPS);
        float lg[NE];
#pragma unroll
        for (int e = 0; e < NE; ++e) lg[e] = 0.f;
#pragma unroll
        for (int j = 0; j < 4; ++j) { const int c0 = 4 * F.lane + 256 * j; u32x2 w;
#pragma unroll
            for (int k = 0; k < 4; ++k) v[j][k] = v[j][k] * r * Av[c0 + k] + Sv[c0 + k];
#pragma unroll
            for (int e = 0; e < NE; ++e) { const f32x4 rw = *(const LAS f32x4*)(RW + e * DM + c0);
                lg[e] += (v[j][0] * rw[0] + v[j][1] * rw[1]) + (v[j][2] * rw[2] + v[j][3] * rw[3]); }
            w.x = pk2(v[j][0], v[j][1]); w.y = pk2(v[j][2], v[j][3]);
            *(u32x2*)(hb + (size_t)row * DM + c0) = w; }
        float mxl = -1e30f;
#pragma unroll
        for (int e = 0; e < NE; ++e) { lg[e] = wave_sum(lg[e]) + RB[e]; mxl = fmaxf(mxl, lg[e]); }
        float pr[NE], den = 0.f;
#pragma unroll
        for (int e = 0; e < NE; ++e) { pr[e] = expf(lg[e] - mxl); den += pr[e]; }
        const float iden = 1.f / den;
#pragma unroll
        for (int e = 0; e < NE; ++e) pr[e] *= iden;
        int bg = 0; float bs = -1.f, bv0 = 0.f, bv1 = 0.f; int bi0 = 0, bi1 = 1;
#pragma unroll
        for (int g = 0; g < 4; ++g) {
            float v0 = pr[4 * g], v1 = -1.f; int i0 = 0, i1 = -1;
#pragma unroll
            for (int k = 1; k < 4; ++k) { const float p = pr[4 * g + k];
                if (p > v0) { v1 = v0; i1 = i0; v0 = p; i0 = k; } else if (p > v1) { v1 = p; i1 = k; } }
            const float gs = v0 + v1;
            if (gs > bs) { bs = gs; bg = g; bv0 = v0; bv1 = v1; bi0 = i0; bi1 = i1; }
        }
        const int e0 = bg * 4 + bi0, e1 = bg * 4 + bi1; const float wsum = bv0 + bv1, w0 = bv0 / wsum, w1 = bv1 / wsum;
        if (F.lane == 0) { const int p0 = __hip_atomic_fetch_add(lcnt + e0, 1, __ATOMIC_RELAXED, __HIP_MEMORY_SCOPE_WORKGROUP), p1 = __hip_atomic_fetch_add(lcnt + e1, 1, __ATOMIC_RELAXED, __HIP_MEMORY_SCOPE_WORKGROUP);
            rinfo[lr * 6 + 0] = e0; rinfo[lr * 6 + 1] = p0; rinfo[lr * 6 + 2] = __float_as_int(w0); rinfo[lr * 6 + 3] = e1; rinfo[lr * 6 + 4] = p1; rinfo[lr * 6 + 5] = __float_as_int(w1); }
    }
    __syncthreads();
    unsigned* gcnt = F.ctl + CW_GCNT + 64 * l;
    if (F.tid < NE) lbase[F.tid] = (int)__hip_atomic_fetch_add(gcnt + F.tid, (unsigned)lcnt[F.tid], RLX_AGENT);
    __syncthreads();
    int* etok = (int*)(F.ws + WS_ETOK); float* ew = (float*)(F.ws + WS_EW); int* edst = (int*)(F.ws + WS_EDST);
    if (F.tid < 2 * rows_per_blk) { const int lr = F.tid >> 1, k = F.tid & 1; const int e = rinfo[lr * 6 + 3 * k], p = rinfo[lr * 6 + 3 * k + 1]; const float w = __int_as_float(rinfo[lr * 6 + 3 * k + 2]);
        const int slot = lbase[e] + p, tok = row_base + lr;
        etok[e * T + slot] = tok; ew[e * T + slot] = w; edst[e * T + slot] = 2 * tok + k; }
}

__device__ __forceinline__ int moe_table(Frame& F, int l, LAS int* tile_end) {
    if (F.tid < 64) { const int e = F.lane & 15; const int n = (int)__hip_atomic_load(F.ctl + CW_GCNT + 64 * l + e, RLX_AGENT); int tiles = (n + 255) >> 8, cum = tiles;
#pragma unroll
        for (int o = 1; o < 16; o <<= 1) { const int v = __shfl_up(cum, o, 16); if (e >= o) cum += v; }
        if (F.lane < 16) { tile_end[e] = cum; tile_end[16 + e] = n; } }
    __syncthreads();
    return tile_end[15];
}
#define XB_TMO      128
#define XB_XCNT(j)  (256  + 64 * (j))
#define XB_XSUB(j)  (1280 + 64 * (j))
#define XB_XGEN(j)  (2304 + 64 * (j))
#define XB_TOP      3328
#define XB_TOPGEN   3392
#define XCD_BAR_WORDS 3456
#define XB_SPIN_CAP (1u << 20)
__device__ __forceinline__ unsigned xb_ld(unsigned* p)              { return __hip_atomic_load(p, __ATOMIC_RELAXED, __HIP_MEMORY_SCOPE_AGENT); }
__device__ __forceinline__ unsigned xb_add(unsigned* p, unsigned v) { return __hip_atomic_fetch_add(p, v, __ATOMIC_RELAXED, __HIP_MEMORY_SCOPE_AGENT); }
__device__ __forceinline__ unsigned xb_xcc_id() { return (unsigned)__builtin_amdgcn_s_getreg((3 << 11) | 20) & 0xFu; }
#define XB_SPIN(cond, bar) do { unsigned _sp = 0; while (cond) { __builtin_amdgcn_s_sleep(1); \
    if ((++_sp & 255u) == 0u) { if (xb_ld(&(bar)[XB_TMO])) break; if (_sp > XB_SPIN_CAP) { atomicAdd(&(bar)[XB_TMO], 1u); break; } } } } while (0)
struct XcdBarrier { unsigned* bar; unsigned x; volatile LAS unsigned* st; };
__device__ __forceinline__ XcdBarrier xcd_barrier_post(unsigned* bar, volatile LAS unsigned* st) {
    XcdBarrier b; b.bar = bar; b.x = xb_xcc_id(); b.st = st;
    if (threadIdx.x == 0) (void)xb_add(&bar[XB_XCNT(b.x)], 1u);
    return b;
}
__device__ __forceinline__ void xcd_barrier_complete(unsigned* bar, unsigned x, unsigned& nloc, unsigned& nx) {
    const unsigned G = gridDim.x * gridDim.y * gridDim.z;
    unsigned sum, cnt, mine, sp = 0u;
    for (;;) {
        sum = 0u; cnt = 0u; mine = 0u;
#pragma unroll
        for (unsigned j = 0; j < 16; ++j) { const unsigned c = xb_ld(&bar[XB_XCNT(j)]); sum += c; cnt += (c > 0u) ? 1u : 0u; mine = (j == x) ? c : mine; }
        if (sum == G) break;
        __builtin_amdgcn_s_sleep(1);
        if ((++sp & 255u) == 0u) { if (xb_ld(&bar[XB_TMO])) break; if (sp > XB_SPIN_CAP) { atomicAdd(&bar[XB_TMO], 1u); break; } }
    }
    nloc = mine > 0u ? mine : 1u; nx = cnt > 0u ? cnt : 1u;
}
__device__ __forceinline__ void xcd_barrier(const XcdBarrier& b) {
    asm volatile("s_waitcnt vmcnt(0)" ::: "memory");
    __syncthreads();
    if (threadIdx.x == 0) {
        unsigned* bar = b.bar;
        __builtin_amdgcn_s_waitcnt(0);
        unsigned nloc = b.st[0], nx = b.st[1];
        if (nloc == 0u) { xcd_barrier_complete(bar, b.x, nloc, nx); b.st[0] = nloc; b.st[1] = nx; }
        const unsigned old = xb_add(&bar[XB_XSUB(b.x)], 1u);
        const unsigned gen = old / nloc;
        if (old + 1u == (gen + 1u) * nloc) {
            __builtin_amdgcn_fence(__ATOMIC_RELEASE, "agent");
            asm volatile("s_waitcnt vmcnt(0)" ::: "memory");
            const unsigned og = xb_add(&bar[XB_TOP], 1u);
            const unsigned tg = og / nx;
            if (og + 1u == (tg + 1u) * nx) xb_add(&bar[XB_TOPGEN], 1u);
            else XB_SPIN(xb_ld(&bar[XB_TOPGEN]) == tg, bar);
            __builtin_amdgcn_fence(__ATOMIC_ACQUIRE, "agent");
            xb_add(&bar[XB_XGEN(b.x)], 1u);
            asm volatile("s_waitcnt vmcnt(0)" ::: "memory");
        } else {
            XB_SPIN(xb_ld(&bar[XB_XGEN(b.x)]) == gen, bar);
            __builtin_amdgcn_fence(__ATOMIC_ACQUIRE, "agent");
            asm volatile("s_waitcnt vmcnt(0)" ::: "memory");
        }
    }
    __syncthreads();
}

constexpr int PH_PER_LAYER = 8, PH_FINAL = 1 + PH_PER_LAYER * DEPTH, N_PHASES = PH_FINAL + 1;
__global__ void __launch_bounds__(NTHR, 2) fwd_kernel(Args args) {
    extern __shared__ __attribute__((aligned(16))) unsigned char lds_raw[];
    Frame F;
    F.lds = (LAS unsigned char*)lds_raw;
    F.tid = threadIdx.x; F.lane = F.tid & 63; F.wave = __builtin_amdgcn_readfirstlane(F.tid >> 6); F.G = gridDim.x; F.blk = blockIdx.x;
    F.out = args.out; F.ws = args.ws; F.ctl = (unsigned*)(args.ws + WS_CTL);
    volatile LAS unsigned* MISC = (volatile LAS unsigned*)(F.lds + MISC_OFF);
    for (int u = F.tid; u < (LDS_BYTES - MISC_OFF) / 4; u += NTHR) ((LAS unsigned*)(F.lds + MISC_OFF))[u] = 0u;
    __syncthreads();
    if (F.tid < 36) ((LAS unsigned*)(F.lds + MISC_OFF + 1024))[F.tid] = ((const unsigned*)__builtin_amdgcn_kernarg_segment_ptr())[F.tid];
    __syncthreads();
    const int lo = args.ph_lo, hi = args.ph_hi;
    XcdBarrier bar; bar.bar = F.ctl + CW_BAR; bar.x = 0; bar.st = nullptr;
    if (hi - lo > 1) bar = xcd_barrier_post(F.ctl + CW_BAR, MISC + 8);
#define SEAM(k) do { if ((k) + 1 < hi) xcd_barrier(bar); } while (0)
    for (int ph = lo; ph < hi; ++ph) {
        { int t_ = threadIdx.x; asm volatile("" : "+v"(t_)); F.tid = t_; F.lane = t_ & 63; F.wave = __builtin_amdgcn_readfirstlane(t_ >> 6);
          unsigned char* w_ = args.ws; asm volatile("" : "+s"(w_)); F.ws = w_; F.ctl = (unsigned*)(w_ + WS_CTL); float* o_ = args.out; asm volatile("" : "+s"(o_)); F.out = o_; }
        if (ph == 0) { phase_prologue(F); }
        else if (ph == PH_FINAL) { phase_rows(F, DEPTH, 2); }
        else {
            const int l = (ph - 1) / PH_PER_LAYER, s = (ph - 1) % PH_PER_LAYER;
            bf16_t* hb = (bf16_t*)(F.ws + WS_H);
            if (s == 0) { phase_rows(F, l, l == 0 ? 0 : 1); }
            else if (s == 1) {
                { pg8::Gemm g{hb, (const bf16_t*)(F.ws + WS_WIN + l * WIN_LAYER), nullptr}; pg8::StaticOrder S; S.init(T, NMAIN, F.G, F.blk);
                  EpiIn E{(bf16_t*)(F.ws + WS_QA), (bf16_t*)(F.ws + WS_KA), (bf16_t*)(F.ws + WS_QB), (bf16_t*)(F.ws + WS_QI), (bf16_t*)(F.ws + WS_KB), (bf16_t*)(F.ws + WS_VBT), (bf16_t*)(F.ws + WS_KI),
                          (bf16_t*)(F.ws + WS_SGA), (bf16_t*)(F.ws + WS_SGB), (float*)(F.ws + WS_WI), F.in(IN_QNG) + l * 64, F.in(IN_KNG) + l * 64};
                  pg8::gemm_phase<1024, 1024, 1024, EpiIn, pg8::StaticOrder, true>(F.lds, g, S, E); }
                { pg8::Gemm g{(const bf16_t*)(F.ws + WS_WIN + l * WIN_LAYER) + (size_t)NMAIN * 1024, hb, nullptr}; pg8::StaticOrder S; S.init(512, T, F.G, (F.blk + F.G / 2) % F.G);
                  EpiPlain E{(bf16_t*)(F.ws + WS_VAT), T};
                  pg8::gemm_phase<1024, 1024, 1024, EpiPlain, pg8::StaticOrder, true>(F.lds, g, S, E); }
            }
            else if (s == 2) { phase_strip(F, l); phase_sb(F); }
            else if (s == 3) {
                pg8::Gemm g{(const bf16_t*)(F.ws + WS_OAB), (const bf16_t*)(F.ws + WS_WO) + (size_t)l * 1024 * 1024, nullptr}; pg8::StaticOrder S; S.init(T, 1024, F.G, F.blk);
                EpiMerge E{(bf16_t*)(F.ws + WS_MERGED), (const bf16_t*)(F.ws + WS_SGA), (const bf16_t*)(F.ws + WS_SGB)};
                pg8::gemm_phase<1024, 1024, 1024, EpiMerge, pg8::StaticOrder, true, false, true>(F.lds, g, S, E);
            }
            else if (s == 4) {
                pg8::Gemm g{(const bf16_t*)(F.ws + WS_MERGED), (const bf16_t*)(F.ws + WS_WOUT) + (size_t)l * 1024 * 1024, nullptr}; pg8::StaticOrder S; S.init(T, 1024, F.G, F.blk);
                EpiOut E{l == 0 ? F.in(IN_X) : F.out, F.out, (const float*)(F.ws + WS_MOD) + (size_t)l * BATCH * NMOD + 2 * DM};
                pg8::gemm_phase<1024, 1024, 1024, EpiOut, pg8::StaticOrder, true>(F.lds, g, S, E);
            }
            else if (s == 5) { phase_h2_route(F, l); }
            else if (s == 6 || s == 7) {
                LAS int* tile_end = (LAS int*)(F.lds + MISC_OFF + 512);
                const int ntiles = moe_table(F, l, tile_end);
                MoeOrder S{tile_end, ntiles, F.G, F.blk};
                if (s == 6) { pg8::Gemm g{(const bf16_t*)(F.ws + WS_H), (const bf16_t*)(F.ws + WS_WGU), (const int*)(F.ws + WS_ETOK)};
                    EpiMoe1 E{(bf16_t*)(F.ws + WS_HID), (const float*)(F.ws + WS_EW)};
                    pg8::gemm_phase<1024, 1024, 1024, EpiMoe1, MoeOrder, true, true>(F.lds, g, S, E); }
                else { pg8::Gemm g{(const bf16_t*)(F.ws + WS_HID), (const bf16_t*)(F.ws + WS_WD), nullptr};
                    EpiMoe2 E{(bf16_t*)(F.ws + WS_Y), (const int*)(F.ws + WS_EDST)};
                    pg8::gemm_phase<512, 512, 512, EpiMoe2, MoeOrder, true>(F.lds, g, S, E); }
            }
        }
        __syncthreads();
        SEAM(ph);
    }
#undef SEAM
}

extern "C" void kernel_launch(void* const* d_in, const int* in_sizes, int n_in, void* d_out, int out_size, void* d_ws, size_t ws_size, hipStream_t stream) {
    static int grid = 0;
    if (grid == 0) {
        if (n_in != 18 || out_size != T * DM || ws_size < WS_END) { fprintf(stderr, "kernel_launch: unexpected problem (n_in %d, out %d, ws %zu)\n", n_in, out_size, ws_size); grid = -1; return; }
        int dev = 0, cus = 0;
        if (hipGetDevice(&dev) != hipSuccess || hipDeviceGetAttribute(&cus, hipDeviceAttributeMultiprocessorCount, dev) != hipSuccess) { grid = -1; return; }
        if (hipFuncSetAttribute((const void*)fwd_kernel, hipFuncAttributeMaxDynamicSharedMemorySize, LDS_BYTES) != hipSuccess) { fprintf(stderr, "kernel_launch: hipFuncSetAttribute failed\n"); grid = -1; return; }
        (void)hipGetLastError();
        grid = cus;
        if (grid != 256) fprintf(stderr, "kernel_launch: %d CUs (built for 256)\n", grid);
    }
    if (grid < 0) return;
    (void)hipMemsetAsync((char*)d_ws + WS_CTL, 0, CTL_ZERO_BYTES, stream);
    Args a{};
    for (int i = 0; i < 18; ++i) a.in[i] = (const float*)d_in[i];
    a.out = (float*)d_out; a.ws = (unsigned char*)d_ws;
#if ONE_LAUNCH
    a.ph_lo = 0; a.ph_hi = N_PHASES;
    hipLaunchKernelGGL(fwd_kernel, dim3(grid), dim3(NTHR), LDS_BYTES, stream, a);
#else
    for (int ph = 0; ph < N_PHASES; ++ph) {
        const int s = ph == 0 || ph == PH_FINAL ? -1 : (ph - 1) % PH_PER_LAYER;
        (void)s;
        a.ph_lo = ph; a.ph_hi = ph + 1;
        hipLaunchKernelGGL(fwd_kernel, dim3(grid), dim3(NTHR), LDS_BYTES, stream, a);
    }
#endif
}
```

```cpp
#include <hip/hip_runtime.h>
#include <cstdio>
#include <cstdint>

#define LAS __attribute__((address_space(3)))
#define GAS __attribute__((address_space(1)))
typedef unsigned short bf16_t;
typedef short bf16x8 __attribute__((ext_vector_type(8)));
typedef float f32x4 __attribute__((ext_vector_type(4)));
typedef float f32x2 __attribute__((ext_vector_type(2)));
typedef unsigned u32x4 __attribute__((ext_vector_type(4)));
typedef unsigned u32x2 __attribute__((ext_vector_type(2)));

constexpr int BATCH = 8, SEQ = 2048, DM = 1024, T = BATCH * SEQ, DEPTH = 2;
constexpr int NIN = 4808, NMOD = 6 * DM;
constexpr int NE = 16, DEXP = 512;
constexpr int NMAIN = 4352;
constexpr int PMAX = 36864;
constexpr float EPS = 1e-6f;
constexpr int NWAVES = 8, NTHR = 512;

#ifndef ONE_LAUNCH
#define ONE_LAUNCH 1
#endif

constexpr size_t MiB = 1u << 20;
constexpr size_t WS_CTL = 0, CTL_ZERO_BYTES = 1 * MiB;
constexpr size_t WS_MOD = 1 * MiB;
constexpr size_t WS_MODP = 2 * MiB;
constexpr size_t WS_ETOK = 8 * MiB, WS_EW = 9 * MiB, WS_EDST = 10 * MiB;
constexpr size_t WS_SLOTW = 11 * MiB, WS_SLOTD = 11 * MiB + 256 * 1024;
constexpr size_t WS_MASK = 12 * MiB;
constexpr size_t WS_WIN = 16 * MiB;
constexpr size_t WIN_LAYER = (size_t)4864 * 1024 * 2;
constexpr size_t WS_WO = 35 * MiB, WS_WOUT = 39 * MiB;
constexpr size_t WS_WGU = 43 * MiB;
constexpr size_t WS_WD = 75 * MiB;
constexpr size_t WS_H = 92 * MiB;
constexpr size_t WS_QA = 124 * MiB, WS_KA = 140 * MiB, WS_VAT = 156 * MiB, WS_QB = 172 * MiB, WS_QI = 188 * MiB;
constexpr size_t WS_KB = 204 * MiB, WS_VBT = 206 * MiB, WS_KI = 208 * MiB, WS_WI = 210 * MiB;
constexpr size_t WS_SGA = 212 * MiB, WS_SGB = 244 * MiB, WS_OAB = 276 * MiB;
constexpr size_t WS_MERGED = 124 * MiB;
constexpr size_t WS_TMP = 156 * MiB;
constexpr size_t WS_XG = 124 * MiB;
constexpr size_t WS_HID = 196 * MiB;
constexpr size_t WS_Y = 232 * MiB;
constexpr size_t WS_END = 308 * MiB;
constexpr int CW_GCNT = 64;
constexpr int CW_BAR = 4096;

#define LDS_WAIT() asm volatile("s_waitcnt lgkmcnt(0)" ::: "memory")
#define VM_WAIT() asm volatile("s_waitcnt vmcnt(0)" ::: "memory")
#define RLX_AGENT __ATOMIC_RELAXED, __HIP_MEMORY_SCOPE_AGENT
__device__ __forceinline__ unsigned f2bf(float f) { unsigned u = __builtin_bit_cast(unsigned, f); return (u + 0x7fffu + ((u >> 16) & 1u)) >> 16; }
__device__ __forceinline__ unsigned pk2(float lo, float hi) { return f2bf(lo) | (f2bf(hi) << 16); }
__device__ __forceinline__ float bflo(unsigned w) { return __builtin_bit_cast(float, w << 16); }
__device__ __forceinline__ float bfhi(unsigned w) { return __builtin_bit_cast(float, w & 0xffff0000u); }
__device__ __forceinline__ float bf2f(bf16_t h) { return __builtin_bit_cast(float, (unsigned)h << 16); }
__device__ __forceinline__ unsigned cvt_pk_bf16(float lo, float hi) { unsigned r; asm volatile("v_cvt_pk_bf16_f32 %0, %1, %2" : "=v"(r) : "v"(lo), "v"(hi)); return r; }
__device__ __forceinline__ u32x4 pack8(f32x4 a, f32x4 b) { u32x4 w; w.x = cvt_pk_bf16(a[0], a[1]); w.y = cvt_pk_bf16(a[2], a[3]); w.z = cvt_pk_bf16(b[0], b[1]); w.w = cvt_pk_bf16(b[2], b[3]); return w; }
__device__ __forceinline__ float sigmoidf_(float x) { return 1.f / (1.f + __expf(-x)); }
__device__ __forceinline__ float wave_sum(float v) {
    v += __builtin_bit_cast(float, __builtin_amdgcn_update_dpp(0, __builtin_bit_cast(int, v), 0xB1, 0xf, 0xf, true));
    v += __builtin_bit_cast(float, __builtin_amdgcn_update_dpp(0, __builtin_bit_cast(int, v), 0x4E, 0xf, 0xf, true));
    v += __builtin_bit_cast(float, __builtin_amdgcn_update_dpp(0, __builtin_bit_cast(int, v), 0x141, 0xf, 0xf, true));
    v += __builtin_bit_cast(float, __builtin_amdgcn_update_dpp(0, __builtin_bit_cast(int, v), 0x140, 0xf, 0xf, true));
    const float a = __builtin_bit_cast(float, __builtin_amdgcn_readlane(__builtin_bit_cast(int, v), 0)), b = __builtin_bit_cast(float, __builtin_amdgcn_readlane(__builtin_bit_cast(int, v), 16));
    const float c = __builtin_bit_cast(float, __builtin_amdgcn_readlane(__builtin_bit_cast(int, v), 32)), d = __builtin_bit_cast(float, __builtin_amdgcn_readlane(__builtin_bit_cast(int, v), 48));
    return (a + b) + (c + d);
}

namespace pg8 {
constexpr int BM = 256, BK = 64, HALF = 128, HTB = HALF * BK * 2, STAGE_BYTES = 8 * HTB, NXCD = 8, WGM = 8;
__host__ __device__ __forceinline__ int lds_byte(int r, int c) { const int st = (r >> 4) * 2 + (c >> 5), rr = r & 15, cc = c & 31, ob = rr * 64 + cc * 2; return st * 1024 + (ob ^ (((ob >> 9) & 1) << 5)); }
__host__ __device__ __forceinline__ void stage_rc(int b, int& R, int& C) { const int st = b / 1024, sb = b % 1024, swz = sb ^ (((sb >> 9) & 1) << 5); R = (st >> 1) * 16 + swz / 64; C = (st & 1) * 32 + (swz % 64) / 2; }
__host__ __device__ __forceinline__ int perm32(int rho) { const int n = rho >> 4, i = rho & 15; return 8 * (i >> 2) + 4 * n + (i & 3); }

struct Unit { int pm, pn, aux, nv; };
struct Gemm { const bf16_t* A; const bf16_t* Bt; const int* rowidx; };

struct StaticOrder {
    int nM, nN, nwg, G, c;
    __host__ __device__ void init(int M, int N, int G_, int c_) { nM = M / BM; nN = N / BM; nwg = nM * nN; G = G_; c = c_; }
    __host__ __device__ bool next(int i, Unit& u) const {
        const long L = (long)i * G + c; if (L >= nwg) return false;
        int wgid = (int)L; { const int q = nwg / NXCD, r = nwg % NXCD, xcd = wgid % NXCD, off = wgid / NXCD; wgid = (xcd < r ? xcd * (q + 1) : r * (q + 1) + (xcd - r) * q) + off; }
        const int nig = WGM * nN, gid = wgid / nig, fm = gid * WGM, gsz = (nM - fm) < WGM ? (nM - fm) : WGM;
        u.pm = fm + ((wgid % nig) % gsz); u.pn = (wgid % nig) / gsz; return true;
    }
    __device__ __forceinline__ void a_ready(const Unit&) const {}
    __device__ __forceinline__ void done(const Unit&) const {}
};

template <int LDA, int LDB, int KK, class Epi, class Sched, bool ALIGN_EPI, bool GATHER = false, bool MIDHOOK = false>
__device__ __forceinline__ void gemm_phase(LAS unsigned char* lds, const Gemm g, const Sched& S, const Epi& E, int tid) {
    asm volatile("" : "+v"(tid));
    const int wid = __builtin_amdgcn_readfirstlane(tid >> 6), lane = tid & 63, wr = wid >> 2, wc = wid & 3, fr = lane & 15, fq = lane >> 4;
    constexpr int nt = KK / BK;
    unsigned voffA[2], voffB[2];
#pragma unroll
    for (int i = 0; i < 2; ++i) { int R, C; stage_rc(tid * 16 + i * 8192, R, C); const int Rb = Epi::PERM ? ((R & ~31) + perm32(R & 31)) : R;
        voffA[i] = (unsigned)(R * LDA + C) * 2u; voffB[i] = (unsigned)(Rb * LDB + C) * 2u; }
    constexpr size_t kstep = (size_t)(BK * 2);
    constexpr size_t hstepA = (size_t)HALF * LDA * 2, hstepB = (size_t)HALF * LDB * 2;
    constexpr size_t tstepA = 2 * hstepA, tstepB = 2 * hstepB;
    const unsigned ldsw = (unsigned)wid * 1024u;
    const int aoff = lds_byte(wr * 64 + fr, fq * 8), boff = lds_byte(wc * 32 + fr, fq * 8);
#define PG8_SA(b, h) (((b) * 2 + (h)) * HTB)
#define PG8_SB(b, h) ((4 + (b) * 2 + (h)) * HTB)
#define PG8_STAGE(bufoff, gbase, voff) do { _Pragma("unroll") for (int _i = 0; _i < 2; ++_i) \
        __builtin_amdgcn_global_load_lds((const unsigned*)((const char*)(gbase) + (voff)[_i]), (LAS unsigned*)(lds + (bufoff) + ldsw + _i * 8192), 16, 0, 0); } while (0)
    unsigned gaC[2][2], gaN[2][2];
#define PG8_SETGA(ga, u) do { if constexpr (GATHER) { _Pragma("unroll") for (int h_ = 0; h_ < 2; ++h_) _Pragma("unroll") for (int i_ = 0; i_ < 2; ++i_) { int R_, C_; stage_rc(tid * 16 + i_ * 8192, R_, C_); \
        const int idx_ = h_ * HALF + R_; const int tok_ = idx_ < (u).nv ? g.rowidx[(u).aux + idx_] : 0; ga[h_][i_] = (unsigned)tok_ * (unsigned)(LDA * 2) + (unsigned)(C_ * 2); } } } while (0)
#define PG8_STAGE_A(bufoff, ngbase, gkoff, isn, h) do { if constexpr (GATHER) { unsigned vo_[2]; vo_[0] = (isn) ? gaN[h][0] : gaC[h][0]; vo_[1] = (isn) ? gaN[h][1] : gaC[h][1]; \
        PG8_STAGE(bufoff, (const char*)g.A + (gkoff), vo_); } else { PG8_STAGE(bufoff, ngbase, voffA); } } while (0)
#define PG8_LDA(dst, b, h) do { _Pragma("unroll") for (int m = 0; m < 4; ++m) _Pragma("unroll") for (int k = 0; k < 2; ++k) dst[m][k] = *(const LAS bf16x8*)(lds + PG8_SA(b, h) + aoff + m * 2048 + k * 1024); } while (0)
#define PG8_LDB(dst, b, h) do { _Pragma("unroll") for (int n = 0; n < 2; ++n) _Pragma("unroll") for (int k = 0; k < 2; ++k) dst[n][k] = *(const LAS bf16x8*)(lds + PG8_SB(b, h) + boff + n * 2048 + k * 1024); } while (0)
#define PG8_MMA(ai, bj, At, Bt) do { __builtin_amdgcn_s_setprio(1); _Pragma("unroll") for (int m = 0; m < 4; ++m) _Pragma("unroll") for (int n = 0; n < 2; ++n) _Pragma("unroll") for (int k = 0; k < 2; ++k) \
        acc[ai][bj][m][n] = __builtin_amdgcn_mfma_f32_16x16x32_bf16(Bt[n][k], At[m][k], acc[ai][bj][m][n], 0, 0, 0); __builtin_amdgcn_s_setprio(0); } while (0)
#define PG8_WAIT_V(n) asm volatile("s_waitcnt vmcnt(" #n ")" ::: "memory")
#define PG8_WAIT_L(n) asm volatile("s_waitcnt lgkmcnt(" #n ")" ::: "memory")
#define PG8_BAR __builtin_amdgcn_s_barrier()
#define PG8_SCHED __builtin_amdgcn_sched_barrier(0)
    Unit cur, nxt; int ui = 0;
    if (!S.next(0, cur)) return;
    f32x4 acc[2][2][4][2];
#pragma unroll
    for (int a = 0; a < 2; ++a)
#pragma unroll
        for (int b = 0; b < 2; ++b)
#pragma unroll
            for (int m = 0; m < 4; ++m)
#pragma unroll
                for (int n = 0; n < 2; ++n) acc[a][b][m][n] = (f32x4){0.f, 0.f, 0.f, 0.f};
    bf16x8 At[4][2], B0[2][2], B1[2][2];
    const char* cA = (const char*)g.A + (size_t)cur.pm * tstepA; const char* cB = (const char*)g.Bt + (size_t)cur.pn * tstepB;
    S.a_ready(cur);
    PG8_SETGA(gaC, cur);
    if constexpr (GATHER) {
#pragma unroll
        for (int h_ = 0; h_ < 2; ++h_)
#pragma unroll
            for (int i_ = 0; i_ < 2; ++i_) gaN[h_][i_] = gaC[h_][i_]; }
    PG8_STAGE(PG8_SB(0, 0), cB, voffB); PG8_STAGE(PG8_SB(0, 1), cB + hstepB, voffB); PG8_STAGE_A(PG8_SA(0, 0), cA, 0, false, 0); PG8_STAGE_A(PG8_SA(0, 1), cA + hstepA, 0, false, 1);
    if (wr == 1) PG8_BAR;
    PG8_WAIT_V(2); PG8_BAR;
    PG8_STAGE(PG8_SB(1, 0), cB + kstep, voffB); PG8_STAGE_A(PG8_SA(1, 0), cA + kstep, kstep, false, 0); PG8_STAGE(PG8_SB(1, 1), cB + hstepB + kstep, voffB);
    PG8_WAIT_V(6); PG8_BAR;
    for (;;) {
        const bool has_next = S.next(ui + 1, nxt);
        const char* nA = has_next ? (const char*)g.A + (size_t)nxt.pm * tstepA : cA; const char* nB = has_next ? (const char*)g.Bt + (size_t)nxt.pn * tstepB : cB;
        if (has_next) PG8_SETGA(gaN, nxt);
        for (int t = 0; t < nt; t += 2) {
            const bool last = (t == nt - 2);
            const char* a1 = cA + (size_t)(t + 1) * kstep;
            const char* a2 = last ? nA : cA + (size_t)(t + 2) * kstep; const char* b2 = last ? nB : cB + (size_t)(t + 2) * kstep;
            const char* a3 = a2 + kstep; const char* b3 = b2 + kstep;
            const size_t k2 = last ? 0 : (size_t)(t + 2) * kstep;
            if (last && has_next) S.a_ready(nxt);
            if constexpr (MIDHOOK) { if (t == nt / 2) E.mid(acc, cur, wr, wc, fr, fq); }
            PG8_LDB(B0, 0, 0); PG8_LDB(B1, 0, 1); PG8_SCHED; PG8_LDA(At, 0, 0); PG8_STAGE_A(PG8_SA(1, 1), a1 + hstepA, (size_t)(t + 1) * kstep, false, 1);
            PG8_WAIT_V(8); PG8_WAIT_L(0); PG8_BAR; PG8_MMA(0, 0, At, B0); PG8_MMA(0, 1, At, B1); PG8_BAR; PG8_SCHED;
            PG8_LDA(At, 0, 1); PG8_STAGE(PG8_SB(0, 0), b2, voffB); PG8_STAGE(PG8_SB(0, 1), b2 + hstepB, voffB); PG8_STAGE_A(PG8_SA(0, 0), a2, k2, last, 0);
            PG8_WAIT_V(8); PG8_WAIT_L(0); PG8_BAR; PG8_MMA(1, 0, At, B0); PG8_MMA(1, 1, At, B1); PG8_BAR; PG8_SCHED;
            PG8_LDB(B0, 1, 0); PG8_LDB(B1, 1, 1); PG8_SCHED; PG8_LDA(At, 1, 0); PG8_STAGE_A(PG8_SA(0, 1), a2 + hstepA, k2, last, 1);
            PG8_WAIT_V(8); PG8_WAIT_L(0); PG8_BAR; PG8_MMA(0, 0, At, B0); PG8_MMA(0, 1, At, B1); PG8_BAR; PG8_SCHED;
            PG8_LDA(At, 1, 1); PG8_STAGE(PG8_SB(1, 0), b3, voffB); PG8_STAGE(PG8_SB(1, 1), b3 + hstepB, voffB); PG8_STAGE_A(PG8_SA(1, 0), a3, k2 + kstep, last, 0);
            PG8_WAIT_V(8); PG8_WAIT_L(0); PG8_BAR; PG8_MMA(1, 0, At, B0); PG8_MMA(1, 1, At, B1); PG8_BAR; PG8_SCHED;
        }
        if constexpr (ALIGN_EPI) { if (wr == 0) PG8_BAR; }
        E(acc, cur, wr, wc, fr, fq); S.done(cur);
        if (!has_next) break;
#pragma unroll
        for (int a = 0; a < 2; ++a)
#pragma unroll
            for (int b = 0; b < 2; ++b)
#pragma unroll
                for (int m = 0; m < 4; ++m)
#pragma unroll
                    for (int n = 0; n < 2; ++n) acc[a][b][m][n] = (f32x4){0.f, 0.f, 0.f, 0.f};
        cur = nxt; cA = nA; cB = nB; ++ui;
        if constexpr (GATHER) {
#pragma unroll
            for (int h_ = 0; h_ < 2; ++h_)
#pragma unroll
                for (int i_ = 0; i_ < 2; ++i_) gaC[h_][i_] = gaN[h_][i_]; }
        if constexpr (ALIGN_EPI) { if (wr == 1) PG8_BAR; }
    }
    PG8_WAIT_V(0);
    if constexpr (!ALIGN_EPI) { if (wr == 0) PG8_BAR; }
    PG8_BAR;
#undef PG8_SA
#undef PG8_SB
#undef PG8_STAGE
#undef PG8_STAGE_A
#undef PG8_SETGA
#undef PG8_LDA
#undef PG8_LDB
#undef PG8_MMA
#undef PG8_WAIT_V
#undef PG8_WAIT_L
#undef PG8_BAR
#undef PG8_SCHED
}
}
typedef f32x4 AccT[2][2][4][2];

template <int SIG> __device__ __forceinline__ void store_tile_bf16(bf16_t* O, int ld, int colt, float sc, const AccT& acc, int row0, int wc, int fq) {
    const int col0 = colt + wc * 32 + 8 * fq;
#pragma unroll
    for (int ai = 0; ai < 2; ++ai)
#pragma unroll
        for (int m = 0; m < 4; ++m) { bf16_t* rowp = O + (size_t)(row0 + ai * 128 + m * 16) * ld + col0;
#pragma unroll
            for (int bj = 0; bj < 2; ++bj) { f32x4 v0 = acc[ai][bj][m][0] * sc, v1 = acc[ai][bj][m][1] * sc;
                if (SIG) {
#pragma unroll
                    for (int i = 0; i < 4; ++i) { v0[i] = sigmoidf_(v0[i]); v1[i] = sigmoidf_(v1[i]); } }
                *(u32x4*)(rowp + bj * 128) = pack8(v0, v1); } }
}
template <int NORM> __device__ __forceinline__ void store_head64(bf16_t* O, int ld, int cbase, const float* gain, float gsc, const AccT& acc, int row0, int fq) {
    f32x4 gq[2][2];
#pragma unroll
    for (int bj = 0; bj < 2; ++bj)
#pragma unroll
        for (int n = 0; n < 2; ++n) gq[bj][n] = NORM ? *(const f32x4*)(gain + 32 * bj + 8 * fq + 4 * n) * gsc : (f32x4){1.f, 1.f, 1.f, 1.f};
#pragma unroll
    for (int ai = 0; ai < 2; ++ai)
#pragma unroll
        for (int m = 0; m < 4; ++m) {
            float r = 1.f;
            if (NORM) { float ss = 0.f;
#pragma unroll
                for (int bj = 0; bj < 2; ++bj)
#pragma unroll
                    for (int n = 0; n < 2; ++n) { const f32x4 x = acc[ai][bj][m][n]; ss += (x[0] * x[0] + x[1] * x[1]) + (x[2] * x[2] + x[3] * x[3]); }
                ss += __shfl_xor(ss, 16); ss += __shfl_xor(ss, 32);
                r = 1.0f / sqrtf(ss * (1.0f / 64.0f) + EPS); }
            bf16_t* rowp = O + (size_t)(row0 + ai * 128 + m * 16) * ld + cbase + 8 * fq;
#pragma unroll
            for (int bj = 0; bj < 2; ++bj) { const f32x4 v0 = acc[ai][bj][m][0] * r * gq[bj][0], v1 = acc[ai][bj][m][1] * r * gq[bj][1];
                *(u32x4*)(rowp + 32 * bj) = pack8(v0, v1); } }
}
struct EpiIn {
    static constexpr bool PERM = true;
    unsigned char* ws; const float *qg, *kg;
    __device__ __forceinline__ void operator()(const AccT& acc, const pg8::Unit& u, int wr, int wc, int fr, int fq) const {
        asm volatile("" : "+v"(fr), "+v"(fq));
        bf16_t* const qa = (bf16_t*)(ws + WS_QA); bf16_t* const ka = (bf16_t*)(ws + WS_KA); bf16_t* const qb = (bf16_t*)(ws + WS_QB); bf16_t* const qi = (bf16_t*)(ws + WS_QI);
        bf16_t* const kb = (bf16_t*)(ws + WS_KB); bf16_t* const vbT = (bf16_t*)(ws + WS_VBT); bf16_t* const ki = (bf16_t*)(ws + WS_KI); bf16_t* const sga = (bf16_t*)(ws + WS_SGA); bf16_t* const sgb = (bf16_t*)(ws + WS_SGB);
        float* const wi = (float*)(ws + WS_WI);
        const int pn = u.pn, row0 = u.pm * 256 + wr * 64 + fr;
        if (pn < 2) store_tile_bf16<0>(qa, 512, pn * 256, 0.125f, acc, row0, wc, fq);
        else if (pn < 4) store_tile_bf16<0>(ka, 512, (pn - 2) * 256, 1.f, acc, row0, wc, fq);
        else if (pn < 6) store_head64<1>(qb, 512, ((pn - 4) * 4 + wc) * 64, qg, 0.125f, acc, row0, fq);
        else if (pn < 8) store_tile_bf16<0>(qi, 512, (pn - 6) * 256, 1.f, acc, row0, wc, fq);
        else if (pn == 8) {
            if (wc == 0) store_head64<1>(kb, 64, 0, kg, 1.f, acc, row0, fq);
            else if (wc == 1) {
#pragma unroll
                for (int ai = 0; ai < 2; ++ai)
#pragma unroll
                    for (int m = 0; m < 4; ++m) { bf16_t* p = vbT + (size_t)(8 * fq) * T + (row0 + ai * 128 + m * 16);
#pragma unroll
                        for (int bj = 0; bj < 2; ++bj)
#pragma unroll
                            for (int n = 0; n < 2; ++n)
#pragma unroll
                                for (int i = 0; i < 4; ++i) p[(size_t)(32 * bj + 4 * n + i) * T] = (bf16_t)f2bf(acc[ai][bj][m][n][i]); } }
            else if (wc == 2) store_head64<0>(ki, 64, 0, nullptr, 1.f, acc, row0, fq);
            else { if (fq == 0) {
#pragma unroll
                for (int ai = 0; ai < 2; ++ai)
#pragma unroll
                    for (int m = 0; m < 4; ++m) { float* p = wi + (size_t)(row0 + ai * 128 + m * 16) * 8; *(f32x4*)p = acc[ai][0][m][0]; *(f32x4*)(p + 4) = acc[ai][0][m][1]; } } }
        }
        else if (pn < 13) store_tile_bf16<1>(sga, 1024, (pn - 9) * 256, 1.f, acc, row0, wc, fq);
        else store_tile_bf16<1>(sgb, 1024, (pn - 13) * 256, 1.f, acc, row0, wc, fq);
    }
};
struct EpiPlain {
    static constexpr bool PERM = true;
    bf16_t* O; int ld;
    __device__ __forceinline__ void operator()(const AccT& acc, const pg8::Unit& u, int wr, int wc, int fr, int fq) const {
        asm volatile("" : "+v"(fr), "+v"(fq));
        store_tile_bf16<0>(O, ld, u.pn * 256, 1.f, acc, u.pm * 256 + wr * 64 + fr, wc, fq);
    }
};
struct EpiMerge {
    static constexpr bool PERM = true;
    bf16_t* O; const bf16_t* sga; const bf16_t* sgb;
    __device__ __forceinline__ void mid(AccT& acc, const pg8::Unit& u, int wr, int wc, int fr, int fq) const {
        asm volatile("" : "+v"(fr), "+v"(fq));
        const int row0 = u.pm * 256 + wr * 64 + fr, col0 = u.pn * 256 + wc * 32 + 8 * fq;
#pragma unroll
        for (int ai = 0; ai < 2; ++ai)
#pragma unroll
            for (int m = 0; m < 4; ++m) { const size_t off = (size_t)(row0 + ai * 128 + m * 16) * 1024 + col0;
#pragma unroll
                for (int bj = 0; bj < 2; ++bj) { const u32x4 a = *(const u32x4*)(sga + off + bj * 128), b = *(const u32x4*)(sgb + off + bj * 128);
                    f32x4& v0 = acc[ai][bj][m][0]; f32x4& v1 = acc[ai][bj][m][1];
                    v0[0] *= bflo(a.x) * __builtin_amdgcn_rcpf(bflo(b.x)); v0[1] *= bfhi(a.x) * __builtin_amdgcn_rcpf(bfhi(b.x)); v0[2] *= bflo(a.y) * __builtin_amdgcn_rcpf(bflo(b.y)); v0[3] *= bfhi(a.y) * __builtin_amdgcn_rcpf(bfhi(b.y));
                    v1[0] *= bflo(a.z) * __builtin_amdgcn_rcpf(bflo(b.z)); v1[1] *= bfhi(a.z) * __builtin_amdgcn_rcpf(bfhi(b.z)); v1[2] *= bflo(a.w) * __builtin_amdgcn_rcpf(bflo(b.w)); v1[3] *= bfhi(a.w) * __builtin_amdgcn_rcpf(bfhi(b.w)); } }
    }
    __device__ __forceinline__ void operator()(const AccT& acc, const pg8::Unit& u, int wr, int wc, int fr, int fq) const {
        asm volatile("" : "+v"(fr), "+v"(fq));
        const int row0 = u.pm * 256 + wr * 64 + fr, col0 = u.pn * 256 + wc * 32 + 8 * fq;
#pragma unroll
        for (int ai = 0; ai < 2; ++ai)
#pragma unroll
            for (int m = 0; m < 4; ++m) { const size_t off = (size_t)(row0 + ai * 128 + m * 16) * 1024 + col0;
#pragma unroll
                for (int bj = 0; bj < 2; ++bj) { const u32x4 gw = *(const u32x4*)(sgb + off + bj * 128);
                    f32x4 v0 = acc[ai][bj][m][0], v1 = acc[ai][bj][m][1];
                    v0[0] *= bflo(gw.x); v0[1] *= bfhi(gw.x); v0[2] *= bflo(gw.y); v0[3] *= bfhi(gw.y);
                    v1[0] *= bflo(gw.z); v1[1] *= bfhi(gw.z); v1[2] *= bflo(gw.w); v1[3] *= bfhi(gw.w);
                    *(u32x4*)(O + off + bj * 128) = pack8(v0, v1); } }
    }
};
struct EpiOut {
    static constexpr bool PERM = false;
    const float* xin; float* xout; const float* gvec;
    __device__ __forceinline__ void operator()(const AccT& acc, const pg8::Unit& u, int wr, int wc, int fr, int fq) const {
        asm volatile("" : "+v"(fr), "+v"(fq));
        const int row0 = u.pm * 256 + wr * 64 + fr, col0 = u.pn * 256 + wc * 32 + 4 * fq;
        const int b = (u.pm * 256) / SEQ;
        f32x4 gv[2][2];
#pragma unroll
        for (int bj = 0; bj < 2; ++bj)
#pragma unroll
            for (int n = 0; n < 2; ++n) gv[bj][n] = *(const f32x4*)(gvec + (size_t)b * NMOD + col0 + bj * 128 + n * 16);
#pragma unroll
        for (int ai = 0; ai < 2; ++ai)
#pragma unroll
            for (int m = 0; m < 4; ++m) { const size_t off = (size_t)(row0 + ai * 128 + m * 16) * 1024 + col0;
#pragma unroll
                for (int bj = 0; bj < 2; ++bj)
#pragma unroll
                    for (int n = 0; n < 2; ++n) { const f32x4 xi = *(const f32x4*)(xin + off + bj * 128 + n * 16);
                        *(f32x4*)(xout + off + bj * 128 + n * 16) = xi + gv[bj][n] * acc[ai][bj][m][n]; } }
    }
};
struct EpiMoe1 {
    static constexpr bool PERM = true;
    bf16_t* hid; const float* ew;
    __device__ __forceinline__ void operator()(const AccT& acc, const pg8::Unit& u, int wr, int wc, int fr, int fq) const {
        asm volatile("" : "+v"(fr), "+v"(fq));
        const int r0 = wr * 64 + fr, pnl = u.pn & 3, col0 = 128 * pnl + 16 * wc + 4 * fq;
#pragma unroll
        for (int ai = 0; ai < 2; ++ai)
#pragma unroll
            for (int m = 0; m < 4; ++m) { const int r = r0 + ai * 128 + m * 16; const float cw = r < u.nv ? ew[u.aux + r] : 0.f;
#pragma unroll
                for (int bj = 0; bj < 2; ++bj) { const f32x4 gt = acc[ai][bj][m][0], up = acc[ai][bj][m][1]; f32x4 h;
#pragma unroll
                    for (int i = 0; i < 4; ++i) h[i] = gt[i] * sigmoidf_(gt[i]) * up[i] * cw;
                    u32x2 w; w.x = cvt_pk_bf16(h[0], h[1]); w.y = cvt_pk_bf16(h[2], h[3]);
                    *(u32x2*)(hid + (size_t)(u.pm * 256 + r) * DEXP + col0 + 64 * bj) = w; } }
    }
};
struct EpiMoe2 {
    static constexpr bool PERM = true;
    bf16_t* y; const int* edst;
    __device__ __forceinline__ void operator()(const AccT& acc, const pg8::Unit& u, int wr, int wc, int fr, int fq) const {
        asm volatile("" : "+v"(fr), "+v"(fq));
        const int r0 = wr * 64 + fr, col0 = (u.pn & 3) * 256 + wc * 32 + 8 * fq;
#pragma unroll
        for (int ai = 0; ai < 2; ++ai)
#pragma unroll
            for (int m = 0; m < 4; ++m) { const int r = r0 + ai * 128 + m * 16;
                if (r < u.nv) { const int dst = edst[u.aux + r]; bf16_t* rowp = y + (size_t)dst * 1024 + col0;
#pragma unroll
                    for (int bj = 0; bj < 2; ++bj) *(u32x4*)(rowp + bj * 128) = pack8(acc[ai][bj][m][0], acc[ai][bj][m][1]); } }
    }
};
struct MoeOrder {
    const LAS int* tile_end; int ntiles, G, c;
    __device__ __forceinline__ bool next(int i, pg8::Unit& u) const {
        const int L = i * G + c; if (L >= 4 * ntiles) return false;
        const int rt = L >> 2; int e = 0;
#pragma unroll
        for (int j = 0; j < NE; ++j) e += (rt >= tile_end[j]) ? 1 : 0;
        e = __builtin_amdgcn_readfirstlane(e);
        const int ts = e == 0 ? 0 : __builtin_amdgcn_readfirstlane(tile_end[e - 1]), ne = __builtin_amdgcn_readfirstlane(tile_end[16 + e]);
        u.pm = rt; u.pn = e * 4 + (L & 3); u.aux = e * T + (rt - ts) * 256; u.nv = ne - (rt - ts) * 256; return true;
    }
    __device__ __forceinline__ void a_ready(const pg8::Unit&) const {}
    __device__ __forceinline__ void done(const pg8::Unit&) const {}
};

constexpr int RING_BYTES = 131072, MISC_OFF = 133120, LDS_BYTES = 147456;
struct Args { const float* in[18]; float* out; unsigned char* ws; int ph_lo, ph_hi; };
struct Frame {
    LAS unsigned char* lds; int tid, lane, wave, G, blk;
    float* out; unsigned char* ws; unsigned* ctl;
    __device__ __forceinline__ const float* in(int i) const {
        const LAS unsigned* t = (const LAS unsigned*)(lds + MISC_OFF + 1024) + 2 * i;
        const unsigned lo = __builtin_amdgcn_readfirstlane(t[0]), hi = __builtin_amdgcn_readfirstlane(t[1]);
        return (const float*)(((unsigned long long)hi << 32) | lo);
    }
};
enum { IN_X = 0, IN_C, IN_WADA, IN_BADA, IN_N1G, IN_WIN, IN_QNG, IN_KNG, IN_RELB, IN_WOA, IN_WOB, IN_WOUT, IN_N2G, IN_RW, IN_RB, IN_WG, IN_WU, IN_WDN };

__device__ __forceinline__ int win_src_col(int r) {
    if (r < 1024) return r;
    if (r < 1536) { const int rho = r - 1024, tile = rho >> 8, q = rho & 255, bj = q >> 7, wc = (q >> 5) & 3, j = q & 31; return 1536 + (tile * 4 + wc) * 64 + 32 * bj + j; }
    if (r < 2048) return 2176 + (r - 1536);
    if (r < 2304) { const int q = r - 2048, bj = q >> 7, wc = (q >> 5) & 3, j = q & 31, cs = 32 * bj + j;
        if (wc == 0) return 2048 + cs; if (wc == 1) return 2112 + cs; if (wc == 2) return 2688 + cs; return cs < 8 ? 2752 + cs : -1; }
    if (r < 3328) return 2760 + (r - 2304);
    if (r < 4352) return 3784 + (r - 3328);
    return 1024 + (r - 4352);
}
__device__ __forceinline__ void transpose_item(const float* colp, int ldw, int ksrc0, bf16_t* WT, size_t drow0, int ldk, int kdst0, LAS float* scr, int lane) {
    float tv[32];
    const float* cp = colp ? colp + (size_t)(ksrc0 + (lane >> 5)) * ldw : nullptr;
#pragma unroll
    for (int i = 0; i < 32; ++i) tv[i] = cp ? cp[(size_t)(2 * i) * ldw] : 0.f;
#pragma unroll
    for (int i = 0; i < 32; ++i) scr[(2 * i + (lane >> 5)) * 33 + (lane & 31)] = tv[i];
    LDS_WAIT(); asm volatile("" ::: "memory");
    const int c = lane & 7;
#pragma unroll
    for (int j = 0; j < 4; ++j) { const int n = (lane >> 3) + 8 * j; const LAS float* s = scr + (8 * c) * 33 + n;
        u32x4 o; o.x = pk2(s[0 * 33], s[1 * 33]); o.y = pk2(s[2 * 33], s[3 * 33]); o.z = pk2(s[4 * 33], s[5 * 33]); o.w = pk2(s[6 * 33], s[7 * 33]);
        *(u32x4*)(WT + (drow0 + n) * ldk + kdst0 + 8 * c) = o; }
    LDS_WAIT(); asm volatile("" ::: "memory");
}
constexpr int IT_WIN = 152 * 16, IT_WO = 32 * 16, IT_WOUT = 32 * 16, IT_SMALL = IT_WIN + IT_WO + IT_WOUT;
constexpr int IT_WGU = 16 * 32 * 16, IT_WD = 16 * 32 * 8, IT_EXP = IT_WGU + IT_WD;
__device__ __forceinline__ void convert_small_item(Frame& F, int l, int it, LAS float* scr) {
    const int n31 = F.lane & 31;
    if (it < IT_WIN) { const int rg = it >> 4, kg = it & 15; const int col = win_src_col(rg * 32 + n31);
        transpose_item(col >= 0 ? F.in(IN_WIN) + (size_t)l * DM * NIN + col : nullptr, NIN, kg * 64, (bf16_t*)(F.ws + WS_WIN + l * WIN_LAYER), (size_t)rg * 32, 1024, kg * 64, scr, F.lane); return; }
    it -= IT_WIN;
    if (it < IT_WO) { const int rg = it >> 4, kg = it & 15, k0 = kg * 64; const float* src = (k0 < 512 ? F.in(IN_WOA) : F.in(IN_WOB)) + (size_t)l * 512 * 1024 + rg * 32 + n31;
        transpose_item(src, 1024, k0 & 511, (bf16_t*)(F.ws + WS_WO) + (size_t)l * 1024 * 1024, (size_t)rg * 32, 1024, k0, scr, F.lane); return; }
    it -= IT_WO;
    { const int rg = it >> 4, kg = it & 15; transpose_item(F.in(IN_WOUT) + (size_t)l * 1024 * 1024 + rg * 32 + n31, 1024, kg * 64, (bf16_t*)(F.ws + WS_WOUT) + (size_t)l * 1024 * 1024, (size_t)rg * 32, 1024, kg * 64, scr, F.lane); }
}
__device__ __forceinline__ void convert_expert_item(Frame& F, int l, int it, LAS float* scr) {
    const int n31 = F.lane & 31;
    if (it < IT_WGU) { const int e = it >> 9, r2 = it & 511, rg = r2 >> 4, kg = r2 & 15; const int r = rg * 32 + n31, q = r >> 3, i = r & 7;
        const float* src = (i < 4 ? F.in(IN_WG) : F.in(IN_WU)) + (size_t)(l * NE + e) * DM * DEXP + 4 * q + (i & 3);
        transpose_item(src, DEXP, kg * 64, (bf16_t*)(F.ws + WS_WGU) + (size_t)e * 1024 * 1024, (size_t)rg * 32, 1024, kg * 64, scr, F.lane); return; }
    it -= IT_WGU;
    { const int e = it >> 8, r2 = it & 255, rg = r2 >> 3, kg = r2 & 7;
        transpose_item(F.in(IN_WDN) + (size_t)(l * NE + e) * DEXP * DM + rg * 32 + n31, DM, kg * 64, (bf16_t*)(F.ws + WS_WD) + (size_t)e * 1024 * 512, (size_t)rg * 32, 512, kg * 64, scr, F.lane); }
}

__device__ __forceinline__ void phase_prologue(Frame& F) {
    LAS float* scr = (LAS float*)(F.lds + F.wave * 8448);
    LAS float* sil = (LAS float*)(F.lds + 69632);
    const float* cin = F.in(IN_C); const float* badap = F.in(IN_BADA);
    for (int i = F.tid; i < BATCH * DM; i += NTHR) { const float v = cin[i]; sil[i] = v / (1.f + __expf(-v)); }
    __syncthreads();
    const int gw = F.blk * NWAVES + F.wave, NGW = F.G * NWAVES;
    float* modp = (float*)(F.ws + WS_MODP);
    for (int it = gw; it < 16 * 2 * 96; it += NGW) {
        const int jb = it % 96, l = (it / 96) & 1, kc = it / 192; const int j = jb * 64 + F.lane;
        float a[BATCH];
#pragma unroll
        for (int b = 0; b < BATCH; ++b) a[b] = 0.f;
        const float* wp = F.in(IN_WADA) + ((size_t)l * DM + kc * 64) * NMOD + j;
        for (int k0 = 0; k0 < 64; k0 += 16) { float wv[16];
#pragma unroll
            for (int k = 0; k < 16; ++k) wv[k] = wp[(size_t)(k0 + k) * NMOD];
#pragma unroll
            for (int k = 0; k < 16; ++k)
#pragma unroll
                for (int b = 0; b < BATCH; ++b) a[b] += sil[b * DM + kc * 64 + k0 + k] * wv[k]; }
        const float bias = (kc == 0) ? badap[l * NMOD + j] : 0.f;
#pragma unroll
        for (int b = 0; b < BATCH; ++b) modp[(((size_t)kc * 2 + l) * BATCH + b) * NMOD + j] = a[b] + bias;
    }
    for (int it = gw; it < 2 * IT_SMALL; it += NGW) { const int l = it >= IT_SMALL ? 1 : 0; convert_small_item(F, l, it - l * IT_SMALL, scr); }
    for (int it = gw; it < IT_EXP; it += NGW) convert_expert_item(F, 0, it, scr);
}

__device__ __forceinline__ float modsum(const float* modp, int l, int b, int j) {
    float s = 0.f;
#pragma unroll
    for (int kc = 0; kc < 16; ++kc) s += modp[(((size_t)kc * 2 + l) * BATCH + b) * NMOD + j];
    return s;
}
__device__ __forceinline__ void phase_rows(Frame& F, int l, int mode) {
    LAS float* Av = (LAS float*)F.lds; LAS float* Sv = Av + DM; LAS float* Gv = Sv + DM;
    const float* modp = (const float*)(F.ws + WS_MODP);
    float* mod = (float*)(F.ws + WS_MOD);
    const float* n1g = F.in(IN_N1G); const float* xin = F.in(IN_X);
    const int row_base = F.blk * (T / F.G);
    const int b = row_base / SEQ;
    if (mode == 0) {
        const int per = (2 * BATCH * NMOD) / F.G;
        for (int i = F.tid; i < per; i += NTHR) { const int idx = F.blk * per + i; const int ll = idx / (BATCH * NMOD), bb = (idx / NMOD) % BATCH, j = idx % NMOD; mod[idx] = modsum(modp, ll, bb, j); }
    }
    for (int d = F.tid; d < DM; d += NTHR) {
        if (mode != 2) { Av[d] = n1g[l * DM + d] * (1.f + modsum(modp, l, b, 1 * DM + d)); Sv[d] = modsum(modp, l, b, 0 * DM + d); }
        if (mode != 0) Gv[d] = modsum(modp, l - 1, b, 5 * DM + d);
    }
    if (mode == 1) {
        LAS float* scr = (LAS float*)(F.lds + 16384 + F.wave * 8448);
        const int gw = F.blk * NWAVES + F.wave, NGW = F.G * NWAVES;
        for (int it = gw; it < IT_EXP; it += NGW) convert_expert_item(F, l, it, scr);
    }
    __syncthreads();
    const bf16_t* ybuf = (const bf16_t*)(F.ws + WS_Y);
    bf16_t* hb = (bf16_t*)(F.ws + WS_H);
    const int rows_per_wave = (T / F.G) / NWAVES;
    for (int i0 = 0; i0 < rows_per_wave; i0 += 4) {
        const int row0 = row_base + F.wave * rows_per_wave + i0;
        f32x4 v[4][4]; u32x2 ya[4][4], yb[4][4];
#pragma unroll
        for (int r = 0; r < 4; ++r) { const float* xr = (mode == 0 ? xin : F.out) + (size_t)(row0 + r) * DM;
#pragma unroll
            for (int j = 0; j < 4; ++j) { v[r][j] = *(const f32x4*)(xr + 4 * F.lane + 256 * j);
                if (mode != 0) { ya[r][j] = *(const u32x2*)(ybuf + (size_t)(2 * (row0 + r)) * DM + 4 * F.lane + 256 * j); yb[r][j] = *(const u32x2*)(ybuf + (size_t)(2 * (row0 + r) + 1) * DM + 4 * F.lane + 256 * j); } } }
#pragma unroll
        for (int r = 0; r < 4; ++r) { const int row = row0 + r;
            if (mode != 0) {
#pragma unroll
                for (int j = 0; j < 4; ++j) { const int c0 = 4 * F.lane + 256 * j; const u32x2 y0 = ya[r][j], y1 = yb[r][j];
                    v[r][j][0] += Gv[c0 + 0] * (bflo(y0.x) + bflo(y1.x)); v[r][j][1] += Gv[c0 + 1] * (bfhi(y0.x) + bfhi(y1.x));
                    v[r][j][2] += Gv[c0 + 2] * (bflo(y0.y) + bflo(y1.y)); v[r][j][3] += Gv[c0 + 3] * (bfhi(y0.y) + bfhi(y1.y));
                    *(f32x4*)(F.out + (size_t)row * DM + c0) = v[r][j]; }
            }
            if (mode != 2) {
                float ss = 0.f;
#pragma unroll
                for (int j = 0; j < 4; ++j) ss += (v[r][j][0] * v[r][j][0] + v[r][j][1] * v[r][j][1]) + (v[r][j][2] * v[r][j][2] + v[r][j][3] * v[r][j][3]);
                const float rs = 1.0f / sqrtf(wave_sum(ss) * (1.0f / DM) + EPS);
#pragma unroll
                for (int j = 0; j < 4; ++j) { const int c0 = 4 * F.lane + 256 * j; u32x2 w;
                    w.x = pk2(v[r][j][0] * rs * Av[c0] + Sv[c0], v[r][j][1] * rs * Av[c0 + 1] + Sv[c0 + 1]);
                    w.y = pk2(v[r][j][2] * rs * Av[c0 + 2] + Sv[c0 + 2], v[r][j][3] * rs * Av[c0 + 3] + Sv[c0 + 3]);
                    *(u32x2*)(hb + (size_t)row * DM + c0) = w; }
            }
        }
    }
}

typedef float f32x16 __attribute__((ext_vector_type(16)));
__device__ __forceinline__ bf16x8 pack_bf16x8(float a0, float a1, float a2, float a3, float a4, float a5, float a6, float a7) {
    u32x4 w; w.x = cvt_pk_bf16(a0, a1); w.y = cvt_pk_bf16(a2, a3); w.z = cvt_pk_bf16(a4, a5); w.w = cvt_pk_bf16(a6, a7); return __builtin_bit_cast(bf16x8, w);
}
__device__ __forceinline__ void phase_sb(Frame& F) {
    const bf16_t* qa = (const bf16_t*)(F.ws + WS_QA); const bf16_t* ka = (const bf16_t*)(F.ws + WS_KA); const bf16_t* vaT = (const bf16_t*)(F.ws + WS_VAT);
    bf16_t* oab = (bf16_t*)(F.ws + WS_OAB);
    const int lane = F.lane, q32 = lane & 31, hi = lane >> 5;
    const int NGW = F.G * NWAVES;
    for (int wu = F.blk * NWAVES + F.wave; wu < BATCH * 8 * 64; wu += NGW) {
        const int qblk = wu & 63, bh = wu >> 6, b = bh >> 3, h = bh & 7;
        const int qw = qblk * 32, t = qw + q32;
        const size_t rowb = (size_t)b * SEQ;
        bf16x8 qf[4];
#pragma unroll
        for (int ks = 0; ks < 4; ++ks) qf[ks] = *(const bf16x8*)(qa + (rowb + t) * 512 + h * 64 + 16 * ks + 8 * hi);
        f32x16 o0, o1;
#pragma unroll
        for (int r = 0; r < 16; ++r) { o0[r] = 0.f; o1[r] = 0.f; }
        float R = 0.f;
        for (int kb = qw; kb >= 0; kb -= 32) {
            const bf16_t* kp = ka + (rowb + kb + q32) * 512 + h * 64 + 8 * hi;
            bf16x8 kf[4];
#pragma unroll
            for (int ks = 0; ks < 4; ++ks) kf[ks] = *(const bf16x8*)(kp + 16 * ks);
            const bf16_t* vp = vaT + (size_t)(h * 64 + q32) * T + rowb + kb + 4 * hi;
            u32x2 vv[2][2][2];
#pragma unroll
            for (int dt = 0; dt < 2; ++dt)
#pragma unroll
                for (int sx = 0; sx < 2; ++sx)
#pragma unroll
                    for (int hf = 0; hf < 2; ++hf) vv[dt][sx][hf] = *(const u32x2*)(vp + (size_t)dt * 32 * T + 16 * sx + 8 * hf);
            f32x16 z;
#pragma unroll
            for (int r = 0; r < 16; ++r) z[r] = 0.f;
#pragma unroll
            for (int ks = 0; ks < 4; ++ks) z = __builtin_amdgcn_mfma_f32_32x32x16_bf16(kf[ks], qf[ks], z, 0, 0, 0);
            float lv[16], zs[16]; bool vl[16];
#pragma unroll
            for (int r = 0; r < 16; ++r) { const float zz = z[r]; const float sp = fmaxf(zz, 0.f) + __logf(1.f + __expf(-fabsf(zz)));
                vl[r] = (kb + (r & 3) + 8 * (r >> 2) + 4 * hi) < t; lv[r] = vl[r] ? -sp : 0.f; zs[r] = zz - sp; }
            float gs[4], pg[4], tl[4];
#pragma unroll
            for (int k = 0; k < 4; ++k) { gs[k] = (lv[4 * k] + lv[4 * k + 1]) + (lv[4 * k + 2] + lv[4 * k + 3]); pg[k] = __shfl_xor(gs[k], 32); }
            tl[3] = 0.f; tl[2] = gs[3] + pg[3]; tl[1] = tl[2] + (gs[2] + pg[2]); tl[0] = tl[1] + (gs[1] + pg[1]);
            const float tot = tl[0] + (gs[0] + pg[0]);
            float av[16];
#pragma unroll
            for (int k = 0; k < 4; ++k) { const float base = R + tl[k] + (hi == 0 ? pg[k] : 0.f);
                const float s3 = base, s2 = s3 + lv[4 * k + 3], s1 = s2 + lv[4 * k + 2], s0 = s1 + lv[4 * k + 1];
                av[4 * k + 0] = vl[4 * k + 0] ? __expf(zs[4 * k + 0] + s0) : 0.f; av[4 * k + 1] = vl[4 * k + 1] ? __expf(zs[4 * k + 1] + s1) : 0.f;
                av[4 * k + 2] = vl[4 * k + 2] ? __expf(zs[4 * k + 2] + s2) : 0.f; av[4 * k + 3] = vl[4 * k + 3] ? __expf(zs[4 * k + 3] + s3) : 0.f; }
            R += tot;
            const bf16x8 pf0 = pack_bf16x8(av[0], av[1], av[2], av[3], av[4], av[5], av[6], av[7]);
            const bf16x8 pf1 = pack_bf16x8(av[8], av[9], av[10], av[11], av[12], av[13], av[14], av[15]);
#define SB_VF(dt, sx) __builtin_bit_cast(bf16x8, (u32x4){vv[dt][sx][0].x, vv[dt][sx][0].y, vv[dt][sx][1].x, vv[dt][sx][1].y})
            o0 = __builtin_amdgcn_mfma_f32_32x32x16_bf16(SB_VF(0, 0), pf0, o0, 0, 0, 0);
            o0 = __builtin_amdgcn_mfma_f32_32x32x16_bf16(SB_VF(0, 1), pf1, o0, 0, 0, 0);
            o1 = __builtin_amdgcn_mfma_f32_32x32x16_bf16(SB_VF(1, 0), pf0, o1, 0, 0, 0);
            o1 = __builtin_amdgcn_mfma_f32_32x32x16_bf16(SB_VF(1, 1), pf1, o1, 0, 0, 0);
#undef SB_VF
            if (__all(R <= -104.f)) break;
        }
        bf16_t* op = oab + (rowb + t) * 1024 + h * 64 + 4 * hi;
#pragma unroll
        for (int k = 0; k < 4; ++k) { u32x2 w0, w1; w0.x = cvt_pk_bf16(o0[4 * k], o0[4 * k + 1]); w0.y = cvt_pk_bf16(o0[4 * k + 2], o0[4 * k + 3]);
            w1.x = cvt_pk_bf16(o1[4 * k], o1[4 * k + 1]); w1.y = cvt_pk_bf16(o1[4 * k + 2], o1[4 * k + 3]);
            *(u32x2*)(op + 8 * k) = w0; *(u32x2*)(op + 32 + 8 * k) = w1; }
    }
}

__device__ __forceinline__ unsigned sortable(float f) { const unsigned u = __builtin_bit_cast(unsigned, f); return (u & 0x80000000u) ? ~u : (u | 0x80000000u); }
__device__ __forceinline__ int wave_total(int v) {
    v += __builtin_amdgcn_update_dpp(0, v, 0xB1, 0xf, 0xf, true);
    v += __builtin_amdgcn_update_dpp(0, v, 0x4E, 0xf, 0xf, true);
    v += __builtin_amdgcn_update_dpp(0, v, 0x141, 0xf, 0xf, true);
    v += __builtin_amdgcn_update_dpp(0, v, 0x140, 0xf, 0xf, true);
    return __builtin_amdgcn_readlane(v, 0) + __builtin_amdgcn_readlane(v, 16) + __builtin_amdgcn_readlane(v, 32) + __builtin_amdgcn_readlane(v, 48);
}
typedef unsigned short u16x2 __attribute__((ext_vector_type(2)));
__device__ __forceinline__ u16x2 pk_ge(unsigned x, unsigned cm1) {
    unsigned d; asm("v_pk_sub_u16 %0, %1, %2 clamp\n\tv_pk_min_u16 %0, %0, 1 op_sel_hi:[1,0]" : "=v"(d) : "v"(x), "v"(cm1));
    return __builtin_bit_cast(u16x2, d);
}
template <bool MASKED>
__device__ __forceinline__ void pk_bisect2(const unsigned (&hpa)[16], const unsigned (&lpa)[16], const unsigned (&hpb)[16], const unsigned (&lpb)[16], unsigned hha, unsigned hhb,
                                           int needa, int needb, unsigned& ta, unsigned& tb, bool& exa, bool& exb) {
    ta = 0u; tb = 0u; exa = false; exb = false;
#pragma unroll 1
    for (int bit = 15; bit >= 0; --bit) {
        const unsigned ca = ta | (1u << bit), cb = tb | (1u << bit), ma = (ca - 1u) * 0x10001u, mb_ = (cb - 1u) * 0x10001u;
        u16x2 na = (u16x2){0, 0}, nb = (u16x2){0, 0};
#pragma unroll
        for (int m = 0; m < 16; ++m) {
            if (MASKED) {
                const u16x2 ea = __builtin_elementwise_sub_sat((u16x2){1, 1}, __builtin_bit_cast(u16x2, hpa[m] ^ hha)), eb = __builtin_elementwise_sub_sat((u16x2){1, 1}, __builtin_bit_cast(u16x2, hpb[m] ^ hhb));
                na += pk_ge(lpa[m] & (__builtin_bit_cast(unsigned, ea) * 0xffffu), ma); nb += pk_ge(lpb[m] & (__builtin_bit_cast(unsigned, eb) * 0xffffu), mb_);
            } else { na += pk_ge(hpa[m], ma); nb += pk_ge(hpb[m], mb_); } }
        const int cta = wave_total((int)na.x + (int)na.y), ctb = wave_total((int)nb.x + (int)nb.y);
        if (!exa) { if (cta >= needa) ta = ca; if (cta == needa) exa = true; }
        if (!exb) { if (ctb >= needb) tb = cb; if (ctb == needb) exb = true; }
        if (exa && exb) break;
    }
}
__device__ __forceinline__ void topk_emit_pk(const unsigned (&hp)[16], const unsigned (&lp)[16], unsigned thr, LAS unsigned* maskrow, int lane) {
    int cg = 0, ce = 0;
#pragma unroll
    for (int m = 0; m < 16; ++m) { const unsigned k0 = (hp[m] << 16) | (lp[m] & 0xffffu), k1 = (hp[m] & 0xffff0000u) | (lp[m] >> 16);
        cg += (k0 > thr) ? 1 : 0; ce += (k0 == thr) ? 1 : 0; cg += (k1 > thr) ? 1 : 0; ce += (k1 == thr) ? 1 : 0; }
    const int need = 256 - wave_total(cg), neq = wave_total(ce);
    unsigned bits = 0u;
    if (neq <= need) {
#pragma unroll
        for (int m = 0; m < 16; ++m) { const unsigned k0 = (hp[m] << 16) | (lp[m] & 0xffffu), k1 = (hp[m] & 0xffff0000u) | (lp[m] >> 16);
            bits |= (k0 >= thr) ? (1u << (2 * m)) : 0u; bits |= (k1 >= thr) ? (1u << (2 * m + 1)) : 0u; }
    } else {
        int run = 0; const unsigned long long lt = (1ull << lane) - 1ull;
#pragma unroll 1
        for (int m = 0; m < 16; ++m) {
#pragma unroll
            for (int hf = 0; hf < 2; ++hf) { unsigned k = 0u;
#pragma unroll
                for (int mm = 0; mm < 16; ++mm) if (mm == m) k = hf == 0 ? ((hp[mm] << 16) | (lp[mm] & 0xffffu)) : ((hp[mm] & 0xffff0000u) | (lp[mm] >> 16));
                const unsigned long long eq = __ballot(k == thr);
                const bool tie_sel = (k == thr) && (run + __popcll(eq & lt) < need);
                if (k > thr || tie_sel) bits |= 1u << (2 * m + hf);
                run += __popcll(eq); } }
    }
    maskrow[lane] = bits;
}
__device__ __forceinline__ void topk_select2_pk(const unsigned (&hpa)[16], const unsigned (&lpa)[16], const unsigned (&hpb)[16], const unsigned (&lpb)[16], LAS unsigned* maska, LAS unsigned* maskb, int lane) {
    unsigned ha, hb_; bool exa, exb;
    pk_bisect2<false>(hpa, lpa, hpb, lpb, 0u, 0u, 256, 256, ha, hb_, exa, exb);
    unsigned la = 0u, lb = 0u;
    if (!(exa && exb)) {
        const unsigned hha = ha * 0x10001u, hhb = hb_ * 0x10001u;
        u16x2 ga = (u16x2){0, 0}, gb = (u16x2){0, 0};
#pragma unroll
        for (int m = 0; m < 16; ++m) { ga += pk_ge(hpa[m], hha); gb += pk_ge(hpb[m], hhb); }
        int ra = 256 - wave_total((int)ga.x + (int)ga.y), rb = 256 - wave_total((int)gb.x + (int)gb.y);
        if (ha == 0xffffu) ra = 256; if (hb_ == 0xffffu) rb = 256;
        bool e2a, e2b; unsigned tla, tlb;
        pk_bisect2<true>(hpa, lpa, hpb, lpb, hha, hhb, exa ? 0 : ra, exb ? 0 : rb, tla, tlb, e2a, e2b);
        if (!exa) la = tla; if (!exb) lb = tlb;
    }
    topk_emit_pk(hpa, lpa, (ha << 16) | la, maska, lane);
    topk_emit_pk(hpb, lpb, (hb_ << 16) | lb, maskb, lane);
}
__device__ __forceinline__ int t5_bucket(int d) {
    if (d < 16) return d;
    int bkt = 16;
    bkt += (d >= 19); bkt += (d >= 21); bkt += (d >= 24); bkt += (d >= 27); bkt += (d >= 31); bkt += (d >= 35); bkt += (d >= 40); bkt += (d >= 46);
    bkt += (d >= 52); bkt += (d >= 59); bkt += (d >= 67); bkt += (d >= 77); bkt += (d >= 87); bkt += (d >= 99); bkt += (d >= 113);
    return bkt;
}
constexpr int SC_STRIDE = 2052;
__device__ __forceinline__ void phase_strip(Frame& F, int l) {
    LAS unsigned* SCB = (LAS unsigned*)F.lds;
    LAS unsigned* MSK = (LAS unsigned*)(F.lds + MISC_OFF + 2048);
    LAS float* LUT = (LAS float*)(F.lds + MISC_OFF + 2048 + 4224);
    LAS float* MB = (LAS float*)(F.lds + MISC_OFF + 2048 + 4224 + 3712);
    const bf16_t* qi = (const bf16_t*)(F.ws + WS_QI); const bf16_t* ki = (const bf16_t*)(F.ws + WS_KI); const float* wi = (const float*)(F.ws + WS_WI);
    const bf16_t* qb = (const bf16_t*)(F.ws + WS_QB); const bf16_t* kbp = (const bf16_t*)(F.ws + WS_KB); const bf16_t* vbT = (const bf16_t*)(F.ws + WS_VBT);
    bf16_t* oab = (bf16_t*)(F.ws + WS_OAB);
    const float* relb = F.in(IN_RELB);
    for (int i = F.tid; i < 8 * 114; i += NTHR) { const int h = i / 114, d = i % 114; LUT[i] = relb[t5_bucket(d) * 8 + h]; }
    if (F.tid < 8) { const float* qg = F.in(IN_QNG) + l * 64; const float* kg = F.in(IN_KNG) + l * 64; float gq = 0.f, gk = 0.f, bm = -1e30f;
        for (int d = 0; d < 64; ++d) { gq = fmaxf(gq, fabsf(qg[d])); gk = fmaxf(gk, fabsf(kg[d])); }
        for (int k = 0; k < 32; ++k) bm = fmaxf(bm, relb[k * 8 + F.tid]);
        MB[F.tid] = 8.1f * gq * gk + bm; }
    __syncthreads();
    const int w = F.wave;
    for (int vc = F.blk; vc < 256; vc += F.G) {
        const int b = vc & 7, jj = vc >> 3; const size_t rowb = (size_t)b * SEQ;
        for (int it = 0; it < 4; ++it) {
            int lane = F.lane; asm volatile("" : "+v"(lane)); const int q = lane & 15, g = lane >> 4;
            const int si = it == 0 ? jj : (it == 1 ? 63 - jj : (it == 2 ? 64 + jj : 127 - jj)); const int t0 = 16 * si;
            if (si < 16) {
                for (int idx = F.tid; idx < 16 * 64; idx += NTHR) { const int tq = t0 + (idx >> 6), L = idx & 63; unsigned bw = 0u;
#pragma unroll
                    for (int j = 0; j < 4; ++j) bw |= (L + 64 * j <= tq) ? (1u << j) : 0u;
                    MSK[(idx >> 6) * 65 + L] = bw; }
            } else {
                bf16x8 qif[8][2]; float wq[8];
#pragma unroll
                for (int h = 0; h < 8; ++h) { wq[h] = wi[(rowb + t0 + q) * 8 + h];
#pragma unroll
                    for (int ks = 0; ks < 2; ++ks) qif[h][ks] = *(const bf16x8*)(qi + (rowb + t0 + q) * 512 + h * 64 + 32 * ks + 8 * g); }
                const bf16_t* kpb = ki + (rowb + 16 * w + q) * 64 + 8 * g;
                const int ntw = (si - w) / 8 + 1;
                bf16x8 ka0, ka1, kb0, kb1, kc0, kc1;
#define IDX_LOAD(K0, K1, n) do { K0 = *(const bf16x8*)(kpb + (size_t)(128 * (n)) * 64); K1 = *(const bf16x8*)(kpb + (size_t)(128 * (n)) * 64 + 32); } while (0)
#define IDX_TILE(K0, K1, n) do { const bf16x8 kf0 = K0, kf1 = K1; const int kt = w + 8 * (n); if ((n) + 3 < ntw) IDX_LOAD(K0, K1, (n) + 3); \
                    f32x4 sc = (f32x4){0.f, 0.f, 0.f, 0.f}; \
                    _Pragma("unroll") for (int h = 0; h < 8; ++h) { f32x4 d = __builtin_amdgcn_mfma_f32_16x16x32_bf16(kf0, qif[h][0], (f32x4){0.f, 0.f, 0.f, 0.f}, 0, 0, 0); \
                        d = __builtin_amdgcn_mfma_f32_16x16x32_bf16(kf1, qif[h][1], d, 0, 0, 0); \
                        _Pragma("unroll") for (int i = 0; i < 4; ++i) sc[i] += wq[h] * fmaxf(d[i], 0.f); } \
                    u32x4 key; \
                    _Pragma("unroll") for (int i = 0; i < 4; ++i) key[i] = (16 * kt + 4 * g + i <= t0 + q) ? sortable(sc[i] + 0.f) : 0u; \
                    *(LAS u32x4*)(SCB + q * SC_STRIDE + 16 * kt + 4 * g) = key; } while (0)
                IDX_LOAD(ka0, ka1, 0); if (1 < ntw) IDX_LOAD(kb0, kb1, 1); if (2 < ntw) IDX_LOAD(kc0, kc1, 2);
                for (int n = 0; n < ntw; n += 3) { IDX_TILE(ka0, ka1, n); if (n + 1 < ntw) IDX_TILE(kb0, kb1, n + 1); if (n + 2 < ntw) IDX_TILE(kc0, kc1, n + 2); }
#undef IDX_LOAD
#undef IDX_TILE
                __syncthreads();
                const int nk = 16 * (si + 1);
                { unsigned hpa[16], lpa[16], hpb[16], lpb[16]; const int nm = (nk + 127) >> 7;
#pragma unroll
                    for (int m = 0; m < 16; ++m) { hpa[m] = 0u; lpa[m] = 0u; hpb[m] = 0u; lpb[m] = 0u;
                        if (m < nm) { const int s0 = lane + 128 * m, s1 = s0 + 64;
                            const unsigned a0 = (s0 < nk) ? SCB[(2 * w) * SC_STRIDE + s0] : 0u, a1 = (s1 < nk) ? SCB[(2 * w) * SC_STRIDE + s1] : 0u;
                            const unsigned b0 = (s0 < nk) ? SCB[(2 * w + 1) * SC_STRIDE + s0] : 0u, b1 = (s1 < nk) ? SCB[(2 * w + 1) * SC_STRIDE + s1] : 0u;
                            hpa[m] = (a0 >> 16) | (a1 & 0xffff0000u); lpa[m] = (a0 & 0xffffu) | (a1 << 16);
                            hpb[m] = (b0 >> 16) | (b1 & 0xffff0000u); lpb[m] = (b0 & 0xffffu) | (b1 << 16); } }
                    topk_select2_pk(hpa, lpa, hpb, lpb, MSK + (2 * w) * 65, MSK + (2 * w + 1) * 65, lane); }
            }
            __syncthreads();
            {
                const int h = w, t = t0 + q;
                bf16x8 qf[2];
#pragma unroll
                for (int ks = 0; ks < 2; ++ks) qf[ks] = *(const bf16x8*)(qb + (rowb + t) * 512 + h * 64 + 32 * ks + 8 * g);
                f32x4 o[4];
#pragma unroll
                for (int dt = 0; dt < 4; ++dt) o[dt] = (f32x4){0.f, 0.f, 0.f, 0.f};
                float l = 0.f;
                const float mb = MB[h], cfar = LUT[h * 114 + 113] - mb;
                unsigned mwr[2][8];
#pragma unroll
                for (int p = 0; p < 2; ++p)
#pragma unroll
                    for (int e = 0; e < 8; ++e) mwr[p][e] = MSK[q * 65 + 32 * p + 16 * (e >> 2) + 4 * g + (e & 3)];
                const int nch = (t0 + 15) / 32 + 1, nst = (t0 + 15) / 128 + 1;
                constexpr int STG = 35840, VOFF = 18432;
                const bf16_t* gk0 = kbp + (rowb + (F.tid >> 3)) * 64 + 8 * (F.tid & 7);
                const bf16_t* gv0 = vbT + (size_t)(F.tid >> 4) * T + rowb + 8 * (F.tid & 15);
                const int dk0 = (F.tid >> 3) * 144 + (F.tid & 7) * 16, dv0 = VOFF + (F.tid >> 4) * 272 + (F.tid & 15) * 16;
                u32x4 ra[4];
#define DSA_LOAD(R, st) do { R[0] = *(const u32x4*)(gk0 + (size_t)(128 * (st)) * 64); R[1] = *(const u32x4*)(gk0 + (size_t)(128 * (st) + 64) * 64); \
                    R[2] = *(const u32x4*)(gv0 + 128 * (st)); R[3] = *(const u32x4*)(gv0 + (size_t)32 * T + 128 * (st)); } while (0)
#define DSA_PUT(R, st) do { LAS unsigned char* sp_ = F.lds + ((st) % 3) * STG; *(LAS u32x4*)(sp_ + dk0) = R[0]; *(LAS u32x4*)(sp_ + dk0 + 64 * 144) = R[1]; \
                    *(LAS u32x4*)(sp_ + dv0) = R[2]; *(LAS u32x4*)(sp_ + dv0 + 32 * 272) = R[3]; } while (0)
                DSA_LOAD(ra, 0); DSA_PUT(ra, 0); if (nst > 1) DSA_LOAD(ra, 1);
                asm volatile("s_waitcnt lgkmcnt(0)" ::: "memory"); __builtin_amdgcn_s_barrier(); asm volatile("" ::: "memory");
#define DSA_STAGE(st, RN) do { \
                    if ((st) + 1 < nst) { DSA_PUT(RN, (st) + 1); if ((st) + 2 < nst) DSA_LOAD(RN, (st) + 2); } \
                    const LAS unsigned char* stg = F.lds + ((st) % 3) * STG; \
                    _Pragma("unroll") for (int cc = 0; cc < 4; ++cc) { const int c = 4 * (st) + cc; if (c < nch) { \
                        bf16x8 kf[2][2]; u32x2 vf[4][2]; \
                        _Pragma("unroll") for (int tl = 0; tl < 2; ++tl) _Pragma("unroll") for (int ks = 0; ks < 2; ++ks) kf[tl][ks] = *(const LAS bf16x8*)(stg + (32 * cc + 16 * tl + q) * 144 + 16 * g + 64 * ks); \
                        _Pragma("unroll") for (int dt = 0; dt < 4; ++dt) _Pragma("unroll") for (int hf = 0; hf < 2; ++hf) vf[dt][hf] = *(const LAS u32x2*)(stg + VOFF + (16 * dt + q) * 272 + 64 * cc + 8 * g + 32 * hf); \
                        const bool farc = (t0 - (32 * c + 31)) >= 113; \
                        const float ci = farc ? cfar : -mb; \
                        f32x4 s0 = __builtin_amdgcn_mfma_f32_16x16x32_bf16(kf[0][0], qf[0], (f32x4){ci, ci, ci, ci}, 0, 0, 0); \
                        s0 = __builtin_amdgcn_mfma_f32_16x16x32_bf16(kf[0][1], qf[1], s0, 0, 0, 0); \
                        f32x4 s1 = __builtin_amdgcn_mfma_f32_16x16x32_bf16(kf[1][0], qf[0], (f32x4){ci, ci, ci, ci}, 0, 0, 0); \
                        s1 = __builtin_amdgcn_mfma_f32_16x16x32_bf16(kf[1][1], qf[1], s1, 0, 0, 0); \
                        if (!farc) { \
                            _Pragma("unroll") for (int i = 0; i < 4; ++i) { const int k0 = 32 * c + 4 * g + i, k1 = k0 + 16; \
                                int d0 = t - k0, d1 = t - k1; d0 = d0 < 0 ? 0 : (d0 > 113 ? 113 : d0); d1 = d1 < 0 ? 0 : (d1 > 113 ? 113 : d1); \
                                s0[i] += LUT[h * 114 + d0]; s1[i] += LUT[h * 114 + d1]; } } \
                        float p[8]; \
                        _Pragma("unroll") for (int i = 0; i < 4; ++i) { p[i] = ((mwr[cc & 1][i] >> (c >> 1)) & 1u) ? __expf(s0[i]) : 0.f; p[4 + i] = ((mwr[cc & 1][4 + i] >> (c >> 1)) & 1u) ? __expf(s1[i]) : 0.f; } \
                        l += ((p[0] + p[1]) + (p[2] + p[3])) + ((p[4] + p[5]) + (p[6] + p[7])); \
                        const bf16x8 pf = pack_bf16x8(p[0], p[1], p[2], p[3], p[4], p[5], p[6], p[7]); \
                        _Pragma("unroll") for (int dt = 0; dt < 4; ++dt) { \
                            const bf16x8 vfr = __builtin_bit_cast(bf16x8, (u32x4){vf[dt][0].x, vf[dt][0].y, vf[dt][1].x, vf[dt][1].y}); \
                            o[dt] = __builtin_amdgcn_mfma_f32_16x16x32_bf16(vfr, pf, o[dt], 0, 0, 0); } } __builtin_amdgcn_sched_barrier(0); } \
                    asm volatile("s_waitcnt lgkmcnt(0)" ::: "memory"); __builtin_amdgcn_s_barrier(); asm volatile("" ::: "memory"); } while (0)
                for (int st = 0; st < nst; ++st) { DSA_STAGE(st, ra); }
#undef DSA_STAGE
#undef DSA_LOAD
#undef DSA_PUT
                l += __shfl_xor(l, 16); l += __shfl_xor(l, 32);
                const float il = 1.f / l;
                bf16_t* op = oab + (rowb + t) * 1024 + 512 + h * 64 + 4 * g;
#pragma unroll
                for (int dt = 0; dt < 4; ++dt) { u32x2 wv; wv.x = cvt_pk_bf16(o[dt][0] * il, o[dt][1] * il); wv.y = cvt_pk_bf16(o[dt][2] * il, o[dt][3] * il); *(u32x2*)(op + 16 * dt) = wv; }
            }
            __syncthreads();
        }
    }
}

__device__ __forceinline__ void phase_h2_route(Frame& F, int l) {
    LAS float* Av = (LAS float*)F.lds; LAS float* Sv = Av + DM;
    LAS float* RW = (LAS float*)(F.lds + 8192);
    LAS float* RB = (LAS float*)(F.lds + 73728);
    LAS int* lcnt = (LAS int*)(F.lds + 73728 + 64);
    LAS int* lbase = (LAS int*)(F.lds + 73728 + 128);
    LAS int* rinfo = (LAS int*)(F.lds + 73728 + 256);
    const float* mod = (const float*)(F.ws + WS_MOD) + (size_t)l * BATCH * NMOD;
    const int rows_per_blk = T / F.G, row_base = F.blk * rows_per_blk, b = row_base / SEQ;
    const float* n2g = F.in(IN_N2G); const float* rwp = F.in(IN_RW); const float* rbp = F.in(IN_RB);
    for (int d = F.tid; d < DM; d += NTHR) { Av[d] = n2g[l * DM + d] * (1.f + mod[(size_t)b * NMOD + 4 * DM + d]); Sv[d] = mod[(size_t)b * NMOD + 3 * DM + d]; }
    for (int i = F.tid; i < DM * NE; i += NTHR) RW[(i & 15) * DM + (i >> 4)] = rwp[i];
    if (F.tid < NE) { RB[F.tid] = rbp[F.tid]; lcnt[F.tid] = 0; }
    __syncthreads();
    bf16_t* hb = (bf16_t*)(F.ws + WS_H);
    const int rows_per_wave = rows_per_blk / NWAVES;
    for (int i0 = 0; i0 < rows_per_wave; i0 += 2) {
      f32x4 vin[2][4];
#pragma unroll
      for (int r = 0; r < 2; ++r)
#pragma unroll
          for (int j = 0; j < 4; ++j) vin[r][j] = *(const f32x4*)(F.out + (size_t)(row_base + F.wave * rows_per_wave + i0 + r) * DM + 4 * F.lane + 256 * j);
#pragma unroll 1
      for (int rr = 0; rr < 2; ++rr) {
        const int lr = F.wave * rows_per_wave + i0 + rr, row = row_base + lr;
        f32x4 v[4]; float ss = 0.f;
#pragma unroll
        for (int j = 0; j < 4; ++j) { v[j] = rr == 0 ? vin[0][j] : vin[1][j]; ss += (v[j][0] * v[j][0] + v[j][1] * v[j][1]) + (v[j][2] * v[j][2] + v[j][3] * v[j][3]); }
        const float r = 1.0f / sqrtf(wave_sum(ss) * (1.0f / DM) + EPS);
        float lg[NE];
#pragma unroll
        for (int e = 0; e < NE; ++e) lg[e] = 0.f;
#pragma unroll
        for (int j = 0; j < 4; ++j) { const int c0 = 4 * F.lane + 256 * j; u32x2 w;
#pragma unroll
            for (int k = 0; k < 4; ++k) v[j][k] = v[j][k] * r * Av[c0 + k] + Sv[c0 + k];
#pragma unroll
            for (int e = 0; e < NE; ++e) { const f32x4 rw = *(const LAS f32x4*)(RW + e * DM + c0);
                lg[e] += (v[j][0] * rw[0] + v[j][1] * rw[1]) + (v[j][2] * rw[2] + v[j][3] * rw[3]); }
            w.x = pk2(v[j][0], v[j][1]); w.y = pk2(v[j][2], v[j][3]);
            *(u32x2*)(hb + (size_t)row * DM + c0) = w; }
        float mxl = -1e30f;
#pragma unroll
        for (int e = 0; e < NE; ++e) { lg[e] = wave_sum(lg[e]) + RB[e]; mxl = fmaxf(mxl, lg[e]); }
        float pr[NE], den = 0.f;
#pragma unroll
        for (int e = 0; e < NE; ++e) { pr[e] = expf(lg[e] - mxl); den += pr[e]; }
        const float iden = 1.f / den;
#pragma unroll
        for (int e = 0; e < NE; ++e) pr[e] *= iden;
        int bg = 0; float bs = -1.f, bv0 = 0.f, bv1 = 0.f; int bi0 = 0, bi1 = 1;
#pragma unroll
        for (int g = 0; g < 4; ++g) {
            float v0 = pr[4 * g], v1 = -1.f; int i0 = 0, i1 = -1;
#pragma unroll
            for (int k = 1; k < 4; ++k) { const float p = pr[4 * g + k];
                if (p > v0) { v1 = v0; i1 = i0; v0 = p; i0 = k; } else if (p > v1) { v1 = p; i1 = k; } }
            const float gs = v0 + v1;
            if (gs > bs) { bs = gs; bg = g; bv0 = v0; bv1 = v1; bi0 = i0; bi1 = i1; }
        }
        const int e0 = bg * 4 + bi0, e1 = bg * 4 + bi1; const float wsum = bv0 + bv1, w0 = bv0 / wsum, w1 = bv1 / wsum;
        if (F.lane == 0) { const int p0 = __hip_atomic_fetch_add(lcnt + e0, 1, __ATOMIC_RELAXED, __HIP_MEMORY_SCOPE_WORKGROUP), p1 = __hip_atomic_fetch_add(lcnt + e1, 1, __ATOMIC_RELAXED, __HIP_MEMORY_SCOPE_WORKGROUP);
            rinfo[lr * 6 + 0] = e0; rinfo[lr * 6 + 1] = p0; rinfo[lr * 6 + 2] = __float_as_int(w0); rinfo[lr * 6 + 3] = e1; rinfo[lr * 6 + 4] = p1; rinfo[lr * 6 + 5] = __float_as_int(w1); }
      }
    }
    __syncthreads();
    unsigned* gcnt = F.ctl + CW_GCNT + 64 * l;
    if (F.tid < NE) lbase[F.tid] = (int)__hip_atomic_fetch_add(gcnt + F.tid, (unsigned)lcnt[F.tid], RLX_AGENT);
    __syncthreads();
    int* etok = (int*)(F.ws + WS_ETOK); float* ew = (float*)(F.ws + WS_EW); int* edst = (int*)(F.ws + WS_EDST);
    if (F.tid < 2 * rows_per_blk) { const int lr = F.tid >> 1, k = F.tid & 1; const int e = rinfo[lr * 6 + 3 * k], p = rinfo[lr * 6 + 3 * k + 1]; const float w = __int_as_float(rinfo[lr * 6 + 3 * k + 2]);
        const int slot = lbase[e] + p, tok = row_base + lr;
        etok[e * T + slot] = tok; ew[e * T + slot] = w; edst[e * T + slot] = 2 * tok + k; }
}

__device__ __forceinline__ int moe_table(Frame& F, int l, LAS int* tile_end) {
    if (F.tid < 64) { const int e = F.lane & 15; const int n = (int)__hip_atomic_load(F.ctl + CW_GCNT + 64 * l + e, RLX_AGENT); int tiles = (n + 255) >> 8, cum = tiles;
#pragma unroll
        for (int o = 1; o < 16; o <<= 1) { const int v = __shfl_up(cum, o, 16); if (e >= o) cum += v; }
        if (F.lane < 16) { tile_end[e] = cum; tile_end[16 + e] = n; } }
    __syncthreads();
    return tile_end[15];
}
#define XB_TMO      128
#define XB_XCNT(j)  (256  + 64 * (j))
#define XB_XSUB(j)  (1280 + 64 * (j))
#define XB_XGEN(j)  (2304 + 64 * (j))
#define XB_TOP      3328
#define XB_TOPGEN   3392
#define XCD_BAR_WORDS 3456
#define XB_SPIN_CAP (1u << 20)
__device__ __forceinline__ unsigned xb_ld(unsigned* p)              { return __hip_atomic_load(p, __ATOMIC_RELAXED, __HIP_MEMORY_SCOPE_AGENT); }
__device__ __forceinline__ unsigned xb_add(unsigned* p, unsigned v) { return __hip_atomic_fetch_add(p, v, __ATOMIC_RELAXED, __HIP_MEMORY_SCOPE_AGENT); }
__device__ __forceinline__ unsigned xb_xcc_id() { return (unsigned)__builtin_amdgcn_s_getreg((3 << 11) | 20) & 0xFu; }
#define XB_SPIN(cond, bar) do { unsigned _sp = 0; while (cond) { __builtin_amdgcn_s_sleep(1); \
    if ((++_sp & 255u) == 0u) { if (xb_ld(&(bar)[XB_TMO])) break; if (_sp > XB_SPIN_CAP) { atomicAdd(&(bar)[XB_TMO], 1u); break; } } } } while (0)
struct XcdBarrier { unsigned* bar; unsigned x; volatile LAS unsigned* st; };
__device__ __forceinline__ XcdBarrier xcd_barrier_post(unsigned* bar, volatile LAS unsigned* st) {
    XcdBarrier b; b.bar = bar; b.x = xb_xcc_id(); b.st = st;
    if (threadIdx.x == 0) (void)xb_add(&bar[XB_XCNT(b.x)], 1u);
    return b;
}
__device__ __forceinline__ void xcd_barrier_complete(unsigned* bar, unsigned x, unsigned& nloc, unsigned& nx) {
    const unsigned G = gridDim.x * gridDim.y * gridDim.z;
    unsigned sum, cnt, mine, sp = 0u;
    for (;;) {
        sum = 0u; cnt = 0u; mine = 0u;
#pragma unroll
        for (unsigned j = 0; j < 16; ++j) { const unsigned c = xb_ld(&bar[XB_XCNT(j)]); sum += c; cnt += (c > 0u) ? 1u : 0u; mine = (j == x) ? c : mine; }
        if (sum == G) break;
        __builtin_amdgcn_s_sleep(1);
        if ((++sp & 255u) == 0u) { if (xb_ld(&bar[XB_TMO])) break; if (sp > XB_SPIN_CAP) { atomicAdd(&bar[XB_TMO], 1u); break; } }
    }
    nloc = mine > 0u ? mine : 1u; nx = cnt > 0u ? cnt : 1u;
}
__device__ __forceinline__ void xcd_barrier(const XcdBarrier& b) {
    asm volatile("s_waitcnt vmcnt(0)" ::: "memory");
    __syncthreads();
    if (threadIdx.x == 0) {
        unsigned* bar = b.bar;
        __builtin_amdgcn_s_waitcnt(0);
        unsigned nloc = b.st[0], nx = b.st[1];
        if (nloc == 0u) { xcd_barrier_complete(bar, b.x, nloc, nx); b.st[0] = nloc; b.st[1] = nx; }
        const unsigned old = xb_add(&bar[XB_XSUB(b.x)], 1u);
        const unsigned gen = old / nloc;
        if (old + 1u == (gen + 1u) * nloc) {
            __builtin_amdgcn_fence(__ATOMIC_RELEASE, "agent");
            asm volatile("s_waitcnt vmcnt(0)" ::: "memory");
            const unsigned og = xb_add(&bar[XB_TOP], 1u);
            const unsigned tg = og / nx;
            if (og + 1u == (tg + 1u) * nx) xb_add(&bar[XB_TOPGEN], 1u);
            else XB_SPIN(xb_ld(&bar[XB_TOPGEN]) == tg, bar);
            __builtin_amdgcn_fence(__ATOMIC_ACQUIRE, "agent");
            xb_add(&bar[XB_XGEN(b.x)], 1u);
            asm volatile("s_waitcnt vmcnt(0)" ::: "memory");
        } else {
            XB_SPIN(xb_ld(&bar[XB_XGEN(b.x)]) == gen, bar);
            __builtin_amdgcn_fence(__ATOMIC_ACQUIRE, "agent");
            asm volatile("s_waitcnt vmcnt(0)" ::: "memory");
        }
    }
    __syncthreads();
}

constexpr int PH_PER_LAYER = 8, PH_FINAL = 1 + PH_PER_LAYER * DEPTH, N_PHASES = PH_FINAL + 1;
__global__ void __launch_bounds__(NTHR, 2) fwd_kernel(Args args) {
    extern __shared__ __attribute__((aligned(16))) unsigned char lds_raw[];
    Frame F;
    F.lds = (LAS unsigned char*)lds_raw;
    F.tid = threadIdx.x; F.lane = F.tid & 63; F.wave = __builtin_amdgcn_readfirstlane(F.tid >> 6); F.G = gridDim.x; F.blk = blockIdx.x;
    F.out = args.out; F.ws = args.ws; F.ctl = (unsigned*)(args.ws + WS_CTL);
    volatile LAS unsigned* MISC = (volatile LAS unsigned*)(F.lds + MISC_OFF);
    for (int u = F.tid; u < (LDS_BYTES - MISC_OFF) / 4; u += NTHR) ((LAS unsigned*)(F.lds + MISC_OFF))[u] = 0u;
    __syncthreads();
    if (F.tid < 36) ((LAS unsigned*)(F.lds + MISC_OFF + 1024))[F.tid] = ((const unsigned*)__builtin_amdgcn_kernarg_segment_ptr())[F.tid];
    __syncthreads();
    const int lo = args.ph_lo, hi = args.ph_hi;
    XcdBarrier bar; bar.bar = F.ctl + CW_BAR; bar.x = 0; bar.st = nullptr;
    if (hi - lo > 1) bar = xcd_barrier_post(F.ctl + CW_BAR, MISC + 8);
#define SEAM(k) do { if ((k) + 1 < hi) xcd_barrier(bar); } while (0)
    for (int ph = lo; ph < hi; ++ph) {
        { int t_ = threadIdx.x; asm volatile("" : "+v"(t_)); F.tid = t_; F.lane = t_ & 63; F.wave = __builtin_amdgcn_readfirstlane(t_ >> 6);
          unsigned char* w_ = args.ws; asm volatile("" : "+s"(w_)); F.ws = w_; F.ctl = (unsigned*)(w_ + WS_CTL); float* o_ = args.out; asm volatile("" : "+s"(o_)); F.out = o_; }
        if (ph == 0) { phase_prologue(F); }
        else if (ph == PH_FINAL) { phase_rows(F, DEPTH, 2); }
        else {
            const int l = (ph - 1) / PH_PER_LAYER, s = (ph - 1) % PH_PER_LAYER;
            bf16_t* hb = (bf16_t*)(F.ws + WS_H);
            if (s == 0) { phase_rows(F, l, l == 0 ? 0 : 1); }
            else if (s == 1) {
                { pg8::Gemm g{hb, (const bf16_t*)(F.ws + WS_WIN + l * WIN_LAYER), nullptr}; pg8::StaticOrder S; S.init(T, NMAIN, F.G, F.blk);
                  EpiIn E{F.ws, F.in(IN_QNG) + l * 64, F.in(IN_KNG) + l * 64};
                  pg8::gemm_phase<1024, 1024, 1024, EpiIn, pg8::StaticOrder, true>(F.lds, g, S, E, F.tid); }
                { pg8::Gemm g{(const bf16_t*)(F.ws + WS_WIN + l * WIN_LAYER) + (size_t)NMAIN * 1024, hb, nullptr}; pg8::StaticOrder S; S.init(512, T, F.G, (F.blk + F.G / 2) % F.G);
                  EpiPlain E{(bf16_t*)(F.ws + WS_VAT), T};
                  pg8::gemm_phase<1024, 1024, 1024, EpiPlain, pg8::StaticOrder, true>(F.lds, g, S, E, F.tid); }
            }
            else if (s == 2) { phase_strip(F, l); phase_sb(F); }
            else if (s == 3) {
                pg8::Gemm g{(const bf16_t*)(F.ws + WS_OAB), (const bf16_t*)(F.ws + WS_WO) + (size_t)l * 1024 * 1024, nullptr}; pg8::StaticOrder S; S.init(T, 1024, F.G, F.blk);
                EpiMerge E{(bf16_t*)(F.ws + WS_MERGED), (const bf16_t*)(F.ws + WS_SGA), (const bf16_t*)(F.ws + WS_SGB)};
                pg8::gemm_phase<1024, 1024, 1024, EpiMerge, pg8::StaticOrder, true, false, true>(F.lds, g, S, E, F.tid);
            }
            else if (s == 4) {
                pg8::Gemm g{(const bf16_t*)(F.ws + WS_MERGED), (const bf16_t*)(F.ws + WS_WOUT) + (size_t)l * 1024 * 1024, nullptr}; pg8::StaticOrder S; S.init(T, 1024, F.G, F.blk);
                EpiOut E{l == 0 ? F.in(IN_X) : F.out, F.out, (const float*)(F.ws + WS_MOD) + (size_t)l * BATCH * NMOD + 2 * DM};
                pg8::gemm_phase<1024, 1024, 1024, EpiOut, pg8::StaticOrder, true>(F.lds, g, S, E, F.tid);
            }
            else if (s == 5) { phase_h2_route(F, l); }
            else if (s == 6 || s == 7) {
                LAS int* tile_end = (LAS int*)(F.lds + MISC_OFF + 512);
                const int ntiles = moe_table(F, l, tile_end);
                MoeOrder S{tile_end, ntiles, F.G, F.blk};
                if (s == 6) { pg8::Gemm g{(const bf16_t*)(F.ws + WS_H), (const bf16_t*)(F.ws + WS_WGU), (const int*)(F.ws + WS_ETOK)};
                    EpiMoe1 E{(bf16_t*)(F.ws + WS_HID), (const float*)(F.ws + WS_EW)};
                    pg8::gemm_phase<1024, 1024, 1024, EpiMoe1, MoeOrder, true, true>(F.lds, g, S, E, F.tid); }
                else { pg8::Gemm g{(const bf16_t*)(F.ws + WS_HID), (const bf16_t*)(F.ws + WS_WD), nullptr};
                    EpiMoe2 E{(bf16_t*)(F.ws + WS_Y), (const int*)(F.ws + WS_EDST)};
                    pg8::gemm_phase<512, 512, 512, EpiMoe2, MoeOrder, true>(F.lds, g, S, E, F.tid); }
            }
        }
        __syncthreads();
        SEAM(ph);
    }
#undef SEAM
}

extern "C" void kernel_launch(void* const* d_in, const int* in_sizes, int n_in, void* d_out, int out_size, void* d_ws, size_t ws_size, hipStream_t stream) {
    static int grid = 0;
    if (grid == 0) {
        if (n_in != 18 || out_size != T * DM || ws_size < WS_END) { fprintf(stderr, "kernel_launch: unexpected problem (n_in %d, out %d, ws %zu)\n", n_in, out_size, ws_size); grid = -1; return; }
        int dev = 0, cus = 0;
        if (hipGetDevice(&dev) != hipSuccess || hipDeviceGetAttribute(&cus, hipDeviceAttributeMultiprocessorCount, dev) != hipSuccess) { grid = -1; return; }
        if (hipFuncSetAttribute((const void*)fwd_kernel, hipFuncAttributeMaxDynamicSharedMemorySize, LDS_BYTES) != hipSuccess) { fprintf(stderr, "kernel_launch: hipFuncSetAttribute failed\n"); grid = -1; return; }
        (void)hipGetLastError();
        grid = cus;
        if (grid != 256) fprintf(stderr, "kernel_launch: %d CUs (built for 256)\n", grid);
    }
    if (grid < 0) return;
    (void)hipMemsetAsync((char*)d_ws + WS_CTL, 0, CTL_ZERO_BYTES, stream);
    Args a{};
    for (int i = 0; i < 18; ++i) a.in[i] = (const float*)d_in[i];
    a.out = (float*)d_out; a.ws = (unsigned char*)d_ws;
#if ONE_LAUNCH
    a.ph_lo = 0; a.ph_hi = N_PHASES;
    hipLaunchKernelGGL(fwd_kernel, dim3(grid), dim3(NTHR), LDS_BYTES, stream, a);
#else
    for (int ph = 0; ph < N_PHASES; ++ph) {
        const int s = ph == 0 || ph == PH_FINAL ? -1 : (ph - 1) % PH_PER_LAYER;
        (void)s;
        a.ph_lo = ph; a.ph_hi = ph + 1;
        hipLaunchKernelGGL(fwd_kernel, dim3(grid), dim3(NTHR), LDS_BYTES, stream, a);
    }
#endif
}
```

```cpp
#include <hip/hip_runtime.h>
#include <cstdio>
#include <cstdint>

#define LAS __attribute__((address_space(3)))
#define GAS __attribute__((address_space(1)))
typedef unsigned short bf16_t;
typedef short bf16x8 __attribute__((ext_vector_type(8)));
typedef float f32x4 __attribute__((ext_vector_type(4)));
typedef float f32x2 __attribute__((ext_vector_type(2)));
typedef unsigned u32x4 __attribute__((ext_vector_type(4)));
typedef unsigned u32x2 __attribute__((ext_vector_type(2)));

constexpr int BATCH = 8, SEQ = 2048, DM = 1024, T = BATCH * SEQ, DEPTH = 2;
constexpr int NIN = 4808, NMOD = 6 * DM;
constexpr int NE = 16, DEXP = 512;
constexpr int NMAIN = 4352;
constexpr int PMAX = 36864;
constexpr float EPS = 1e-6f;
constexpr int NWAVES = 8, NTHR = 512;

#ifndef ONE_LAUNCH
#define ONE_LAUNCH 1
#endif

constexpr size_t MiB = 1u << 20;
constexpr size_t WS_CTL = 0, CTL_ZERO_BYTES = 1 * MiB;
constexpr size_t WS_MOD = 1 * MiB;
constexpr size_t WS_MODP = 2 * MiB;
constexpr size_t WS_ETOK = 8 * MiB, WS_EW = 9 * MiB, WS_EDST = 10 * MiB;
constexpr size_t WS_SLOTW = 11 * MiB, WS_SLOTD = 11 * MiB + 256 * 1024;
constexpr size_t WS_MASK = 12 * MiB;
constexpr size_t WS_WIN = 16 * MiB;
constexpr size_t WIN_LAYER = (size_t)4864 * 1024 * 2;
constexpr size_t WS_WO = 35 * MiB, WS_WOUT = 39 * MiB;
constexpr size_t WS_WGU = 43 * MiB;
constexpr size_t WS_WD = 75 * MiB;
constexpr size_t WS_H = 92 * MiB;
constexpr size_t WS_QA = 124 * MiB, WS_KA = 140 * MiB, WS_VAT = 156 * MiB, WS_QB = 172 * MiB, WS_QI = 188 * MiB;
constexpr size_t WS_KB = 204 * MiB, WS_VBT = 206 * MiB, WS_KI = 208 * MiB, WS_WI = 210 * MiB;
constexpr size_t WS_SGA = 212 * MiB, WS_SGB = 244 * MiB, WS_OAB = 276 * MiB;
constexpr size_t WS_MERGED = 124 * MiB;
constexpr size_t WS_TMP = 156 * MiB;
constexpr size_t WS_XG = 124 * MiB;
constexpr size_t WS_HID = 196 * MiB;
constexpr size_t WS_Y = 232 * MiB;
constexpr size_t WS_END = 308 * MiB;
constexpr int CW_GCNT = 64;
constexpr int CW_BAR = 4096;

#define LDS_WAIT() asm volatile("s_waitcnt lgkmcnt(0)" ::: "memory")
#define VM_WAIT() asm volatile("s_waitcnt vmcnt(0)" ::: "memory")
#define RLX_AGENT __ATOMIC_RELAXED, __HIP_MEMORY_SCOPE_AGENT
__device__ __forceinline__ unsigned f2bf(float f) { unsigned u = __builtin_bit_cast(unsigned, f); return (u + 0x7fffu + ((u >> 16) & 1u)) >> 16; }
__device__ __forceinline__ unsigned pk2(float lo, float hi) { return f2bf(lo) | (f2bf(hi) << 16); }
__device__ __forceinline__ float bflo(unsigned w) { return __builtin_bit_cast(float, w << 16); }
__device__ __forceinline__ float bfhi(unsigned w) { return __builtin_bit_cast(float, w & 0xffff0000u); }
__device__ __forceinline__ float bf2f(bf16_t h) { return __builtin_bit_cast(float, (unsigned)h << 16); }
__device__ __forceinline__ unsigned cvt_pk_bf16(float lo, float hi) { unsigned r; asm volatile("v_cvt_pk_bf16_f32 %0, %1, %2" : "=v"(r) : "v"(lo), "v"(hi)); return r; }
__device__ __forceinline__ u32x4 pack8(f32x4 a, f32x4 b) { u32x4 w; w.x = cvt_pk_bf16(a[0], a[1]); w.y = cvt_pk_bf16(a[2], a[3]); w.z = cvt_pk_bf16(b[0], b[1]); w.w = cvt_pk_bf16(b[2], b[3]); return w; }
__device__ __forceinline__ float sigmoidf_(float x) { return 1.f / (1.f + __expf(-x)); }
__device__ __forceinline__ float wave_sum(float v) {
    v += __builtin_bit_cast(float, __builtin_amdgcn_update_dpp(0, __builtin_bit_cast(int, v), 0xB1, 0xf, 0xf, true));
    v += __builtin_bit_cast(float, __builtin_amdgcn_update_dpp(0, __builtin_bit_cast(int, v), 0x4E, 0xf, 0xf, true));
    v += __builtin_bit_cast(float, __builtin_amdgcn_update_dpp(0, __builtin_bit_cast(int, v), 0x141, 0xf, 0xf, true));
    v += __builtin_bit_cast(float, __builtin_amdgcn_update_dpp(0, __builtin_bit_cast(int, v), 0x140, 0xf, 0xf, true));
    const float a = __builtin_bit_cast(float, __builtin_amdgcn_readlane(__builtin_bit_cast(int, v), 0)), b = __builtin_bit_cast(float, __builtin_amdgcn_readlane(__builtin_bit_cast(int, v), 16));
    const float c = __builtin_bit_cast(float, __builtin_amdgcn_readlane(__builtin_bit_cast(int, v), 32)), d = __builtin_bit_cast(float, __builtin_amdgcn_readlane(__builtin_bit_cast(int, v), 48));
    return (a + b) + (c + d);
}

namespace pg8 {
constexpr int BM = 256, BK = 64, HALF = 128, HTB = HALF * BK * 2, STAGE_BYTES = 8 * HTB, NXCD = 8, WGM = 8;
__host__ __device__ __forceinline__ int lds_byte(int r, int c) { const int st = (r >> 4) * 2 + (c >> 5), rr = r & 15, cc = c & 31, ob = rr * 64 + cc * 2; return st * 1024 + (ob ^ (((ob >> 9) & 1) << 5)); }
__host__ __device__ __forceinline__ void stage_rc(int b, int& R, int& C) { const int st = b / 1024, sb = b % 1024, swz = sb ^ (((sb >> 9) & 1) << 5); R = (st >> 1) * 16 + swz / 64; C = (st & 1) * 32 + (swz % 64) / 2; }
__host__ __device__ __forceinline__ int perm32(int rho) { const int n = rho >> 4, i = rho & 15; return 8 * (i >> 2) + 4 * n + (i & 3); }

struct Unit { int pm, pn, aux, nv; };
struct Gemm { const bf16_t* A; const bf16_t* Bt; const int* rowidx; };

struct StaticOrder {
    int nM, nN, nwg, G, c;
    __host__ __device__ void init(int M, int N, int G_, int c_) { nM = M / BM; nN = N / BM; nwg = nM * nN; G = G_; c = c_; }
    __host__ __device__ bool next(int i, Unit& u) const {
        const long L = (long)i * G + c; if (L >= nwg) return false;
        int wgid = (int)L; { const int q = nwg / NXCD, r = nwg % NXCD, xcd = wgid % NXCD, off = wgid / NXCD; wgid = (xcd < r ? xcd * (q + 1) : r * (q + 1) + (xcd - r) * q) + off; }
        const int nig = WGM * nN, gid = wgid / nig, fm = gid * WGM, gsz = (nM - fm) < WGM ? (nM - fm) : WGM;
        u.pm = fm + ((wgid % nig) % gsz); u.pn = (wgid % nig) / gsz; return true;
    }
    __device__ __forceinline__ void a_ready(const Unit&) const {}
    __device__ __forceinline__ void done(const Unit&) const {}
};

template <int LDA, int LDB, int KK, class Epi, class Sched, bool ALIGN_EPI, bool GATHER = false, bool MIDHOOK = false>
__device__ __forceinline__ void gemm_phase(LAS unsigned char* lds, const Gemm g, const Sched& S, const Epi& E, int tid) {
    asm volatile("" : "+v"(tid));
    const int wid = __builtin_amdgcn_readfirstlane(tid >> 6), lane = tid & 63, wr = wid >> 2, wc = wid & 3, fr = lane & 15, fq = lane >> 4;
    constexpr int nt = KK / BK;
    unsigned voffA[2], voffB[2];
#pragma unroll
    for (int i = 0; i < 2; ++i) { int R, C; stage_rc(tid * 16 + i * 8192, R, C); const int Rb = Epi::PERM ? ((R & ~31) + perm32(R & 31)) : R;
        voffA[i] = (unsigned)(R * LDA + C) * 2u; voffB[i] = (unsigned)(Rb * LDB + C) * 2u; }
    constexpr size_t kstep = (size_t)(BK * 2);
    constexpr size_t hstepA = (size_t)HALF * LDA * 2, hstepB = (size_t)HALF * LDB * 2;
    constexpr size_t tstepA = 2 * hstepA, tstepB = 2 * hstepB;
    const unsigned ldsw = (unsigned)wid * 1024u;
    const int aoff = lds_byte(wr * 64 + fr, fq * 8), boff = lds_byte(wc * 32 + fr, fq * 8);
#define PG8_SA(b, h) (((b) * 2 + (h)) * HTB)
#define PG8_SB(b, h) ((4 + (b) * 2 + (h)) * HTB)
#define PG8_STAGE(bufoff, gbase, voff) do { _Pragma("unroll") for (int _i = 0; _i < 2; ++_i) \
        __builtin_amdgcn_global_load_lds((const unsigned*)((const char*)(gbase) + (voff)[_i]), (LAS unsigned*)(lds + (bufoff) + ldsw + _i * 8192), 16, 0, 0); } while (0)
    unsigned gaC[2][2], gaN[2][2];
#define PG8_SETGA(ga, u) do { if constexpr (GATHER) { _Pragma("unroll") for (int h_ = 0; h_ < 2; ++h_) _Pragma("unroll") for (int i_ = 0; i_ < 2; ++i_) { int R_, C_; stage_rc(tid * 16 + i_ * 8192, R_, C_); \
        const int idx_ = h_ * HALF + R_; const int tok_ = idx_ < (u).nv ? g.rowidx[(u).aux + idx_] : 0; ga[h_][i_] = (unsigned)tok_ * (unsigned)(LDA * 2) + (unsigned)(C_ * 2); } } } while (0)
#define PG8_STAGE_A(bufoff, ngbase, gkoff, isn, h) do { if constexpr (GATHER) { unsigned vo_[2]; vo_[0] = (isn) ? gaN[h][0] : gaC[h][0]; vo_[1] = (isn) ? gaN[h][1] : gaC[h][1]; \
        PG8_STAGE(bufoff, (const char*)g.A + (gkoff), vo_); } else { PG8_STAGE(bufoff, ngbase, voffA); } } while (0)
#define PG8_LDA(dst, b, h) do { _Pragma("unroll") for (int m = 0; m < 4; ++m) _Pragma("unroll") for (int k = 0; k < 2; ++k) dst[m][k] = *(const LAS bf16x8*)(lds + PG8_SA(b, h) + aoff + m * 2048 + k * 1024); } while (0)
#define PG8_LDB(dst, b, h) do { _Pragma("unroll") for (int n = 0; n < 2; ++n) _Pragma("unroll") for (int k = 0; k < 2; ++k) dst[n][k] = *(const LAS bf16x8*)(lds + PG8_SB(b, h) + boff + n * 2048 + k * 1024); } while (0)
#define PG8_MMA(ai, bj, At, Bt) do { __builtin_amdgcn_s_setprio(1); _Pragma("unroll") for (int m = 0; m < 4; ++m) _Pragma("unroll") for (int n = 0; n < 2; ++n) _Pragma("unroll") for (int k = 0; k < 2; ++k) \
        acc[ai][bj][m][n] = __builtin_amdgcn_mfma_f32_16x16x32_bf16(Bt[n][k], At[m][k], acc[ai][bj][m][n], 0, 0, 0); __builtin_amdgcn_s_setprio(0); } while (0)
#define PG8_WAIT_V(n) asm volatile("s_waitcnt vmcnt(" #n ")" ::: "memory")
#define PG8_WAIT_L(n) asm volatile("s_waitcnt lgkmcnt(" #n ")" ::: "memory")
#define PG8_BAR __builtin_amdgcn_s_barrier()
#define PG8_SCHED __builtin_amdgcn_sched_barrier(0)
    Unit cur, nxt; int ui = 0;
    if (!S.next(0, cur)) return;
    f32x4 acc[2][2][4][2];
#pragma unroll
    for (int a = 0; a < 2; ++a)
#pragma unroll
        for (int b = 0; b < 2; ++b)
#pragma unroll
            for (int m = 0; m < 4; ++m)
#pragma unroll
                for (int n = 0; n < 2; ++n) acc[a][b][m][n] = (f32x4){0.f, 0.f, 0.f, 0.f};
    bf16x8 At[4][2], B0[2][2], B1[2][2];
    const char* cA = (const char*)g.A + (size_t)cur.pm * tstepA; const char* cB = (const char*)g.Bt + (size_t)cur.pn * tstepB;
    S.a_ready(cur);
    PG8_SETGA(gaC, cur);
    if constexpr (GATHER) {
#pragma unroll
        for (int h_ = 0; h_ < 2; ++h_)
#pragma unroll
            for (int i_ = 0; i_ < 2; ++i_) gaN[h_][i_] = gaC[h_][i_]; }
    PG8_STAGE(PG8_SB(0, 0), cB, voffB); PG8_STAGE(PG8_SB(0, 1), cB + hstepB, voffB); PG8_STAGE_A(PG8_SA(0, 0), cA, 0, false, 0); PG8_STAGE_A(PG8_SA(0, 1), cA + hstepA, 0, false, 1);
    if (wr == 1) PG8_BAR;
    PG8_WAIT_V(2); PG8_BAR;
    PG8_STAGE(PG8_SB(1, 0), cB + kstep, voffB); PG8_STAGE_A(PG8_SA(1, 0), cA + kstep, kstep, false, 0); PG8_STAGE(PG8_SB(1, 1), cB + hstepB + kstep, voffB);
    PG8_WAIT_V(6); PG8_BAR;
    for (;;) {
        const bool has_next = S.next(ui + 1, nxt);
        const char* nA = has_next ? (const char*)g.A + (size_t)nxt.pm * tstepA : cA; const char* nB = has_next ? (const char*)g.Bt + (size_t)nxt.pn * tstepB : cB;
        if (has_next) PG8_SETGA(gaN, nxt);
        for (int t = 0; t < nt; t += 2) {
            const bool last = (t == nt - 2);
            const char* a1 = cA + (size_t)(t + 1) * kstep;
            const char* a2 = last ? nA : cA + (size_t)(t + 2) * kstep; const char* b2 = last ? nB : cB + (size_t)(t + 2) * kstep;
            const char* a3 = a2 + kstep; const char* b3 = b2 + kstep;
            const size_t k2 = last ? 0 : (size_t)(t + 2) * kstep;
            if (last && has_next) S.a_ready(nxt);
            if constexpr (MIDHOOK) { if (t == nt / 2) E.mid(acc, cur, wr, wc, fr, fq); }
            PG8_LDB(B0, 0, 0); PG8_LDB(B1, 0, 1); PG8_SCHED; PG8_LDA(At, 0, 0); PG8_STAGE_A(PG8_SA(1, 1), a1 + hstepA, (size_t)(t + 1) * kstep, false, 1);
            PG8_WAIT_V(8); PG8_WAIT_L(0); PG8_BAR; PG8_MMA(0, 0, At, B0); PG8_MMA(0, 1, At, B1); PG8_BAR; PG8_SCHED;
            PG8_LDA(At, 0, 1); PG8_STAGE(PG8_SB(0, 0), b2, voffB); PG8_STAGE(PG8_SB(0, 1), b2 + hstepB, voffB); PG8_STAGE_A(PG8_SA(0, 0), a2, k2, last, 0);
            PG8_WAIT_V(8); PG8_WAIT_L(0); PG8_BAR; PG8_MMA(1, 0, At, B0); PG8_MMA(1, 1, At, B1); PG8_BAR; PG8_SCHED;
            PG8_LDB(B0, 1, 0); PG8_LDB(B1, 1, 1); PG8_SCHED; PG8_LDA(At, 1, 0); PG8_STAGE_A(PG8_SA(0, 1), a2 + hstepA, k2, last, 1);
            PG8_WAIT_V(8); PG8_WAIT_L(0); PG8_BAR; PG8_MMA(0, 0, At, B0); PG8_MMA(0, 1, At, B1); PG8_BAR; PG8_SCHED;
            PG8_LDA(At, 1, 1); PG8_STAGE(PG8_SB(1, 0), b3, voffB); PG8_STAGE(PG8_SB(1, 1), b3 + hstepB, voffB); PG8_STAGE_A(PG8_SA(1, 0), a3, k2 + kstep, last, 0);
            PG8_WAIT_V(8); PG8_WAIT_L(0); PG8_BAR; PG8_MMA(1, 0, At, B0); PG8_MMA(1, 1, At, B1); PG8_BAR; PG8_SCHED;
        }
        if constexpr (ALIGN_EPI) { if (wr == 0) PG8_BAR; }
        E(acc, cur, wr, wc, fr, fq); S.done(cur);
        if (!has_next) break;
#pragma unroll
        for (int a = 0; a < 2; ++a)
#pragma unroll
            for (int b = 0; b < 2; ++b)
#pragma unroll
                for (int m = 0; m < 4; ++m)
#pragma unroll
                    for (int n = 0; n < 2; ++n) acc[a][b][m][n] = (f32x4){0.f, 0.f, 0.f, 0.f};
        cur = nxt; cA = nA; cB = nB; ++ui;
        if constexpr (GATHER) {
#pragma unroll
            for (int h_ = 0; h_ < 2; ++h_)
#pragma unroll
                for (int i_ = 0; i_ < 2; ++i_) gaC[h_][i_] = gaN[h_][i_]; }
        if constexpr (ALIGN_EPI) { if (wr == 1) PG8_BAR; }
    }
    PG8_WAIT_V(0);
    if constexpr (!ALIGN_EPI) { if (wr == 0) PG8_BAR; }
    PG8_BAR;
#undef PG8_SA
#undef PG8_SB
#undef PG8_STAGE
#undef PG8_STAGE_A
#undef PG8_SETGA
#undef PG8_LDA
#undef PG8_LDB
#undef PG8_MMA
#undef PG8_WAIT_V
#undef PG8_WAIT_L
#undef PG8_BAR
#undef PG8_SCHED
}
}
typedef f32x4 AccT[2][2][4][2];

template <int SIG> __device__ __forceinline__ void store_tile_bf16(bf16_t* O, int ld, int colt, float sc, const AccT& acc, int row0, int wc, int fq) {
    const int col0 = colt + wc * 32 + 8 * fq;
#pragma unroll
    for (int ai = 0; ai < 2; ++ai)
#pragma unroll
        for (int m = 0; m < 4; ++m) { bf16_t* rowp = O + (size_t)(row0 + ai * 128 + m * 16) * ld + col0;
#pragma unroll
            for (int bj = 0; bj < 2; ++bj) { f32x4 v0 = acc[ai][bj][m][0] * sc, v1 = acc[ai][bj][m][1] * sc;
                if (SIG) {
#pragma unroll
                    for (int i = 0; i < 4; ++i) { v0[i] = sigmoidf_(v0[i]); v1[i] = sigmoidf_(v1[i]); } }
                *(u32x4*)(rowp + bj * 128) = pack8(v0, v1); } }
}
template <int NORM> __device__ __forceinline__ void store_head64(bf16_t* O, int ld, int cbase, const float* gain, float gsc, const AccT& acc, int row0, int fq) {
    f32x4 gq[2][2];
#pragma unroll
    for (int bj = 0; bj < 2; ++bj)
#pragma unroll
        for (int n = 0; n < 2; ++n) gq[bj][n] = NORM ? *(const f32x4*)(gain + 32 * bj + 8 * fq + 4 * n) * gsc : (f32x4){1.f, 1.f, 1.f, 1.f};
#pragma unroll
    for (int ai = 0; ai < 2; ++ai)
#pragma unroll
        for (int m = 0; m < 4; ++m) {
            float r = 1.f;
            if (NORM) { float ss = 0.f;
#pragma unroll
                for (int bj = 0; bj < 2; ++bj)
#pragma unroll
                    for (int n = 0; n < 2; ++n) { const f32x4 x = acc[ai][bj][m][n]; ss += (x[0] * x[0] + x[1] * x[1]) + (x[2] * x[2] + x[3] * x[3]); }
                ss += __shfl_xor(ss, 16); ss += __shfl_xor(ss, 32);
                r = 1.0f / sqrtf(ss * (1.0f / 64.0f) + EPS); }
            bf16_t* rowp = O + (size_t)(row0 + ai * 128 + m * 16) * ld + cbase + 8 * fq;
#pragma unroll
            for (int bj = 0; bj < 2; ++bj) { const f32x4 v0 = acc[ai][bj][m][0] * r * gq[bj][0], v1 = acc[ai][bj][m][1] * r * gq[bj][1];
                *(u32x4*)(rowp + 32 * bj) = pack8(v0, v1); } }
}
struct EpiIn {
    static constexpr bool PERM = true;
    unsigned char* ws; const float *qg, *kg;
    __device__ __forceinline__ void operator()(const AccT& acc, const pg8::Unit& u, int wr, int wc, int fr, int fq) const {
        asm volatile("" : "+v"(fr), "+v"(fq));
        bf16_t* const qa = (bf16_t*)(ws + WS_QA); bf16_t* const ka = (bf16_t*)(ws + WS_KA); bf16_t* const qb = (bf16_t*)(ws + WS_QB); bf16_t* const qi = (bf16_t*)(ws + WS_QI);
        bf16_t* const kb = (bf16_t*)(ws + WS_KB); bf16_t* const vbT = (bf16_t*)(ws + WS_VBT); bf16_t* const ki = (bf16_t*)(ws + WS_KI); bf16_t* const sga = (bf16_t*)(ws + WS_SGA); bf16_t* const sgb = (bf16_t*)(ws + WS_SGB);
        float* const wi = (float*)(ws + WS_WI);
        const int pn = u.pn, row0 = u.pm * 256 + wr * 64 + fr;
        if (pn < 2) store_tile_bf16<0>(qa, 512, pn * 256, 0.125f * 1.4426950408889634f, acc, row0, wc, fq);
        else if (pn < 4) store_tile_bf16<0>(ka, 512, (pn - 2) * 256, 1.f, acc, row0, wc, fq);
        else if (pn < 6) store_head64<1>(qb, 512, ((pn - 4) * 4 + wc) * 64, qg, 0.125f * 1.4426950408889634f, acc, row0, fq);
        else if (pn < 8) store_tile_bf16<0>(qi, 512, (pn - 6) * 256, 1.f, acc, row0, wc, fq);
        else if (pn == 8) {
            if (wc == 0) store_head64<1>(kb, 64, 0, kg, 1.f, acc, row0, fq);
            else if (wc == 1) {
#pragma unroll
                for (int ai = 0; ai < 2; ++ai)
#pragma unroll
                    for (int m = 0; m < 4; ++m) { bf16_t* p = vbT + (size_t)(8 * fq) * T + (row0 + ai * 128 + m * 16);
#pragma unroll
                        for (int bj = 0; bj < 2; ++bj)
#pragma unroll
                            for (int n = 0; n < 2; ++n)
#pragma unroll
                                for (int i = 0; i < 4; ++i) p[(size_t)(32 * bj + 4 * n + i) * T] = (bf16_t)f2bf(acc[ai][bj][m][n][i]); } }
            else if (wc == 2) store_head64<0>(ki, 64, 0, nullptr, 1.f, acc, row0, fq);
            else { if (fq == 0) {
#pragma unroll
                for (int ai = 0; ai < 2; ++ai)
#pragma unroll
                    for (int m = 0; m < 4; ++m) { float* p = wi + (size_t)(row0 + ai * 128 + m * 16) * 8; *(f32x4*)p = acc[ai][0][m][0]; *(f32x4*)(p + 4) = acc[ai][0][m][1]; } } }
        }
        else if (pn < 13) store_tile_bf16<1>(sga, 1024, (pn - 9) * 256, 1.f, acc, row0, wc, fq);
        else store_tile_bf16<1>(sgb, 1024, (pn - 13) * 256, 1.f, acc, row0, wc, fq);
    }
};
struct EpiPlain {
    static constexpr bool PERM = true;
    bf16_t* O; int ld;
    __device__ __forceinline__ void operator()(const AccT& acc, const pg8::Unit& u, int wr, int wc, int fr, int fq) const {
        asm volatile("" : "+v"(fr), "+v"(fq));
        store_tile_bf16<0>(O, ld, u.pn * 256, 1.f, acc, u.pm * 256 + wr * 64 + fr, wc, fq);
    }
};
struct EpiMerge {
    static constexpr bool PERM = true;
    bf16_t* O; const bf16_t* sga; const bf16_t* sgb;
    __device__ __forceinline__ void mid(AccT& acc, const pg8::Unit& u, int wr, int wc, int fr, int fq) const {
        asm volatile("" : "+v"(fr), "+v"(fq));
        const int row0 = u.pm * 256 + wr * 64 + fr, col0 = u.pn * 256 + wc * 32 + 8 * fq;
#pragma unroll
        for (int ai = 0; ai < 2; ++ai)
#pragma unroll
            for (int m = 0; m < 4; ++m) { const size_t off = (size_t)(row0 + ai * 128 + m * 16) * 1024 + col0;
#pragma unroll
                for (int bj = 0; bj < 2; ++bj) { const u32x4 a = *(const u32x4*)(sga + off + bj * 128), b = *(const u32x4*)(sgb + off + bj * 128);
                    f32x4& v0 = acc[ai][bj][m][0]; f32x4& v1 = acc[ai][bj][m][1];
                    v0[0] *= bflo(a.x) * __builtin_amdgcn_rcpf(bflo(b.x)); v0[1] *= bfhi(a.x) * __builtin_amdgcn_rcpf(bfhi(b.x)); v0[2] *= bflo(a.y) * __builtin_amdgcn_rcpf(bflo(b.y)); v0[3] *= bfhi(a.y) * __builtin_amdgcn_rcpf(bfhi(b.y));
                    v1[0] *= bflo(a.z) * __builtin_amdgcn_rcpf(bflo(b.z)); v1[1] *= bfhi(a.z) * __builtin_amdgcn_rcpf(bfhi(b.z)); v1[2] *= bflo(a.w) * __builtin_amdgcn_rcpf(bflo(b.w)); v1[3] *= bfhi(a.w) * __builtin_amdgcn_rcpf(bfhi(b.w)); } }
    }
    __device__ __forceinline__ void operator()(const AccT& acc, const pg8::Unit& u, int wr, int wc, int fr, int fq) const {
        asm volatile("" : "+v"(fr), "+v"(fq));
        const int row0 = u.pm * 256 + wr * 64 + fr, col0 = u.pn * 256 + wc * 32 + 8 * fq;
#pragma unroll
        for (int ai = 0; ai < 2; ++ai)
#pragma unroll
            for (int m = 0; m < 4; ++m) { const size_t off = (size_t)(row0 + ai * 128 + m * 16) * 1024 + col0;
#pragma unroll
                for (int bj = 0; bj < 2; ++bj) { const u32x4 gw = *(const u32x4*)(sgb + off + bj * 128);
                    f32x4 v0 = acc[ai][bj][m][0], v1 = acc[ai][bj][m][1];
                    v0[0] *= bflo(gw.x); v0[1] *= bfhi(gw.x); v0[2] *= bflo(gw.y); v0[3] *= bfhi(gw.y);
                    v1[0] *= bflo(gw.z); v1[1] *= bfhi(gw.z); v1[2] *= bflo(gw.w); v1[3] *= bfhi(gw.w);
                    *(u32x4*)(O + off + bj * 128) = pack8(v0, v1); } }
    }
};
struct EpiOut {
    static constexpr bool PERM = false;
    const float* xin; float* xout; const float* gvec;
    __device__ __forceinline__ void operator()(const AccT& acc, const pg8::Unit& u, int wr, int wc, int fr, int fq) const {
        asm volatile("" : "+v"(fr), "+v"(fq));
        const int row0 = u.pm * 256 + wr * 64 + fr, col0 = u.pn * 256 + wc * 32 + 4 * fq;
        const int b = (u.pm * 256) / SEQ;
        f32x4 gv[2][2];
#pragma unroll
        for (int bj = 0; bj < 2; ++bj)
#pragma unroll
            for (int n = 0; n < 2; ++n) gv[bj][n] = *(const f32x4*)(gvec + (size_t)b * NMOD + col0 + bj * 128 + n * 16);
#pragma unroll
        for (int ai = 0; ai < 2; ++ai)
#pragma unroll
            for (int m = 0; m < 4; ++m) { const size_t off = (size_t)(row0 + ai * 128 + m * 16) * 1024 + col0;
#pragma unroll
                for (int bj = 0; bj < 2; ++bj)
#pragma unroll
                    for (int n = 0; n < 2; ++n) { const f32x4 xi = *(const f32x4*)(xin + off + bj * 128 + n * 16);
                        *(f32x4*)(xout + off + bj * 128 + n * 16) = xi + gv[bj][n] * acc[ai][bj][m][n]; } }
    }
};
struct EpiMoe1 {
    static constexpr bool PERM = true;
    bf16_t* hid; const float* ew;
    __device__ __forceinline__ void operator()(const AccT& acc, const pg8::Unit& u, int wr, int wc, int fr, int fq) const {
        asm volatile("" : "+v"(fr), "+v"(fq));
        const int r0 = wr * 64 + fr, pnl = u.pn & 3, col0 = 128 * pnl + 16 * wc + 4 * fq;
#pragma unroll
        for (int ai = 0; ai < 2; ++ai)
#pragma unroll
            for (int m = 0; m < 4; ++m) { const int r = r0 + ai * 128 + m * 16; const float cw = r < u.nv ? ew[u.aux + r] : 0.f;
#pragma unroll
                for (int bj = 0; bj < 2; ++bj) { const f32x4 gt = acc[ai][bj][m][0], up = acc[ai][bj][m][1]; f32x4 h;
#pragma unroll
                    for (int i = 0; i < 4; ++i) h[i] = gt[i] * sigmoidf_(gt[i]) * up[i] * cw;
                    u32x2 w; w.x = cvt_pk_bf16(h[0], h[1]); w.y = cvt_pk_bf16(h[2], h[3]);
                    *(u32x2*)(hid + (size_t)(u.pm * 256 + r) * DEXP + col0 + 64 * bj) = w; } }
    }
};
struct EpiMoe2 {
    static constexpr bool PERM = true;
    bf16_t* y; const int* edst;
    __device__ __forceinline__ void operator()(const AccT& acc, const pg8::Unit& u, int wr, int wc, int fr, int fq) const {
        asm volatile("" : "+v"(fr), "+v"(fq));
        const int r0 = wr * 64 + fr, col0 = (u.pn & 3) * 256 + wc * 32 + 8 * fq;
#pragma unroll
        for (int ai = 0; ai < 2; ++ai)
#pragma unroll
            for (int m = 0; m < 4; ++m) { const int r = r0 + ai * 128 + m * 16;
                if (r < u.nv) { const int dst = edst[u.aux + r]; bf16_t* rowp = y + (size_t)dst * 1024 + col0;
#pragma unroll
                    for (int bj = 0; bj < 2; ++bj) *(u32x4*)(rowp + bj * 128) = pack8(acc[ai][bj][m][0], acc[ai][bj][m][1]); } }
    }
};
struct MoeOrder {
    const LAS int* tile_end; int ntiles, G, c;
    __device__ __forceinline__ bool next(int i, pg8::Unit& u) const {
        const int L = i * G + c; if (L >= 4 * ntiles) return false;
        const int rt = L >> 2; int e = 0;
#pragma unroll
        for (int j = 0; j < NE; ++j) e += (rt >= tile_end[j]) ? 1 : 0;
        e = __builtin_amdgcn_readfirstlane(e);
        const int ts = e == 0 ? 0 : __builtin_amdgcn_readfirstlane(tile_end[e - 1]), ne = __builtin_amdgcn_readfirstlane(tile_end[16 + e]);
        u.pm = rt; u.pn = e * 4 + (L & 3); u.aux = e * T + (rt - ts) * 256; u.nv = ne - (rt - ts) * 256; return true;
    }
    __device__ __forceinline__ void a_ready(const pg8::Unit&) const {}
    __device__ __forceinline__ void done(const pg8::Unit&) const {}
};

constexpr int RING_BYTES = 131072, MISC_OFF = 133120, LDS_BYTES = 147456;
struct Args { const float* in[18]; float* out; unsigned char* ws; int ph_lo, ph_hi; };
struct Frame {
    LAS unsigned char* lds; int tid, lane, wave, G, blk;
    float* out; unsigned char* ws; unsigned* ctl;
    __device__ __forceinline__ const float* in(int i) const {
        const LAS unsigned* t = (const LAS unsigned*)(lds + MISC_OFF + 1024) + 2 * i;
        const unsigned lo = __builtin_amdgcn_readfirstlane(t[0]), hi = __builtin_amdgcn_readfirstlane(t[1]);
        return (const float*)(((unsigned long long)hi << 32) | lo);
    }
};
enum { IN_X = 0, IN_C, IN_WADA, IN_BADA, IN_N1G, IN_WIN, IN_QNG, IN_KNG, IN_RELB, IN_WOA, IN_WOB, IN_WOUT, IN_N2G, IN_RW, IN_RB, IN_WG, IN_WU, IN_WDN };

__device__ __forceinline__ int win_src_col(int r) {
    if (r < 1024) return r;
    if (r < 1536) { const int rho = r - 1024, tile = rho >> 8, q = rho & 255, bj = q >> 7, wc = (q >> 5) & 3, j = q & 31; return 1536 + (tile * 4 + wc) * 64 + 32 * bj + j; }
    if (r < 2048) return 2176 + (r - 1536);
    if (r < 2304) { const int q = r - 2048, bj = q >> 7, wc = (q >> 5) & 3, j = q & 31, cs = 32 * bj + j;
        if (wc == 0) return 2048 + cs; if (wc == 1) return 2112 + cs; if (wc == 2) return 2688 + cs; return cs < 8 ? 2752 + cs : -1; }
    if (r < 3328) return 2760 + (r - 2304);
    if (r < 4352) return 3784 + (r - 3328);
    return 1024 + (r - 4352);
}
__device__ __forceinline__ void transpose_item(const float* colp, int ldw, int ksrc0, bf16_t* WT, size_t drow0, int ldk, int kdst0, LAS float* scr, int lane) {
    float tv[32];
    const float* cp = colp ? colp + (size_t)(ksrc0 + (lane >> 5)) * ldw : nullptr;
#pragma unroll
    for (int i = 0; i < 32; ++i) tv[i] = cp ? cp[(size_t)(2 * i) * ldw] : 0.f;
#pragma unroll
    for (int i = 0; i < 32; ++i) scr[(2 * i + (lane >> 5)) * 33 + (lane & 31)] = tv[i];
    LDS_WAIT(); asm volatile("" ::: "memory");
    const int c = lane & 7;
#pragma unroll
    for (int j = 0; j < 4; ++j) { const int n = (lane >> 3) + 8 * j; const LAS float* s = scr + (8 * c) * 33 + n;
        u32x4 o; o.x = pk2(s[0 * 33], s[1 * 33]); o.y = pk2(s[2 * 33], s[3 * 33]); o.z = pk2(s[4 * 33], s[5 * 33]); o.w = pk2(s[6 * 33], s[7 * 33]);
        *(u32x4*)(WT + (drow0 + n) * ldk + kdst0 + 8 * c) = o; }
    LDS_WAIT(); asm volatile("" ::: "memory");
}
constexpr int IT_WIN = 152 * 16, IT_WO = 32 * 16, IT_WOUT = 32 * 16, IT_SMALL = IT_WIN + IT_WO + IT_WOUT;
constexpr int IT_WGU = 16 * 32 * 16, IT_WD = 16 * 32 * 8, IT_EXP = IT_WGU + IT_WD;
__device__ __forceinline__ void convert_small_item(Frame& F, int l, int it, LAS float* scr) {
    const int n31 = F.lane & 31;
    if (it < IT_WIN) { const int rg = it >> 4, kg = it & 15; const int col = win_src_col(rg * 32 + n31);
        transpose_item(col >= 0 ? F.in(IN_WIN) + (size_t)l * DM * NIN + col : nullptr, NIN, kg * 64, (bf16_t*)(F.ws + WS_WIN + l * WIN_LAYER), (size_t)rg * 32, 1024, kg * 64, scr, F.lane); return; }
    it -= IT_WIN;
    if (it < IT_WO) { const int rg = it >> 4, kg = it & 15, k0 = kg * 64; const float* src = (k0 < 512 ? F.in(IN_WOA) : F.in(IN_WOB)) + (size_t)l * 512 * 1024 + rg * 32 + n31;
        transpose_item(src, 1024, k0 & 511, (bf16_t*)(F.ws + WS_WO) + (size_t)l * 1024 * 1024, (size_t)rg * 32, 1024, k0, scr, F.lane); return; }
    it -= IT_WO;
    { const int rg = it >> 4, kg = it & 15; transpose_item(F.in(IN_WOUT) + (size_t)l * 1024 * 1024 + rg * 32 + n31, 1024, kg * 64, (bf16_t*)(F.ws + WS_WOUT) + (size_t)l * 1024 * 1024, (size_t)rg * 32, 1024, kg * 64, scr, F.lane); }
}
__device__ __forceinline__ void convert_expert_item(Frame& F, int l, int it, LAS float* scr) {
    const int n31 = F.lane & 31;
    if (it < IT_WGU) { const int e = it >> 9, r2 = it & 511, rg = r2 >> 4, kg = r2 & 15; const int r = rg * 32 + n31, q = r >> 3, i = r & 7;
        const float* src = (i < 4 ? F.in(IN_WG) : F.in(IN_WU)) + (size_t)(l * NE + e) * DM * DEXP + 4 * q + (i & 3);
        transpose_item(src, DEXP, kg * 64, (bf16_t*)(F.ws + WS_WGU) + (size_t)e * 1024 * 1024, (size_t)rg * 32, 1024, kg * 64, scr, F.lane); return; }
    it -= IT_WGU;
    { const int e = it >> 8, r2 = it & 255, rg = r2 >> 3, kg = r2 & 7;
        transpose_item(F.in(IN_WDN) + (size_t)(l * NE + e) * DEXP * DM + rg * 32 + n31, DM, kg * 64, (bf16_t*)(F.ws + WS_WD) + (size_t)e * 1024 * 512, (size_t)rg * 32, 512, kg * 64, scr, F.lane); }
}

__device__ __forceinline__ void phase_prologue(Frame& F) {
    LAS float* scr = (LAS float*)(F.lds + F.wave * 8448);
    LAS float* sil = (LAS float*)(F.lds + 69632);
    const float* cin = F.in(IN_C); const float* badap = F.in(IN_BADA);
    for (int i = F.tid; i < BATCH * DM; i += NTHR) { const float v = cin[i]; sil[i] = v / (1.f + __expf(-v)); }
    __syncthreads();
    const int gw = F.blk * NWAVES + F.wave, NGW = F.G * NWAVES;
    float* modp = (float*)(F.ws + WS_MODP);
    for (int it = gw; it < 16 * 2 * 96; it += NGW) {
        const int jb = it % 96, l = (it / 96) & 1, kc = it / 192; const int j = jb * 64 + F.lane;
        float a[BATCH];
#pragma unroll
        for (int b = 0; b < BATCH; ++b) a[b] = 0.f;
        const float* wp = F.in(IN_WADA) + ((size_t)l * DM + kc * 64) * NMOD + j;
        for (int k0 = 0; k0 < 64; k0 += 16) { float wv[16];
#pragma unroll
            for (int k = 0; k < 16; ++k) wv[k] = wp[(size_t)(k0 + k) * NMOD];
#pragma unroll
            for (int k = 0; k < 16; ++k)
#pragma unroll
                for (int b = 0; b < BATCH; ++b) a[b] += sil[b * DM + kc * 64 + k0 + k] * wv[k]; }
        const float bias = (kc == 0) ? badap[l * NMOD + j] : 0.f;
#pragma unroll
        for (int b = 0; b < BATCH; ++b) modp[(((size_t)kc * 2 + l) * BATCH + b) * NMOD + j] = a[b] + bias;
    }
    for (int it = gw; it < 2 * IT_SMALL; it += NGW) { const int l = it >= IT_SMALL ? 1 : 0; convert_small_item(F, l, it - l * IT_SMALL, scr); }
    for (int it = gw; it < IT_EXP; it += NGW) convert_expert_item(F, 0, it, scr);
}

__device__ __forceinline__ float modsum(const float* modp, int l, int b, int j) {
    float s = 0.f;
#pragma unroll
    for (int kc = 0; kc < 16; ++kc) s += modp[(((size_t)kc * 2 + l) * BATCH + b) * NMOD + j];
    return s;
}
__device__ __forceinline__ void phase_rows(Frame& F, int l, int mode) {
    LAS float* Av = (LAS float*)F.lds; LAS float* Sv = Av + DM; LAS float* Gv = Sv + DM;
    const float* modp = (const float*)(F.ws + WS_MODP);
    float* mod = (float*)(F.ws + WS_MOD);
    const float* n1g = F.in(IN_N1G); const float* xin = F.in(IN_X);
    const int row_base = F.blk * (T / F.G);
    const int b = row_base / SEQ;
    if (mode == 0) {
        const int per = (2 * BATCH * NMOD) / F.G;
        for (int i = F.tid; i < per; i += NTHR) { const int idx = F.blk * per + i; const int ll = idx / (BATCH * NMOD), bb = (idx / NMOD) % BATCH, j = idx % NMOD; mod[idx] = modsum(modp, ll, bb, j); }
    }
    for (int d = F.tid; d < DM; d += NTHR) {
        if (mode != 2) { Av[d] = n1g[l * DM + d] * (1.f + modsum(modp, l, b, 1 * DM + d)); Sv[d] = modsum(modp, l, b, 0 * DM + d); }
        if (mode != 0) Gv[d] = modsum(modp, l - 1, b, 5 * DM + d);
    }
    if (mode == 1) {
        LAS float* scr = (LAS float*)(F.lds + 16384 + F.wave * 8448);
        const int gw = F.blk * NWAVES + F.wave, NGW = F.G * NWAVES;
        for (int it = gw; it < IT_EXP; it += NGW) convert_expert_item(F, l, it, scr);
    }
    __syncthreads();
    const bf16_t* ybuf = (const bf16_t*)(F.ws + WS_Y);
    bf16_t* hb = (bf16_t*)(F.ws + WS_H);
    const int rows_per_wave = (T / F.G) / NWAVES;
    for (int i0 = 0; i0 < rows_per_wave; i0 += 4) {
        const int row0 = row_base + F.wave * rows_per_wave + i0;
        f32x4 v[4][4]; u32x2 ya[4][4], yb[4][4];
#pragma unroll
        for (int r = 0; r < 4; ++r) { const float* xr = (mode == 0 ? xin : F.out) + (size_t)(row0 + r) * DM;
#pragma unroll
            for (int j = 0; j < 4; ++j) { v[r][j] = *(const f32x4*)(xr + 4 * F.lane + 256 * j);
                if (mode != 0) { ya[r][j] = *(const u32x2*)(ybuf + (size_t)(2 * (row0 + r)) * DM + 4 * F.lane + 256 * j); yb[r][j] = *(const u32x2*)(ybuf + (size_t)(2 * (row0 + r) + 1) * DM + 4 * F.lane + 256 * j); } } }
#pragma unroll
        for (int r = 0; r < 4; ++r) { const int row = row0 + r;
            if (mode != 0) {
#pragma unroll
                for (int j = 0; j < 4; ++j) { const int c0 = 4 * F.lane + 256 * j; const u32x2 y0 = ya[r][j], y1 = yb[r][j];
                    v[r][j][0] += Gv[c0 + 0] * (bflo(y0.x) + bflo(y1.x)); v[r][j][1] += Gv[c0 + 1] * (bfhi(y0.x) + bfhi(y1.x));
                    v[r][j][2] += Gv[c0 + 2] * (bflo(y0.y) + bflo(y1.y)); v[r][j][3] += Gv[c0 + 3] * (bfhi(y0.y) + bfhi(y1.y));
                    *(f32x4*)(F.out + (size_t)row * DM + c0) = v[r][j]; }
            }
            if (mode != 2) {
                float ss = 0.f;
#pragma unroll
                for (int j = 0; j < 4; ++j) ss += (v[r][j][0] * v[r][j][0] + v[r][j][1] * v[r][j][1]) + (v[r][j][2] * v[r][j][2] + v[r][j][3] * v[r][j][3]);
                const float rs = 1.0f / sqrtf(wave_sum(ss) * (1.0f / DM) + EPS);
#pragma unroll
                for (int j = 0; j < 4; ++j) { const int c0 = 4 * F.lane + 256 * j; u32x2 w;
                    w.x = pk2(v[r][j][0] * rs * Av[c0] + Sv[c0], v[r][j][1] * rs * Av[c0 + 1] + Sv[c0 + 1]);
                    w.y = pk2(v[r][j][2] * rs * Av[c0 + 2] + Sv[c0 + 2], v[r][j][3] * rs * Av[c0 + 3] + Sv[c0 + 3]);
                    *(u32x2*)(hb + (size_t)row * DM + c0) = w; }
            }
        }
    }
}

typedef float f32x16 __attribute__((ext_vector_type(16)));
__device__ __forceinline__ bf16x8 pack_bf16x8(float a0, float a1, float a2, float a3, float a4, float a5, float a6, float a7) {
    u32x4 w; w.x = cvt_pk_bf16(a0, a1); w.y = cvt_pk_bf16(a2, a3); w.z = cvt_pk_bf16(a4, a5); w.w = cvt_pk_bf16(a6, a7); return __builtin_bit_cast(bf16x8, w);
}
__device__ __forceinline__ void phase_sb(Frame& F) {
    const bf16_t* qa = (const bf16_t*)(F.ws + WS_QA); const bf16_t* ka = (const bf16_t*)(F.ws + WS_KA); const bf16_t* vaT = (const bf16_t*)(F.ws + WS_VAT);
    bf16_t* oab = (bf16_t*)(F.ws + WS_OAB);
    const int lane = F.lane, q32 = lane & 31, hi = lane >> 5;
    const int NGW = F.G * NWAVES;
    for (int wu = F.blk * NWAVES + F.wave; wu < BATCH * 8 * 64; wu += NGW) {
        const int qblk = wu & 63, bh = wu >> 6, b = bh >> 3, h = bh & 7;
        const int qw = qblk * 32, t = qw + q32;
        const size_t rowb = (size_t)b * SEQ;
        bf16x8 qf[4];
#pragma unroll
        for (int ks = 0; ks < 4; ++ks) qf[ks] = *(const bf16x8*)(qa + (rowb + t) * 512 + h * 64 + 16 * ks + 8 * hi);
        f32x16 o0, o1;
#pragma unroll
        for (int r = 0; r < 16; ++r) { o0[r] = 0.f; o1[r] = 0.f; }
        float R = 0.f;
        for (int kb = qw; kb >= 0; kb -= 32) {
            const bf16_t* kp = ka + (rowb + kb + q32) * 512 + h * 64 + 8 * hi;
            bf16x8 kf[4];
#pragma unroll
            for (int ks = 0; ks < 4; ++ks) kf[ks] = *(const bf16x8*)(kp + 16 * ks);
            const bf16_t* vp = vaT + (size_t)(h * 64 + q32) * T + rowb + kb + 4 * hi;
            u32x2 vv[2][2][2];
#pragma unroll
            for (int dt = 0; dt < 2; ++dt)
#pragma unroll
                for (int sx = 0; sx < 2; ++sx)
#pragma unroll
                    for (int hf = 0; hf < 2; ++hf) vv[dt][sx][hf] = *(const u32x2*)(vp + (size_t)dt * 32 * T + 16 * sx + 8 * hf);
            f32x16 z;
#pragma unroll
            for (int r = 0; r < 16; ++r) z[r] = 0.f;
#pragma unroll
            for (int ks = 0; ks < 4; ++ks) z = __builtin_amdgcn_mfma_f32_32x32x16_bf16(kf[ks], qf[ks], z, 0, 0, 0);
            float lv[16], zs[16]; bool vl[16];
#pragma unroll
            for (int r = 0; r < 16; ++r) { const float zz = z[r]; const float sp = fmaxf(zz, 0.f) + __builtin_amdgcn_logf(1.f + __builtin_amdgcn_exp2f(-fabsf(zz)));
                vl[r] = (kb + (r & 3) + 8 * (r >> 2) + 4 * hi) < t; lv[r] = vl[r] ? -sp : 0.f; zs[r] = zz - sp; }
            float gs[4], pg[4], tl[4];
#pragma unroll
            for (int k = 0; k < 4; ++k) { gs[k] = (lv[4 * k] + lv[4 * k + 1]) + (lv[4 * k + 2] + lv[4 * k + 3]); pg[k] = __shfl_xor(gs[k], 32); }
            tl[3] = 0.f; tl[2] = gs[3] + pg[3]; tl[1] = tl[2] + (gs[2] + pg[2]); tl[0] = tl[1] + (gs[1] + pg[1]);
            const float tot = tl[0] + (gs[0] + pg[0]);
            float av[16];
#pragma unroll
            for (int k = 0; k < 4; ++k) { const float base = R + tl[k] + (hi == 0 ? pg[k] : 0.f);
                const float s3 = base, s2 = s3 + lv[4 * k + 3], s1 = s2 + lv[4 * k + 2], s0 = s1 + lv[4 * k + 1];
                av[4 * k + 0] = vl[4 * k + 0] ? __builtin_amdgcn_exp2f(zs[4 * k + 0] + s0) : 0.f; av[4 * k + 1] = vl[4 * k + 1] ? __builtin_amdgcn_exp2f(zs[4 * k + 1] + s1) : 0.f;
                av[4 * k + 2] = vl[4 * k + 2] ? __builtin_amdgcn_exp2f(zs[4 * k + 2] + s2) : 0.f; av[4 * k + 3] = vl[4 * k + 3] ? __builtin_amdgcn_exp2f(zs[4 * k + 3] + s3) : 0.f; }
            R += tot;
            const bf16x8 pf0 = pack_bf16x8(av[0], av[1], av[2], av[3], av[4], av[5], av[6], av[7]);
            const bf16x8 pf1 = pack_bf16x8(av[8], av[9], av[10], av[11], av[12], av[13], av[14], av[15]);
#define SB_VF(dt, sx) __builtin_bit_cast(bf16x8, (u32x4){vv[dt][sx][0].x, vv[dt][sx][0].y, vv[dt][sx][1].x, vv[dt][sx][1].y})
            o0 = __builtin_amdgcn_mfma_f32_32x32x16_bf16(SB_VF(0, 0), pf0, o0, 0, 0, 0);
            o0 = __builtin_amdgcn_mfma_f32_32x32x16_bf16(SB_VF(0, 1), pf1, o0, 0, 0, 0);
            o1 = __builtin_amdgcn_mfma_f32_32x32x16_bf16(SB_VF(1, 0), pf0, o1, 0, 0, 0);
            o1 = __builtin_amdgcn_mfma_f32_32x32x16_bf16(SB_VF(1, 1), pf1, o1, 0, 0, 0);
#undef SB_VF
            if (__all(R <= -150.1f)) break;
        }
        bf16_t* op = oab + (rowb + t) * 1024 + h * 64 + 4 * hi;
#pragma unroll
        for (int k = 0; k < 4; ++k) { u32x2 w0, w1; w0.x = cvt_pk_bf16(o0[4 * k], o0[4 * k + 1]); w0.y = cvt_pk_bf16(o0[4 * k + 2], o0[4 * k + 3]);
            w1.x = cvt_pk_bf16(o1[4 * k], o1[4 * k + 1]); w1.y = cvt_pk_bf16(o1[4 * k + 2], o1[4 * k + 3]);
            *(u32x2*)(op + 8 * k) = w0; *(u32x2*)(op + 32 + 8 * k) = w1; }
    }
}

__device__ __forceinline__ unsigned sortable(float f) { const unsigned u = __builtin_bit_cast(unsigned, f); return (u & 0x80000000u) ? ~u : (u | 0x80000000u); }
__device__ __forceinline__ int wave_total(int v) {
    v += __builtin_amdgcn_update_dpp(0, v, 0xB1, 0xf, 0xf, true);
    v += __builtin_amdgcn_update_dpp(0, v, 0x4E, 0xf, 0xf, true);
    v += __builtin_amdgcn_update_dpp(0, v, 0x141, 0xf, 0xf, true);
    v += __builtin_amdgcn_update_dpp(0, v, 0x140, 0xf, 0xf, true);
    return __builtin_amdgcn_readlane(v, 0) + __builtin_amdgcn_readlane(v, 16) + __builtin_amdgcn_readlane(v, 32) + __builtin_amdgcn_readlane(v, 48);
}
typedef unsigned short u16x2 __attribute__((ext_vector_type(2)));
__device__ __forceinline__ u16x2 pk_ge(unsigned x, unsigned cm1) {
    unsigned d; asm("v_pk_sub_u16 %0, %1, %2 clamp\n\tv_pk_min_u16 %0, %0, 1 op_sel_hi:[1,0]" : "=v"(d) : "v"(x), "v"(cm1));
    return __builtin_bit_cast(u16x2, d);
}
template <bool MASKED>
__device__ __forceinline__ void pk_bisect2(const unsigned (&hpa)[16], const unsigned (&lpa)[16], const unsigned (&hpb)[16], const unsigned (&lpb)[16], unsigned hha, unsigned hhb,
                                           int needa, int needb, unsigned& ta, unsigned& tb, bool& exa, bool& exb) {
    ta = 0u; tb = 0u; exa = false; exb = false;
#pragma unroll 1
    for (int bit = 15; bit >= 0; --bit) {
        const unsigned ca = ta | (1u << bit), cb = tb | (1u << bit), ma = (ca - 1u) * 0x10001u, mb_ = (cb - 1u) * 0x10001u;
        u16x2 na = (u16x2){0, 0}, nb = (u16x2){0, 0};
#pragma unroll
        for (int m = 0; m < 16; ++m) {
            if (MASKED) {
                const u16x2 ea = __builtin_elementwise_sub_sat((u16x2){1, 1}, __builtin_bit_cast(u16x2, hpa[m] ^ hha)), eb = __builtin_elementwise_sub_sat((u16x2){1, 1}, __builtin_bit_cast(u16x2, hpb[m] ^ hhb));
                na += pk_ge(lpa[m] & (__builtin_bit_cast(unsigned, ea) * 0xffffu), ma); nb += pk_ge(lpb[m] & (__builtin_bit_cast(unsigned, eb) * 0xffffu), mb_);
            } else { na += pk_ge(hpa[m], ma); nb += pk_ge(hpb[m], mb_); } }
        const int cta = wave_total((int)na.x + (int)na.y), ctb = wave_total((int)nb.x + (int)nb.y);
        if (!exa) { if (cta >= needa) ta = ca; if (cta == needa) exa = true; }
        if (!exb) { if (ctb >= needb) tb = cb; if (ctb == needb) exb = true; }
        if (exa && exb) break;
    }
}
__device__ __forceinline__ void topk_emit_pk(const unsigned (&hp)[16], const unsigned (&lp)[16], unsigned thr, LAS unsigned* maskrow, int lane) {
    int cg = 0, ce = 0;
#pragma unroll
    for (int m = 0; m < 16; ++m) { const unsigned k0 = (hp[m] << 16) | (lp[m] & 0xffffu), k1 = (hp[m] & 0xffff0000u) | (lp[m] >> 16);
        cg += (k0 > thr) ? 1 : 0; ce += (k0 == thr) ? 1 : 0; cg += (k1 > thr) ? 1 : 0; ce += (k1 == thr) ? 1 : 0; }
    const int need = 256 - wave_total(cg), neq = wave_total(ce);
    unsigned bits = 0u;
    if (neq <= need) {
#pragma unroll
        for (int m = 0; m < 16; ++m) { const unsigned k0 = (hp[m] << 16) | (lp[m] & 0xffffu), k1 = (hp[m] & 0xffff0000u) | (lp[m] >> 16);
            bits |= (k0 >= thr) ? (1u << (2 * m)) : 0u; bits |= (k1 >= thr) ? (1u << (2 * m + 1)) : 0u; }
    } else {
        int run = 0; const unsigned long long lt = (1ull << lane) - 1ull;
#pragma unroll 1
        for (int m = 0; m < 16; ++m) {
#pragma unroll
            for (int hf = 0; hf < 2; ++hf) { unsigned k = 0u;
#pragma unroll
                for (int mm = 0; mm < 16; ++mm) if (mm == m) k = hf == 0 ? ((hp[mm] << 16) | (lp[mm] & 0xffffu)) : ((hp[mm] & 0xffff0000u) | (lp[mm] >> 16));
                const unsigned long long eq = __ballot(k == thr);
                const bool tie_sel = (k == thr) && (run + __popcll(eq & lt) < need);
                if (k > thr || tie_sel) bits |= 1u << (2 * m + hf);
                run += __popcll(eq); } }
    }
    maskrow[lane] = bits;
}
__device__ __forceinline__ void topk_select2_pk(const unsigned (&hpa)[16], const unsigned (&lpa)[16], const unsigned (&hpb)[16], const unsigned (&lpb)[16], LAS unsigned* maska, LAS unsigned* maskb, int lane) {
    unsigned ha, hb_; bool exa, exb;
    pk_bisect2<false>(hpa, lpa, hpb, lpb, 0u, 0u, 256, 256, ha, hb_, exa, exb);
    unsigned la = 0u, lb = 0u;
    if (!(exa && exb)) {
        const unsigned hha = ha * 0x10001u, hhb = hb_ * 0x10001u;
        u16x2 ga = (u16x2){0, 0}, gb = (u16x2){0, 0};
#pragma unroll
        for (int m = 0; m < 16; ++m) { ga += pk_ge(hpa[m], hha); gb += pk_ge(hpb[m], hhb); }
        int ra = 256 - wave_total((int)ga.x + (int)ga.y), rb = 256 - wave_total((int)gb.x + (int)gb.y);
        if (ha == 0xffffu) ra = 256; if (hb_ == 0xffffu) rb = 256;
        bool e2a, e2b; unsigned tla, tlb;
        pk_bisect2<true>(hpa, lpa, hpb, lpb, hha, hhb, exa ? 0 : ra, exb ? 0 : rb, tla, tlb, e2a, e2b);
        if (!exa) la = tla; if (!exb) lb = tlb;
    }
    topk_emit_pk(hpa, lpa, (ha << 16) | la, maska, lane);
    topk_emit_pk(hpb, lpb, (hb_ << 16) | lb, maskb, lane);
}
__device__ __forceinline__ int t5_bucket(int d) {
    if (d < 16) return d;
    int bkt = 16;
    bkt += (d >= 19); bkt += (d >= 21); bkt += (d >= 24); bkt += (d >= 27); bkt += (d >= 31); bkt += (d >= 35); bkt += (d >= 40); bkt += (d >= 46);
    bkt += (d >= 52); bkt += (d >= 59); bkt += (d >= 67); bkt += (d >= 77); bkt += (d >= 87); bkt += (d >= 99); bkt += (d >= 113);
    return bkt;
}
constexpr int SC_STRIDE = 2052;
__device__ __forceinline__ void phase_strip(Frame& F, int l) {
    LAS unsigned* SCB = (LAS unsigned*)F.lds;
    LAS unsigned* MSK = (LAS unsigned*)(F.lds + MISC_OFF + 2048);
    LAS float* LUT = (LAS float*)(F.lds + MISC_OFF + 2048 + 4224);
    LAS float* MB = (LAS float*)(F.lds + MISC_OFF + 2048 + 4224 + 3712);
    const bf16_t* qi = (const bf16_t*)(F.ws + WS_QI); const bf16_t* ki = (const bf16_t*)(F.ws + WS_KI); const float* wi = (const float*)(F.ws + WS_WI);
    const bf16_t* qb = (const bf16_t*)(F.ws + WS_QB); const bf16_t* kbp = (const bf16_t*)(F.ws + WS_KB); const bf16_t* vbT = (const bf16_t*)(F.ws + WS_VBT);
    bf16_t* oab = (bf16_t*)(F.ws + WS_OAB);
    const float* relb = F.in(IN_RELB);
    for (int i = F.tid; i < 8 * 114; i += NTHR) { const int h = i / 114, d = i % 114; LUT[i] = relb[t5_bucket(d) * 8 + h] * 1.4426950408889634f; }
    if (F.tid < 8) { const float* qg = F.in(IN_QNG) + l * 64; const float* kg = F.in(IN_KNG) + l * 64; float gq = 0.f, gk = 0.f, bm = -1e30f;
        for (int d = 0; d < 64; ++d) { gq = fmaxf(gq, fabsf(qg[d])); gk = fmaxf(gk, fabsf(kg[d])); }
        for (int k = 0; k < 32; ++k) bm = fmaxf(bm, relb[k * 8 + F.tid]);
        MB[F.tid] = (8.1f * gq * gk + bm) * 1.4426950408889634f; }
    __syncthreads();
    const int w = F.wave;
    for (int vc = F.blk; vc < 256; vc += F.G) {
        const int b = vc & 7, jj = vc >> 3; const size_t rowb = (size_t)b * SEQ;
        for (int it = 0; it < 4; ++it) {
            int lane = F.lane; asm volatile("" : "+v"(lane)); const int q = lane & 15, g = lane >> 4;
            const int si = it == 0 ? jj : (it == 1 ? 63 - jj : (it == 2 ? 64 + jj : 127 - jj)); const int t0 = 16 * si;
            if (si < 16) {
                for (int idx = F.tid; idx < 16 * 64; idx += NTHR) { const int tq = t0 + (idx >> 6), L = idx & 63; unsigned bw = 0u;
#pragma unroll
                    for (int j = 0; j < 4; ++j) bw |= (L + 64 * j <= tq) ? (1u << j) : 0u;
                    MSK[(idx >> 6) * 65 + L] = bw; }
            } else {
                bf16x8 qif[8][2]; float wq[8];
#pragma unroll
                for (int h = 0; h < 8; ++h) { wq[h] = wi[(rowb + t0 + q) * 8 + h];
#pragma unroll
                    for (int ks = 0; ks < 2; ++ks) qif[h][ks] = *(const bf16x8*)(qi + (rowb + t0 + q) * 512 + h * 64 + 32 * ks + 8 * g); }
                const bf16_t* kpb = ki + (rowb + 16 * w + q) * 64 + 8 * g;
                const int ntw = (si - w) / 8 + 1;
                bf16x8 ka0, ka1, kb0, kb1, kc0, kc1;
#define IDX_LOAD(K0, K1, n) do { K0 = *(const bf16x8*)(kpb + (size_t)(128 * (n)) * 64); K1 = *(const bf16x8*)(kpb + (size_t)(128 * (n)) * 64 + 32); } while (0)
#define IDX_TILE(K0, K1, n) do { const bf16x8 kf0 = K0, kf1 = K1; const int kt = w + 8 * (n); if ((n) + 3 < ntw) IDX_LOAD(K0, K1, (n) + 3); \
                    f32x4 sc = (f32x4){0.f, 0.f, 0.f, 0.f}; \
                    _Pragma("unroll") for (int h = 0; h < 8; ++h) { f32x4 d = __builtin_amdgcn_mfma_f32_16x16x32_bf16(kf0, qif[h][0], (f32x4){0.f, 0.f, 0.f, 0.f}, 0, 0, 0); \
                        d = __builtin_amdgcn_mfma_f32_16x16x32_bf16(kf1, qif[h][1], d, 0, 0, 0); \
                        _Pragma("unroll") for (int i = 0; i < 4; ++i) sc[i] += wq[h] * fmaxf(d[i], 0.f); } \
                    u32x4 key; \
                    _Pragma("unroll") for (int i = 0; i < 4; ++i) key[i] = (16 * kt + 4 * g + i <= t0 + q) ? sortable(sc[i] + 0.f) : 0u; \
                    *(LAS u32x4*)(SCB + q * SC_STRIDE + 16 * kt + 4 * g) = key; } while (0)
                IDX_LOAD(ka0, ka1, 0); if (1 < ntw) IDX_LOAD(kb0, kb1, 1); if (2 < ntw) IDX_LOAD(kc0, kc1, 2);
                for (int n = 0; n < ntw; n += 3) { IDX_TILE(ka0, ka1, n); if (n + 1 < ntw) IDX_TILE(kb0, kb1, n + 1); if (n + 2 < ntw) IDX_TILE(kc0, kc1, n + 2); }
#undef IDX_LOAD
#undef IDX_TILE
                __syncthreads();
                const int nk = 16 * (si + 1);
                { unsigned hpa[16], lpa[16], hpb[16], lpb[16]; const int nm = (nk + 127) >> 7;
#pragma unroll
                    for (int m = 0; m < 16; ++m) { hpa[m] = 0u; lpa[m] = 0u; hpb[m] = 0u; lpb[m] = 0u;
                        if (m < nm) { const int s0 = lane + 128 * m, s1 = s0 + 64;
                            const unsigned a0 = (s0 < nk) ? SCB[(2 * w) * SC_STRIDE + s0] : 0u, a1 = (s1 < nk) ? SCB[(2 * w) * SC_STRIDE + s1] : 0u;
                            const unsigned b0 = (s0 < nk) ? SCB[(2 * w + 1) * SC_STRIDE + s0] : 0u, b1 = (s1 < nk) ? SCB[(2 * w + 1) * SC_STRIDE + s1] : 0u;
                            hpa[m] = (a0 >> 16) | (a1 & 0xffff0000u); lpa[m] = (a0 & 0xffffu) | (a1 << 16);
                            hpb[m] = (b0 >> 16) | (b1 & 0xffff0000u); lpb[m] = (b0 & 0xffffu) | (b1 << 16); } }
                    topk_select2_pk(hpa, lpa, hpb, lpb, MSK + (2 * w) * 65, MSK + (2 * w + 1) * 65, lane); }
            }
            __syncthreads();
            {
                const int h = w, t = t0 + q;
                bf16x8 qf[2];
#pragma unroll
                for (int ks = 0; ks < 2; ++ks) qf[ks] = *(const bf16x8*)(qb + (rowb + t) * 512 + h * 64 + 32 * ks + 8 * g);
                f32x4 o[4];
#pragma unroll
                for (int dt = 0; dt < 4; ++dt) o[dt] = (f32x4){0.f, 0.f, 0.f, 0.f};
                float l = 0.f;
                const float mb = MB[h], cfar = LUT[h * 114 + 113] - mb;
                unsigned mwr[2][8];
#pragma unroll
                for (int p = 0; p < 2; ++p)
#pragma unroll
                    for (int e = 0; e < 8; ++e) mwr[p][e] = MSK[q * 65 + 32 * p + 8 * g + e];
                const int nch = (t0 + 15) / 32 + 1, nst = (t0 + 15) / 128 + 1;
                constexpr int STG = 35840, VOFF = 18432;
                const bf16_t* gk0 = kbp + (rowb + (F.tid >> 3)) * 64 + 8 * (F.tid & 7);
                const bf16_t* gv0 = vbT + (size_t)(F.tid >> 4) * T + rowb + 8 * (F.tid & 15);
                const int dk0 = (F.tid >> 3) * 144 + (F.tid & 7) * 16, dv0 = VOFF + (F.tid >> 4) * 272 + (F.tid & 15) * 16;
                u32x4 ra[4];
#define DSA_LOAD(R, st) do { R[0] = *(const u32x4*)(gk0 + (size_t)(128 * (st)) * 64); R[1] = *(const u32x4*)(gk0 + (size_t)(128 * (st) + 64) * 64); \
                    R[2] = *(const u32x4*)(gv0 + 128 * (st)); R[3] = *(const u32x4*)(gv0 + (size_t)32 * T + 128 * (st)); } while (0)
#define DSA_PUT(R, st) do { LAS unsigned char* sp_ = F.lds + ((st) % 3) * STG; *(LAS u32x4*)(sp_ + dk0) = R[0]; *(LAS u32x4*)(sp_ + dk0 + 64 * 144) = R[1]; \
                    *(LAS u32x4*)(sp_ + dv0) = R[2]; *(LAS u32x4*)(sp_ + dv0 + 32 * 272) = R[3]; } while (0)
                DSA_LOAD(ra, 0); DSA_PUT(ra, 0); if (nst > 1) DSA_LOAD(ra, 1);
                asm volatile("s_waitcnt lgkmcnt(0)" ::: "memory"); __builtin_amdgcn_s_barrier(); asm volatile("" ::: "memory");
#define DSA_STAGE(st, RN) do { \
                    if ((st) + 1 < nst) { DSA_PUT(RN, (st) + 1); if ((st) + 2 < nst) DSA_LOAD(RN, (st) + 2); } \
                    const LAS unsigned char* stg = F.lds + ((st) % 3) * STG; \
                    _Pragma("unroll") for (int cc = 0; cc < 4; ++cc) { const int c = 4 * (st) + cc; if (c < nch) { \
                        bf16x8 kf[2][2], vf[4];                                    \
                        _Pragma("unroll") for (int tl = 0; tl < 2; ++tl) _Pragma("unroll") for (int ks = 0; ks < 2; ++ks) kf[tl][ks] = *(const LAS bf16x8*)(stg + (32 * cc + 8 * (q >> 2) + 4 * tl + (q & 3)) * 144 + 16 * g + 64 * ks); \
                        _Pragma("unroll") for (int dt = 0; dt < 4; ++dt) vf[dt] = *(const LAS bf16x8*)(stg + VOFF + (16 * dt + q) * 272 + 64 * cc + 16 * g); \
                        const bool farc = (t0 - (32 * c + 31)) >= 113; \
                        const float ci = farc ? cfar : -mb; \
                        f32x4 s0 = __builtin_amdgcn_mfma_f32_16x16x32_bf16(kf[0][0], qf[0], (f32x4){ci, ci, ci, ci}, 0, 0, 0); \
                        s0 = __builtin_amdgcn_mfma_f32_16x16x32_bf16(kf[0][1], qf[1], s0, 0, 0, 0); \
                        f32x4 s1 = __builtin_amdgcn_mfma_f32_16x16x32_bf16(kf[1][0], qf[0], (f32x4){ci, ci, ci, ci}, 0, 0, 0); \
                        s1 = __builtin_amdgcn_mfma_f32_16x16x32_bf16(kf[1][1], qf[1], s1, 0, 0, 0); \
                        if (!farc) { \
                            _Pragma("unroll") for (int i = 0; i < 4; ++i) { const int k0 = 32 * c + 8 * g + i, k1 = k0 + 4; \
                                int d0 = t - k0, d1 = t - k1; d0 = d0 < 0 ? 0 : (d0 > 113 ? 113 : d0); d1 = d1 < 0 ? 0 : (d1 > 113 ? 113 : d1); \
                                s0[i] += LUT[h * 114 + d0]; s1[i] += LUT[h * 114 + d1]; } } \
                        float p[8]; \
                        _Pragma("unroll") for (int i = 0; i < 4; ++i) { \
                            p[i] = __builtin_bit_cast(float, __builtin_bit_cast(unsigned, __builtin_amdgcn_exp2f(s0[i])) & (unsigned)__builtin_amdgcn_sbfe((int)mwr[cc & 1][i], (unsigned)(c >> 1), 1u)); \
                            p[4 + i] = __builtin_bit_cast(float, __builtin_bit_cast(unsigned, __builtin_amdgcn_exp2f(s1[i])) & (unsigned)__builtin_amdgcn_sbfe((int)mwr[cc & 1][4 + i], (unsigned)(c >> 1), 1u)); } \
                        l += ((p[0] + p[1]) + (p[2] + p[3])) + ((p[4] + p[5]) + (p[6] + p[7])); \
                        const bf16x8 pf = pack_bf16x8(p[0], p[1], p[2], p[3], p[4], p[5], p[6], p[7]); \
                        _Pragma("unroll") for (int dt = 0; dt < 4; ++dt) o[dt] = __builtin_amdgcn_mfma_f32_16x16x32_bf16(vf[dt], pf, o[dt], 0, 0, 0); } __builtin_amdgcn_sched_barrier(0); } \
                    asm volatile("s_waitcnt lgkmcnt(0)" ::: "memory"); __builtin_amdgcn_s_barrier(); asm volatile("" ::: "memory"); } while (0)
                for (int st = 0; st < nst; ++st) { DSA_STAGE(st, ra); }
#undef DSA_STAGE
#undef DSA_LOAD
#undef DSA_PUT
                l += __shfl_xor(l, 16); l += __shfl_xor(l, 32);
                const float il = 1.f / l;
                bf16_t* op = oab + (rowb + t) * 1024 + 512 + h * 64 + 4 * g;
#pragma unroll
                for (int dt = 0; dt < 4; ++dt) { u32x2 wv; wv.x = cvt_pk_bf16(o[dt][0] * il, o[dt][1] * il); wv.y = cvt_pk_bf16(o[dt][2] * il, o[dt][3] * il); *(u32x2*)(op + 16 * dt) = wv; }
            }
            __syncthreads();
        }
    }
}

__device__ __forceinline__ void phase_h2_route(Frame& F, int l) {
    LAS float* Av = (LAS float*)F.lds; LAS float* Sv = Av + DM;
    LAS float* RW = (LAS float*)(F.lds + 8192);
    LAS float* RB = (LAS float*)(F.lds + 73728);
    LAS int* lcnt = (LAS int*)(F.lds + 73728 + 64);
    LAS int* lbase = (LAS int*)(F.lds + 73728 + 128);
    LAS int* rinfo = (LAS int*)(F.lds + 73728 + 256);
    const float* mod = (const float*)(F.ws + WS_MOD) + (size_t)l * BATCH * NMOD;
    const int rows_per_blk = T / F.G, row_base = F.blk * rows_per_blk, b = row_base / SEQ;
    const float* n2g = F.in(IN_N2G); const float* rwp = F.in(IN_RW); const float* rbp = F.in(IN_RB);
    for (int d = F.tid; d < DM; d += NTHR) { Av[d] = n2g[l * DM + d] * (1.f + mod[(size_t)b * NMOD + 4 * DM + d]); Sv[d] = mod[(size_t)b * NMOD + 3 * DM + d]; }
    for (int i = F.tid; i < DM * NE; i += NTHR) RW[(i & 15) * DM + (i >> 4)] = rwp[i];
    if (F.tid < NE) { RB[F.tid] = rbp[F.tid]; lcnt[F.tid] = 0; }
    __syncthreads();
    bf16_t* hb = (bf16_t*)(F.ws + WS_H);
    const int rows_per_wave = rows_per_blk / NWAVES;
    for (int i0 = 0; i0 < rows_per_wave; i0 += 2) {
      f32x4 vin[2][4];
#pragma unroll
      for (int r = 0; r < 2; ++r)
#pragma unroll
          for (int j = 0; j < 4; ++j) vin[r][j] = *(const f32x4*)(F.out + (size_t)(row_base + F.wave * rows_per_wave + i0 + r) * DM + 4 * F.lane + 256 * j);
#pragma unroll 1
      for (int rr = 0; rr < 2; ++rr) {
        const int lr = F.wave * rows_per_wave + i0 + rr, row = row_base + lr;
        f32x4 v[4]; float ss = 0.f;
#pragma unroll
        for (int j = 0; j < 4; ++j) { v[j] = rr == 0 ? vin[0][j] : vin[1][j]; ss += (v[j][0] * v[j][0] + v[j][1] * v[j][1]) + (v[j][2] * v[j][2] + v[j][3] * v[j][3]); }
        const float r = 1.0f / sqrtf(wave_sum(ss) * (1.0f / DM) + EPS);
        float lg[NE];
#pragma unroll
        for (int e = 0; e < NE; ++e) lg[e] = 0.f;
#pragma unroll
        for (int j = 0; j < 4; ++j) { const int c0 = 4 * F.lane + 256 * j; u32x2 w;
#pragma unroll
            for (int k = 0; k < 4; ++k) v[j][k] = v[j][k] * r * Av[c0 + k] + Sv[c0 + k];
#pragma unroll
            for (int e = 0; e < NE; ++e) { const f32x4 rw = *(const LAS f32x4*)(RW + e * DM + c0);
                lg[e] += (v[j][0] * rw[0] + v[j][1] * rw[1]) + (v[j][2] * rw[2] + v[j][3] * rw[3]); }
            w.x = pk2(v[j][0], v[j][1]); w.y = pk2(v[j][2], v[j][3]);
            *(u32x2*)(hb + (size_t)row * DM + c0) = w; }
        float mxl = -1e30f;
#pragma unroll
        for (int e = 0; e < NE; ++e) { lg[e] = wave_sum(lg[e]) + RB[e]; mxl = fmaxf(mxl, lg[e]); }
        float pr[NE], den = 0.f;
#pragma unroll
        for (int e = 0; e < NE; ++e) { pr[e] = expf(lg[e] - mxl); den += pr[e]; }
        const float iden = 1.f / den;
#pragma unroll
        for (int e = 0; e < NE; ++e) pr[e] *= iden;
        int bg = 0; float bs = -1.f, bv0 = 0.f, bv1 = 0.f; int bi0 = 0, bi1 = 1;
#pragma unroll
        for (int g = 0; g < 4; ++g) {
            float v0 = pr[4 * g], v1 = -1.f; int i0 = 0, i1 = -1;
#pragma unroll
            for (int k = 1; k < 4; ++k) { const float p = pr[4 * g + k];
                if (p > v0) { v1 = v0; i1 = i0; v0 = p; i0 = k; } else if (p > v1) { v1 = p; i1 = k; } }
            const float gs = v0 + v1;
            if (gs > bs) { bs = gs; bg = g; bv0 = v0; bv1 = v1; bi0 = i0; bi1 = i1; }
        }
        const int e0 = bg * 4 + bi0, e1 = bg * 4 + bi1; const float wsum = bv0 + bv1, w0 = bv0 / wsum, w1 = bv1 / wsum;
        if (F.lane == 0) { const int p0 = __hip_atomic_fetch_add(lcnt + e0, 1, __ATOMIC_RELAXED, __HIP_MEMORY_SCOPE_WORKGROUP), p1 = __hip_atomic_fetch_add(lcnt + e1, 1, __ATOMIC_RELAXED, __HIP_MEMORY_SCOPE_WORKGROUP);
            rinfo[lr * 6 + 0] = e0; rinfo[lr * 6 + 1] = p0; rinfo[lr * 6 + 2] = __float_as_int(w0); rinfo[lr * 6 + 3] = e1; rinfo[lr * 6 + 4] = p1; rinfo[lr * 6 + 5] = __float_as_int(w1); }
      }
    }
    __syncthreads();
    unsigned* gcnt = F.ctl + CW_GCNT + 64 * l;
    if (F.tid < NE) lbase[F.tid] = (int)__hip_atomic_fetch_add(gcnt + F.tid, (unsigned)lcnt[F.tid], RLX_AGENT);
    __syncthreads();
    int* etok = (int*)(F.ws + WS_ETOK); float* ew = (float*)(F.ws + WS_EW); int* edst = (int*)(F.ws + WS_EDST);
    if (F.tid < 2 * rows_per_blk) { const int lr = F.tid >> 1, k = F.tid & 1; const int e = rinfo[lr * 6 + 3 * k], p = rinfo[lr * 6 + 3 * k + 1]; const float w = __int_as_float(rinfo[lr * 6 + 3 * k + 2]);
        const int slot = lbase[e] + p, tok = row_base + lr;
        etok[e * T + slot] = tok; ew[e * T + slot] = w; edst[e * T + slot] = 2 * tok + k; }
}

__device__ __forceinline__ int moe_table(Frame& F, int l, LAS int* tile_end) {
    if (F.tid < 64) { const int e = F.lane & 15; const int n = (int)__hip_atomic_load(F.ctl + CW_GCNT + 64 * l + e, RLX_AGENT); int tiles = (n + 255) >> 8, cum = tiles;
#pragma unroll
        for (int o = 1; o < 16; o <<= 1) { const int v = __shfl_up(cum, o, 16); if (e >= o) cum += v; }
        if (F.lane < 16) { tile_end[e] = cum; tile_end[16 + e] = n; } }
    __syncthreads();
    return tile_end[15];
}
#define XB_TMO      128
#define XB_XCNT(j)  (256  + 64 * (j))
#define XB_XSUB(j)  (1280 + 64 * (j))
#define XB_XGEN(j)  (2304 + 64 * (j))
#define XB_TOP      3328
#define XB_TOPGEN   3392
#define XCD_BAR_WORDS 3456
#define XB_SPIN_CAP (1u << 20)
__device__ __forceinline__ unsigned xb_ld(unsigned* p)              { return __hip_atomic_load(p, __ATOMIC_RELAXED, __HIP_MEMORY_SCOPE_AGENT); }
__device__ __forceinline__ unsigned xb_add(unsigned* p, unsigned v) { return __hip_atomic_fetch_add(p, v, __ATOMIC_RELAXED, __HIP_MEMORY_SCOPE_AGENT); }
__device__ __forceinline__ unsigned xb_xcc_id() { return (unsigned)__builtin_amdgcn_s_getreg((3 << 11) | 20) & 0xFu; }
#define XB_SPIN(cond, bar) do { unsigned _sp = 0; while (cond) { __builtin_amdgcn_s_sleep(1); \
    if ((++_sp & 255u) == 0u) { if (xb_ld(&(bar)[XB_TMO])) break; if (_sp > XB_SPIN_CAP) { atomicAdd(&(bar)[XB_TMO], 1u); break; } } } } while (0)
struct XcdBarrier { unsigned* bar; unsigned x; volatile LAS unsigned* st; };
__device__ __forceinline__ XcdBarrier xcd_barrier_post(unsigned* bar, volatile LAS unsigned* st) {
    XcdBarrier b; b.bar = bar; b.x = xb_xcc_id(); b.st = st;
    if (threadIdx.x == 0) (void)xb_add(&bar[XB_XCNT(b.x)], 1u);
    return b;
}
__device__ __forceinline__ void xcd_barrier_complete(unsigned* bar, unsigned x, unsigned& nloc, unsigned& nx) {
    const unsigned G = gridDim.x * gridDim.y * gridDim.z;
    unsigned sum, cnt, mine, sp = 0u;
    for (;;) {
        sum = 0u; cnt = 0u; mine = 0u;
#pragma unroll
        for (unsigned j = 0; j < 16; ++j) { const unsigned c = xb_ld(&bar[XB_XCNT(j)]); sum += c; cnt += (c > 0u) ? 1u : 0u; mine = (j == x) ? c : mine; }
        if (sum == G) break;
        __builtin_amdgcn_s_sleep(1);
        if ((++sp & 255u) == 0u) { if (xb_ld(&bar[XB_TMO])) break; if (sp > XB_SPIN_CAP) { atomicAdd(&bar[XB_TMO], 1u); break; } }
    }
    nloc = mine > 0u ? mine : 1u; nx = cnt > 0u ? cnt : 1u;
}
__device__ __forceinline__ void xcd_barrier(const XcdBarrier& b) {
    asm volatile("s_waitcnt vmcnt(0)" ::: "memory");
    __syncthreads();
    if (threadIdx.x == 0) {
        unsigned* bar = b.bar;
        __builtin_amdgcn_s_waitcnt(0);
        unsigned nloc = b.st[0], nx = b.st[1];
        if (nloc == 0u) { xcd_barrier_complete(bar, b.x, nloc, nx); b.st[0] = nloc; b.st[1] = nx; }
        const unsigned old = xb_add(&bar[XB_XSUB(b.x)], 1u);
        const unsigned gen = old / nloc;
        if (old + 1u == (gen + 1u) * nloc) {
            __builtin_amdgcn_fence(__ATOMIC_RELEASE, "agent");
            asm volatile("s_waitcnt vmcnt(0)" ::: "memory");
            const unsigned og = xb_add(&bar[XB_TOP], 1u);
            const unsigned tg = og / nx;
            if (og + 1u == (tg + 1u) * nx) xb_add(&bar[XB_TOPGEN], 1u);
            else XB_SPIN(xb_ld(&bar[XB_TOPGEN]) == tg, bar);
            __builtin_amdgcn_fence(__ATOMIC_ACQUIRE, "agent");
            xb_add(&bar[XB_XGEN(b.x)], 1u);
            asm volatile("s_waitcnt vmcnt(0)" ::: "memory");
        } else {
            XB_SPIN(xb_ld(&bar[XB_XGEN(b.x)]) == gen, bar);
            __builtin_amdgcn_fence(__ATOMIC_ACQUIRE, "agent");
            asm volatile("s_waitcnt vmcnt(0)" ::: "memory");
        }
    }
    __syncthreads();
}

constexpr int PH_PER_LAYER = 8, PH_FINAL = 1 + PH_PER_LAYER * DEPTH, N_PHASES = PH_FINAL + 1;
__global__ void __launch_bounds__(NTHR, 2) fwd_kernel(Args args) {
    extern __shared__ __attribute__((aligned(16))) unsigned char lds_raw[];
    Frame F;
    F.lds = (LAS unsigned char*)lds_raw;
    F.tid = threadIdx.x; F.lane = F.tid & 63; F.wave = __builtin_amdgcn_readfirstlane(F.tid >> 6); F.G = gridDim.x; F.blk = blockIdx.x;
    F.out = args.out; F.ws = args.ws; F.ctl = (unsigned*)(args.ws + WS_CTL);
    volatile LAS unsigned* MISC = (volatile LAS unsigned*)(F.lds + MISC_OFF);
    for (int u = F.tid; u < (LDS_BYTES - MISC_OFF) / 4; u += NTHR) ((LAS unsigned*)(F.lds + MISC_OFF))[u] = 0u;
    __syncthreads();
    if (F.tid < 36) ((LAS unsigned*)(F.lds + MISC_OFF + 1024))[F.tid] = ((const unsigned*)__builtin_amdgcn_kernarg_segment_ptr())[F.tid];
    __syncthreads();
    const int lo = args.ph_lo, hi = args.ph_hi;
    XcdBarrier bar; bar.bar = F.ctl + CW_BAR; bar.x = 0; bar.st = nullptr;
    if (hi - lo > 1) bar = xcd_barrier_post(F.ctl + CW_BAR, MISC + 8);
#define SEAM(k) do { if ((k) + 1 < hi) xcd_barrier(bar); } while (0)
    for (int ph = lo; ph < hi; ++ph) {
        { int t_ = threadIdx.x; asm volatile("" : "+v"(t_)); F.tid = t_; F.lane = t_ & 63; F.wave = __builtin_amdgcn_readfirstlane(t_ >> 6);
          unsigned char* w_ = args.ws; asm volatile("" : "+s"(w_)); F.ws = w_; F.ctl = (unsigned*)(w_ + WS_CTL); float* o_ = args.out; asm volatile("" : "+s"(o_)); F.out = o_; }
        if (ph == 0) { phase_prologue(F); }
        else if (ph == PH_FINAL) { phase_rows(F, DEPTH, 2); }
        else {
            const int l = (ph - 1) / PH_PER_LAYER, s = (ph - 1) % PH_PER_LAYER;
            bf16_t* hb = (bf16_t*)(F.ws + WS_H);
            if (s == 0) { phase_rows(F, l, l == 0 ? 0 : 1); }
            else if (s == 1) {
                { pg8::Gemm g{hb, (const bf16_t*)(F.ws + WS_WIN + l * WIN_LAYER), nullptr}; pg8::StaticOrder S; S.init(T, NMAIN, F.G, F.blk);
                  EpiIn E{F.ws, F.in(IN_QNG) + l * 64, F.in(IN_KNG) + l * 64};
                  pg8::gemm_phase<1024, 1024, 1024, EpiIn, pg8::StaticOrder, true>(F.lds, g, S, E, F.tid); }
                { pg8::Gemm g{(const bf16_t*)(F.ws + WS_WIN + l * WIN_LAYER) + (size_t)NMAIN * 1024, hb, nullptr}; pg8::StaticOrder S; S.init(512, T, F.G, (F.blk + F.G / 2) % F.G);
                  EpiPlain E{(bf16_t*)(F.ws + WS_VAT), T};
                  pg8::gemm_phase<1024, 1024, 1024, EpiPlain, pg8::StaticOrder, true>(F.lds, g, S, E, F.tid); }
            }
            else if (s == 2) { phase_strip(F, l); phase_sb(F); }
            else if (s == 3) {
                pg8::Gemm g{(const bf16_t*)(F.ws + WS_OAB), (const bf16_t*)(F.ws + WS_WO) + (size_t)l * 1024 * 1024, nullptr}; pg8::StaticOrder S; S.init(T, 1024, F.G, F.blk);
                EpiMerge E{(bf16_t*)(F.ws + WS_MERGED), (const bf16_t*)(F.ws + WS_SGA), (const bf16_t*)(F.ws + WS_SGB)};
                pg8::gemm_phase<1024, 1024, 1024, EpiMerge, pg8::StaticOrder, true, false, true>(F.lds, g, S, E, F.tid);
            }
            else if (s == 4) {
                pg8::Gemm g{(const bf16_t*)(F.ws + WS_MERGED), (const bf16_t*)(F.ws + WS_WOUT) + (size_t)l * 1024 * 1024, nullptr}; pg8::StaticOrder S; S.init(T, 1024, F.G, F.blk);
                EpiOut E{l == 0 ? F.in(IN_X) : F.out, F.out, (const float*)(F.ws + WS_MOD) + (size_t)l * BATCH * NMOD + 2 * DM};
                pg8::gemm_phase<1024, 1024, 1024, EpiOut, pg8::StaticOrder, true>(F.lds, g, S, E, F.tid);
            }
            else if (s == 5) { phase_h2_route(F, l); }
            else if (s == 6 || s == 7) {
                LAS int* tile_end = (LAS int*)(F.lds + MISC_OFF + 512);
                const int ntiles = moe_table(F, l, tile_end);
                MoeOrder S{tile_end, ntiles, F.G, F.blk};
                if (s == 6) { pg8::Gemm g{(const bf16_t*)(F.ws + WS_H), (const bf16_t*)(F.ws + WS_WGU), (const int*)(F.ws + WS_ETOK)};
                    EpiMoe1 E{(bf16_t*)(F.ws + WS_HID), (const float*)(F.ws + WS_EW)};
                    pg8::gemm_phase<1024, 1024, 1024, EpiMoe1, MoeOrder, true, true>(F.lds, g, S, E, F.tid); }
                else { pg8::Gemm g{(const bf16_t*)(F.ws + WS_HID), (const bf16_t*)(F.ws + WS_WD), nullptr};
                    EpiMoe2 E{(bf16_t*)(F.ws + WS_Y), (const int*)(F.ws + WS_EDST)};
                    pg8::gemm_phase<512, 512, 512, EpiMoe2, MoeOrder, true>(F.lds, g, S, E, F.tid); }
            }
        }
        __syncthreads();
        SEAM(ph);
    }
#undef SEAM
}

extern "C" void kernel_launch(void* const* d_in, const int* in_sizes, int n_in, void* d_out, int out_size, void* d_ws, size_t ws_size, hipStream_t stream) {
    static int grid = 0;
    if (grid == 0) {
        if (n_in != 18 || out_size != T * DM || ws_size < WS_END) { fprintf(stderr, "kernel_launch: unexpected problem (n_in %d, out %d, ws %zu)\n", n_in, out_size, ws_size); grid = -1; return; }
        int dev = 0, cus = 0;
        if (hipGetDevice(&dev) != hipSuccess || hipDeviceGetAttribute(&cus, hipDeviceAttributeMultiprocessorCount, dev) != hipSuccess) { grid = -1; return; }
        if (hipFuncSetAttribute((const void*)fwd_kernel, hipFuncAttributeMaxDynamicSharedMemorySize, LDS_BYTES) != hipSuccess) { fprintf(stderr, "kernel_launch: hipFuncSetAttribute failed\n"); grid = -1; return; }
        (void)hipGetLastError();
        grid = cus;
        if (grid != 256) fprintf(stderr, "kernel_launch: %d CUs (built for 256)\n", grid);
    }
    if (grid < 0) return;
    (void)hipMemsetAsync((char*)d_ws + WS_CTL, 0, CTL_ZERO_BYTES, stream);
    Args a{};
    for (int i = 0; i < 18; ++i) a.in[i] = (const float*)d_in[i];
    a.out = (float*)d_out; a.ws = (unsigned char*)d_ws;
#if ONE_LAUNCH
    a.ph_lo = 0; a.ph_hi = N_PHASES;
    hipLaunchKernelGGL(fwd_kernel, dim3(grid), dim3(NTHR), LDS_BYTES, stream, a);
#else
    for (int ph = 0; ph < N_PHASES; ++ph) {
        const int s = ph == 0 || ph == PH_FINAL ? -1 : (ph - 1) % PH_PER_LAYER;
        (void)s;
        a.ph_lo = ph; a.ph_hi = ph + 1;
        hipLaunchKernelGGL(fwd_kernel, dim3(grid), dim3(NTHR), LDS_BYTES, stream, a);
    }
#endif
}
```

```cpp
#include <hip/hip_runtime.h>
#include <cstdio>
#include <cstdint>

#define LAS __attribute__((address_space(3)))
#define GAS __attribute__((address_space(1)))
typedef unsigned short bf16_t;
typedef short bf16x8 __attribute__((ext_vector_type(8)));
typedef float f32x4 __attribute__((ext_vector_type(4)));
typedef float f32x2 __attribute__((ext_vector_type(2)));
typedef unsigned u32x4 __attribute__((ext_vector_type(4)));
typedef unsigned u32x2 __attribute__((ext_vector_type(2)));

constexpr int BATCH = 8, SEQ = 2048, DM = 1024, T = BATCH * SEQ, DEPTH = 2;
constexpr int NIN = 4808, NMOD = 6 * DM;
constexpr int NE = 16, DEXP = 512;
constexpr int NMAIN = 4352;
constexpr int PMAX = 36864;
constexpr float EPS = 1e-6f;
constexpr int NWAVES = 8, NTHR = 512;

#ifndef ONE_LAUNCH
#define ONE_LAUNCH 1
#endif

constexpr size_t MiB = 1u << 20;
constexpr size_t WS_CTL = 0, CTL_ZERO_BYTES = 1 * MiB;
constexpr size_t WS_MOD = 1 * MiB;
constexpr size_t WS_MODP = 2 * MiB;
constexpr size_t WS_ETOK = 8 * MiB, WS_EW = 9 * MiB, WS_EDST = 10 * MiB;
constexpr size_t WS_SLOTW = 11 * MiB, WS_SLOTD = 11 * MiB + 256 * 1024;
constexpr size_t WS_MASK = 12 * MiB;
constexpr size_t WS_WIN = 16 * MiB;
constexpr size_t WIN_LAYER = (size_t)4864 * 1024 * 2;
constexpr size_t WS_WO = 35 * MiB, WS_WOUT = 39 * MiB;
constexpr size_t WS_WGU = 43 * MiB;
constexpr size_t WS_WD = 75 * MiB;
constexpr size_t WS_H = 92 * MiB;
constexpr size_t WS_QA = 124 * MiB, WS_KA = 140 * MiB, WS_VAT = 156 * MiB, WS_QB = 172 * MiB, WS_QI = 188 * MiB;
constexpr size_t WS_KB = 204 * MiB, WS_VBT = 206 * MiB, WS_KI = 208 * MiB, WS_WI = 210 * MiB;
constexpr size_t WS_SGA = 212 * MiB, WS_SGB = 244 * MiB, WS_OAB = 276 * MiB;
constexpr size_t WS_MERGED = 124 * MiB;
constexpr size_t WS_TMP = 156 * MiB;
constexpr size_t WS_XG = 124 * MiB;
constexpr size_t WS_HID = 196 * MiB;
constexpr size_t WS_Y = 232 * MiB;
constexpr size_t WS_END = 308 * MiB;
constexpr int CW_GCNT = 64;
constexpr int CW_BAR = 4096;

#define LDS_WAIT() asm volatile("s_waitcnt lgkmcnt(0)" ::: "memory")
#define VM_WAIT() asm volatile("s_waitcnt vmcnt(0)" ::: "memory")
#define RLX_AGENT __ATOMIC_RELAXED, __HIP_MEMORY_SCOPE_AGENT
__device__ __forceinline__ unsigned f2bf(float f) { unsigned u = __builtin_bit_cast(unsigned, f); return (u + 0x7fffu + ((u >> 16) & 1u)) >> 16; }
__device__ __forceinline__ unsigned pk2(float lo, float hi) { return f2bf(lo) | (f2bf(hi) << 16); }
__device__ __forceinline__ float bflo(unsigned w) { return __builtin_bit_cast(float, w << 16); }
__device__ __forceinline__ float bfhi(unsigned w) { return __builtin_bit_cast(float, w & 0xffff0000u); }
__device__ __forceinline__ float bf2f(bf16_t h) { return __builtin_bit_cast(float, (unsigned)h << 16); }
__device__ __forceinline__ unsigned cvt_pk_bf16(float lo, float hi) { unsigned r; asm volatile("v_cvt_pk_bf16_f32 %0, %1, %2" : "=v"(r) : "v"(lo), "v"(hi)); return r; }
__device__ __forceinline__ u32x4 pack8(f32x4 a, f32x4 b) { u32x4 w; w.x = cvt_pk_bf16(a[0], a[1]); w.y = cvt_pk_bf16(a[2], a[3]); w.z = cvt_pk_bf16(b[0], b[1]); w.w = cvt_pk_bf16(b[2], b[3]); return w; }
__device__ __forceinline__ float sigmoidf_(float x) { return 1.f / (1.f + __expf(-x)); }
__device__ __forceinline__ float wave_sum(float v) {
    v += __builtin_bit_cast(float, __builtin_amdgcn_update_dpp(0, __builtin_bit_cast(int, v), 0xB1, 0xf, 0xf, true));
    v += __builtin_bit_cast(float, __builtin_amdgcn_update_dpp(0, __builtin_bit_cast(int, v), 0x4E, 0xf, 0xf, true));
    v += __builtin_bit_cast(float, __builtin_amdgcn_update_dpp(0, __builtin_bit_cast(int, v), 0x141, 0xf, 0xf, true));
    v += __builtin_bit_cast(float, __builtin_amdgcn_update_dpp(0, __builtin_bit_cast(int, v), 0x140, 0xf, 0xf, true));
    const float a = __builtin_bit_cast(float, __builtin_amdgcn_readlane(__builtin_bit_cast(int, v), 0)), b = __builtin_bit_cast(float, __builtin_amdgcn_readlane(__builtin_bit_cast(int, v), 16));
    const float c = __builtin_bit_cast(float, __builtin_amdgcn_readlane(__builtin_bit_cast(int, v), 32)), d = __builtin_bit_cast(float, __builtin_amdgcn_readlane(__builtin_bit_cast(int, v), 48));
    return (a + b) + (c + d);
}

namespace pg8 {
constexpr int BM = 256, BK = 64, HALF = 128, HTB = HALF * BK * 2, STAGE_BYTES = 8 * HTB, NXCD = 8, WGM = 8;
__host__ __device__ __forceinline__ int lds_byte(int r, int c) { const int st = (r >> 4) * 2 + (c >> 5), rr = r & 15, cc = c & 31, ob = rr * 64 + cc * 2; return st * 1024 + (ob ^ (((ob >> 9) & 1) << 5)); }
__host__ __device__ __forceinline__ void stage_rc(int b, int& R, int& C) { const int st = b / 1024, sb = b % 1024, swz = sb ^ (((sb >> 9) & 1) << 5); R = (st >> 1) * 16 + swz / 64; C = (st & 1) * 32 + (swz % 64) / 2; }
__host__ __device__ __forceinline__ int perm32(int rho) { const int n = rho >> 4, i = rho & 15; return 8 * (i >> 2) + 4 * n + (i & 3); }

struct Unit { int pm, pn, aux, nv; };
struct Gemm { const bf16_t* A; const bf16_t* Bt; const int* rowidx; };

struct StaticOrder {
    int nM, nN, nwg, G, c;
    __host__ __device__ void init(int M, int N, int G_, int c_) { nM = M / BM; nN = N / BM; nwg = nM * nN; G = G_; c = c_; }
    __host__ __device__ bool next(int i, Unit& u) const {
        const long L = (long)i * G + c; if (L >= nwg) return false;
        int wgid = (int)L; { const int q = nwg / NXCD, r = nwg % NXCD, xcd = wgid % NXCD, off = wgid / NXCD; wgid = (xcd < r ? xcd * (q + 1) : r * (q + 1) + (xcd - r) * q) + off; }
        const int nig = WGM * nN, gid = wgid / nig, fm = gid * WGM, gsz = (nM - fm) < WGM ? (nM - fm) : WGM;
        u.pm = fm + ((wgid % nig) % gsz); u.pn = (wgid % nig) / gsz; return true;
    }
    __device__ __forceinline__ void a_ready(const Unit&) const {}
    __device__ __forceinline__ void done(const Unit&) const {}
};

template <int LDA, int LDB, int KK, class Epi, class Sched, bool ALIGN_EPI, bool GATHER = false, bool MIDHOOK = false>
__device__ __forceinline__ void gemm_phase(LAS unsigned char* lds, const Gemm g, const Sched& S, const Epi& E, int tid) {
    asm volatile("" : "+v"(tid));
    const int wid = __builtin_amdgcn_readfirstlane(tid >> 6), lane = tid & 63, wr = wid >> 2, wc = wid & 3, fr = lane & 15, fq = lane >> 4;
    constexpr int nt = KK / BK;
    unsigned voffA[2], voffB[2];
#pragma unroll
    for (int i = 0; i < 2; ++i) { int R, C; stage_rc(tid * 16 + i * 8192, R, C); const int Rb = Epi::PERM ? ((R & ~31) + perm32(R & 31)) : R;
        voffA[i] = (unsigned)(R * LDA + C) * 2u; voffB[i] = (unsigned)(Rb * LDB + C) * 2u; }
    constexpr size_t kstep = (size_t)(BK * 2);
    constexpr size_t hstepA = (size_t)HALF * LDA * 2, hstepB = (size_t)HALF * LDB * 2;
    constexpr size_t tstepA = 2 * hstepA, tstepB = 2 * hstepB;
    const unsigned ldsw = (unsigned)wid * 1024u;
    const int aoff = lds_byte(wr * 64 + fr, fq * 8), boff = lds_byte(wc * 32 + fr, fq * 8);
#define PG8_SA(b, h) (((b) * 2 + (h)) * HTB)
#define PG8_SB(b, h) ((4 + (b) * 2 + (h)) * HTB)
#define PG8_STAGE(bufoff, gbase, voff) do { _Pragma("unroll") for (int _i = 0; _i < 2; ++_i) \
        __builtin_amdgcn_global_load_lds((const unsigned*)((const char*)(gbase) + (voff)[_i]), (LAS unsigned*)(lds + (bufoff) + ldsw + _i * 8192), 16, 0, 0); } while (0)
    unsigned gaC[2][2], gaN[2][2];
#define PG8_SETGA(ga, u) do { if constexpr (GATHER) { _Pragma("unroll") for (int h_ = 0; h_ < 2; ++h_) _Pragma("unroll") for (int i_ = 0; i_ < 2; ++i_) { int R_, C_; stage_rc(tid * 16 + i_ * 8192, R_, C_); \
        const int idx_ = h_ * HALF + R_; const int tok_ = idx_ < (u).nv ? g.rowidx[(u).aux + idx_] : 0; ga[h_][i_] = (unsigned)tok_ * (unsigned)(LDA * 2) + (unsigned)(C_ * 2); } } } while (0)
#define PG8_STAGE_A(bufoff, ngbase, gkoff, isn, h) do { if constexpr (GATHER) { unsigned vo_[2]; vo_[0] = (isn) ? gaN[h][0] : gaC[h][0]; vo_[1] = (isn) ? gaN[h][1] : gaC[h][1]; \
        PG8_STAGE(bufoff, (const char*)g.A + (gkoff), vo_); } else { PG8_STAGE(bufoff, ngbase, voffA); } } while (0)
#define PG8_LDA(dst, b, h) do { _Pragma("unroll") for (int m = 0; m < 4; ++m) _Pragma("unroll") for (int k = 0; k < 2; ++k) dst[m][k] = *(const LAS bf16x8*)(lds + PG8_SA(b, h) + aoff + m * 2048 + k * 1024); } while (0)
#define PG8_LDB(dst, b, h) do { _Pragma("unroll") for (int n = 0; n < 2; ++n) _Pragma("unroll") for (int k = 0; k < 2; ++k) dst[n][k] = *(const LAS bf16x8*)(lds + PG8_SB(b, h) + boff + n * 2048 + k * 1024); } while (0)
#define PG8_MMA(ai, bj, At, Bt) do { __builtin_amdgcn_s_setprio(1); _Pragma("unroll") for (int m = 0; m < 4; ++m) _Pragma("unroll") for (int n = 0; n < 2; ++n) _Pragma("unroll") for (int k = 0; k < 2; ++k) \
        acc[ai][bj][m][n] = __builtin_amdgcn_mfma_f32_16x16x32_bf16(Bt[n][k], At[m][k], acc[ai][bj][m][n], 0, 0, 0); __builtin_amdgcn_s_setprio(0); } while (0)
#define PG8_WAIT_V(n) asm volatile("s_waitcnt vmcnt(" #n ")" ::: "memory")
#define PG8_WAIT_L(n) asm volatile("s_waitcnt lgkmcnt(" #n ")" ::: "memory")
#define PG8_BAR __builtin_amdgcn_s_barrier()
#define PG8_SCHED __builtin_amdgcn_sched_barrier(0)
    Unit cur, nxt; int ui = 0;
    if (!S.next(0, cur)) return;
    f32x4 acc[2][2][4][2];
#pragma unroll
    for (int a = 0; a < 2; ++a)
#pragma unroll
        for (int b = 0; b < 2; ++b)
#pragma unroll
            for (int m = 0; m < 4; ++m)
#pragma unroll
                for (int n = 0; n < 2; ++n) acc[a][b][m][n] = (f32x4){0.f, 0.f, 0.f, 0.f};
    bf16x8 At[4][2], B0[2][2], B1[2][2];
    const char* cA = (const char*)g.A + (size_t)cur.pm * tstepA; const char* cB = (const char*)g.Bt + (size_t)cur.pn * tstepB;
    S.a_ready(cur);
    PG8_SETGA(gaC, cur);
    if constexpr (GATHER) {
#pragma unroll
        for (int h_ = 0; h_ < 2; ++h_)
#pragma unroll
            for (int i_ = 0; i_ < 2; ++i_) gaN[h_][i_] = gaC[h_][i_]; }
    PG8_STAGE(PG8_SB(0, 0), cB, voffB); PG8_STAGE(PG8_SB(0, 1), cB + hstepB, voffB); PG8_STAGE_A(PG8_SA(0, 0), cA, 0, false, 0); PG8_STAGE_A(PG8_SA(0, 1), cA + hstepA, 0, false, 1);
    if (wr == 1) PG8_BAR;
    PG8_WAIT_V(2); PG8_BAR;
    PG8_STAGE(PG8_SB(1, 0), cB + kstep, voffB); PG8_STAGE_A(PG8_SA(1, 0), cA + kstep, kstep, false, 0); PG8_STAGE(PG8_SB(1, 1), cB + hstepB + kstep, voffB);
    PG8_WAIT_V(6); PG8_BAR;
    for (;;) {
        const bool has_next = S.next(ui + 1, nxt);
        const char* nA = has_next ? (const char*)g.A + (size_t)nxt.pm * tstepA : cA; const char* nB = has_next ? (const char*)g.Bt + (size_t)nxt.pn * tstepB : cB;
        if (has_next) PG8_SETGA(gaN, nxt);
        for (int t = 0; t < nt; t += 2) {
            const bool last = (t == nt - 2);
            const char* a1 = cA + (size_t)(t + 1) * kstep;
            const char* a2 = last ? nA : cA + (size_t)(t + 2) * kstep; const char* b2 = last ? nB : cB + (size_t)(t + 2) * kstep;
            const char* a3 = a2 + kstep; const char* b3 = b2 + kstep;
            const size_t k2 = last ? 0 : (size_t)(t + 2) * kstep;
            if (last && has_next) S.a_ready(nxt);
            if constexpr (MIDHOOK) { if (t == nt / 2) E.mid(acc, cur, wr, wc, fr, fq); }
            PG8_LDB(B0, 0, 0); PG8_LDB(B1, 0, 1); PG8_SCHED; PG8_LDA(At, 0, 0); PG8_STAGE_A(PG8_SA(1, 1), a1 + hstepA, (size_t)(t + 1) * kstep, false, 1);
            PG8_WAIT_V(8); PG8_WAIT_L(0); PG8_BAR; PG8_MMA(0, 0, At, B0); PG8_MMA(0, 1, At, B1); PG8_BAR; PG8_SCHED;
            PG8_LDA(At, 0, 1); PG8_STAGE(PG8_SB(0, 0), b2, voffB); PG8_STAGE(PG8_SB(0, 1), b2 + hstepB, voffB); PG8_STAGE_A(PG8_SA(0, 0), a2, k2, last, 0);
            PG8_WAIT_V(8); PG8_WAIT_L(0); PG8_BAR; PG8_MMA(1, 0, At, B0); PG8_MMA(1, 1, At, B1); PG8_BAR; PG8_SCHED;
            PG8_LDB(B0, 1, 0); PG8_LDB(B1, 1, 1); PG8_SCHED; PG8_LDA(At, 1, 0); PG8_STAGE_A(PG8_SA(0, 1), a2 + hstepA, k2, last, 1);
            PG8_WAIT_V(8); PG8_WAIT_L(0); PG8_BAR; PG8_MMA(0, 0, At, B0); PG8_MMA(0, 1, At, B1); PG8_BAR; PG8_SCHED;
            PG8_LDA(At, 1, 1); PG8_STAGE(PG8_SB(1, 0), b3, voffB); PG8_STAGE(PG8_SB(1, 1), b3 + hstepB, voffB); PG8_STAGE_A(PG8_SA(1, 0), a3, k2 + kstep, last, 0);
            PG8_WAIT_V(8); PG8_WAIT_L(0); PG8_BAR; PG8_MMA(1, 0, At, B0); PG8_MMA(1, 1, At, B1); PG8_BAR; PG8_SCHED;
        }
        if constexpr (ALIGN_EPI) { if (wr == 0) PG8_BAR; }
        E(acc, cur, wr, wc, fr, fq); S.done(cur);
        if (!has_next) break;
#pragma unroll
        for (int a = 0; a < 2; ++a)
#pragma unroll
            for (int b = 0; b < 2; ++b)
#pragma unroll
                for (int m = 0; m < 4; ++m)
#pragma unroll
                    for (int n = 0; n < 2; ++n) acc[a][b][m][n] = (f32x4){0.f, 0.f, 0.f, 0.f};
        cur = nxt; cA = nA; cB = nB; ++ui;
        if constexpr (GATHER) {
#pragma unroll
            for (int h_ = 0; h_ < 2; ++h_)
#pragma unroll
                for (int i_ = 0; i_ < 2; ++i_) gaC[h_][i_] = gaN[h_][i_]; }
        if constexpr (ALIGN_EPI) { if (wr == 1) PG8_BAR; }
    }
    PG8_WAIT_V(0);
    if constexpr (!ALIGN_EPI) { if (wr == 0) PG8_BAR; }
    PG8_BAR;
#undef PG8_SA
#undef PG8_SB
#undef PG8_STAGE
#undef PG8_STAGE_A
#undef PG8_SETGA
#undef PG8_LDA
#undef PG8_LDB
#undef PG8_MMA
#undef PG8_WAIT_V
#undef PG8_WAIT_L
#undef PG8_BAR
#undef PG8_SCHED
}
}
typedef f32x4 AccT[2][2][4][2];

template <int SIG> __device__ __forceinline__ void store_tile_bf16(bf16_t* O, int ld, int colt, float sc, const AccT& acc, int row0, int wc, int fq) {
    const int col0 = colt + wc * 32 + 8 * fq;
#pragma unroll
    for (int ai = 0; ai < 2; ++ai)
#pragma unroll
        for (int m = 0; m < 4; ++m) { bf16_t* rowp = O + (size_t)(row0 + ai * 128 + m * 16) * ld + col0;
#pragma unroll
            for (int bj = 0; bj < 2; ++bj) { f32x4 v0 = acc[ai][bj][m][0] * sc, v1 = acc[ai][bj][m][1] * sc;
                if (SIG) {
#pragma unroll
                    for (int i = 0; i < 4; ++i) { v0[i] = sigmoidf_(v0[i]); v1[i] = sigmoidf_(v1[i]); } }
                *(u32x4*)(rowp + bj * 128) = pack8(v0, v1); } }
}
template <int NORM> __device__ __forceinline__ void store_head64(bf16_t* O, int ld, int cbase, const float* gain, float gsc, const AccT& acc, int row0, int fq) {
    f32x4 gq[2][2];
#pragma unroll
    for (int bj = 0; bj < 2; ++bj)
#pragma unroll
        for (int n = 0; n < 2; ++n) gq[bj][n] = NORM ? *(const f32x4*)(gain + 32 * bj + 8 * fq + 4 * n) * gsc : (f32x4){1.f, 1.f, 1.f, 1.f};
#pragma unroll
    for (int ai = 0; ai < 2; ++ai)
#pragma unroll
        for (int m = 0; m < 4; ++m) {
            float r = 1.f;
            if (NORM) { float ss = 0.f;
#pragma unroll
                for (int bj = 0; bj < 2; ++bj)
#pragma unroll
                    for (int n = 0; n < 2; ++n) { const f32x4 x = acc[ai][bj][m][n]; ss += (x[0] * x[0] + x[1] * x[1]) + (x[2] * x[2] + x[3] * x[3]); }
                ss += __shfl_xor(ss, 16); ss += __shfl_xor(ss, 32);
                r = 1.0f / sqrtf(ss * (1.0f / 64.0f) + EPS); }
            bf16_t* rowp = O + (size_t)(row0 + ai * 128 + m * 16) * ld + cbase + 8 * fq;
#pragma unroll
            for (int bj = 0; bj < 2; ++bj) { const f32x4 v0 = acc[ai][bj][m][0] * r * gq[bj][0], v1 = acc[ai][bj][m][1] * r * gq[bj][1];
                *(u32x4*)(rowp + 32 * bj) = pack8(v0, v1); } }
}
struct EpiIn {
    static constexpr bool PERM = true;
    unsigned char* ws; const float *qg, *kg;
    __device__ __forceinline__ void operator()(const AccT& acc, const pg8::Unit& u, int wr, int wc, int fr, int fq) const {
        asm volatile("" : "+v"(fr), "+v"(fq));
        bf16_t* const qa = (bf16_t*)(ws + WS_QA); bf16_t* const ka = (bf16_t*)(ws + WS_KA); bf16_t* const qb = (bf16_t*)(ws + WS_QB); bf16_t* const qi = (bf16_t*)(ws + WS_QI);
        bf16_t* const kb = (bf16_t*)(ws + WS_KB); bf16_t* const vbT = (bf16_t*)(ws + WS_VBT); bf16_t* const ki = (bf16_t*)(ws + WS_KI); bf16_t* const sga = (bf16_t*)(ws + WS_SGA); bf16_t* const sgb = (bf16_t*)(ws + WS_SGB);
        float* const wi = (float*)(ws + WS_WI);
        const int pn = u.pn, row0 = u.pm * 256 + wr * 64 + fr;
        if (pn < 2) store_tile_bf16<0>(qa, 512, pn * 256, 0.125f * 1.4426950408889634f, acc, row0, wc, fq);
        else if (pn < 4) store_tile_bf16<0>(ka, 512, (pn - 2) * 256, 1.f, acc, row0, wc, fq);
        else if (pn < 6) store_head64<1>(qb, 512, ((pn - 4) * 4 + wc) * 64, qg, 0.125f * 1.4426950408889634f, acc, row0, fq);
        else if (pn < 8) store_tile_bf16<0>(qi, 512, (pn - 6) * 256, 1.f, acc, row0, wc, fq);
        else if (pn == 8) {
            if (wc == 0) store_head64<1>(kb, 64, 0, kg, 1.f, acc, row0, fq);
            else if (wc == 1) {
#pragma unroll
                for (int ai = 0; ai < 2; ++ai)
#pragma unroll
                    for (int m = 0; m < 4; ++m) { bf16_t* p = vbT + (size_t)(8 * fq) * T + (row0 + ai * 128 + m * 16);
#pragma unroll
                        for (int bj = 0; bj < 2; ++bj)
#pragma unroll
                            for (int n = 0; n < 2; ++n)
#pragma unroll
                                for (int i = 0; i < 4; ++i) p[(size_t)(32 * bj + 4 * n + i) * T] = (bf16_t)f2bf(acc[ai][bj][m][n][i]); } }
            else if (wc == 2) store_head64<0>(ki, 64, 0, nullptr, 1.f, acc, row0, fq);
            else { if (fq == 0) {
#pragma unroll
                for (int ai = 0; ai < 2; ++ai)
#pragma unroll
                    for (int m = 0; m < 4; ++m) { float* p = wi + (size_t)(row0 + ai * 128 + m * 16) * 8; *(f32x4*)p = acc[ai][0][m][0]; *(f32x4*)(p + 4) = acc[ai][0][m][1]; } } }
        }
        else if (pn < 13) store_tile_bf16<1>(sga, 1024, (pn - 9) * 256, 1.f, acc, row0, wc, fq);
        else store_tile_bf16<1>(sgb, 1024, (pn - 13) * 256, 1.f, acc, row0, wc, fq);
    }
};
struct EpiPlain {
    static constexpr bool PERM = true;
    bf16_t* O; int ld;
    __device__ __forceinline__ void operator()(const AccT& acc, const pg8::Unit& u, int wr, int wc, int fr, int fq) const {
        asm volatile("" : "+v"(fr), "+v"(fq));
        store_tile_bf16<0>(O, ld, u.pn * 256, 1.f, acc, u.pm * 256 + wr * 64 + fr, wc, fq);
    }
};
struct EpiMerge {
    static constexpr bool PERM = true;
    bf16_t* O; const bf16_t* sga; const bf16_t* sgb;
    __device__ __forceinline__ void mid(AccT& acc, const pg8::Unit& u, int wr, int wc, int fr, int fq) const {
        asm volatile("" : "+v"(fr), "+v"(fq));
        const int row0 = u.pm * 256 + wr * 64 + fr, col0 = u.pn * 256 + wc * 32 + 8 * fq;
#pragma unroll
        for (int ai = 0; ai < 2; ++ai)
#pragma unroll
            for (int m = 0; m < 4; ++m) { const size_t off = (size_t)(row0 + ai * 128 + m * 16) * 1024 + col0;
#pragma unroll
                for (int bj = 0; bj < 2; ++bj) { const u32x4 a = *(const u32x4*)(sga + off + bj * 128), b = *(const u32x4*)(sgb + off + bj * 128);
                    f32x4& v0 = acc[ai][bj][m][0]; f32x4& v1 = acc[ai][bj][m][1];
                    v0[0] *= bflo(a.x) * __builtin_amdgcn_rcpf(bflo(b.x)); v0[1] *= bfhi(a.x) * __builtin_amdgcn_rcpf(bfhi(b.x)); v0[2] *= bflo(a.y) * __builtin_amdgcn_rcpf(bflo(b.y)); v0[3] *= bfhi(a.y) * __builtin_amdgcn_rcpf(bfhi(b.y));
                    v1[0] *= bflo(a.z) * __builtin_amdgcn_rcpf(bflo(b.z)); v1[1] *= bfhi(a.z) * __builtin_amdgcn_rcpf(bfhi(b.z)); v1[2] *= bflo(a.w) * __builtin_amdgcn_rcpf(bflo(b.w)); v1[3] *= bfhi(a.w) * __builtin_amdgcn_rcpf(bfhi(b.w)); } }
    }
    __device__ __forceinline__ void operator()(const AccT& acc, const pg8::Unit& u, int wr, int wc, int fr, int fq) const {
        asm volatile("" : "+v"(fr), "+v"(fq));
        const int row0 = u.pm * 256 + wr * 64 + fr, col0 = u.pn * 256 + wc * 32 + 8 * fq;
#pragma unroll
        for (int ai = 0; ai < 2; ++ai)
#pragma unroll
            for (int m = 0; m < 4; ++m) { const size_t off = (size_t)(row0 + ai * 128 + m * 16) * 1024 + col0;
#pragma unroll
                for (int bj = 0; bj < 2; ++bj) { const u32x4 gw = *(const u32x4*)(sgb + off + bj * 128);
                    f32x4 v0 = acc[ai][bj][m][0], v1 = acc[ai][bj][m][1];
                    v0[0] *= bflo(gw.x); v0[1] *= bfhi(gw.x); v0[2] *= bflo(gw.y); v0[3] *= bfhi(gw.y);
                    v1[0] *= bflo(gw.z); v1[1] *= bfhi(gw.z); v1[2] *= bflo(gw.w); v1[3] *= bfhi(gw.w);
                    *(u32x4*)(O + off + bj * 128) = pack8(v0, v1); } }
    }
};
struct EpiOut {
    static constexpr bool PERM = false;
    const float* xin; float* xout; const float* gvec;
    __device__ __forceinline__ void operator()(const AccT& acc, const pg8::Unit& u, int wr, int wc, int fr, int fq) const {
        asm volatile("" : "+v"(fr), "+v"(fq));
        const int row0 = u.pm * 256 + wr * 64 + fr, col0 = u.pn * 256 + wc * 32 + 4 * fq;
        const int b = (u.pm * 256) / SEQ;
        f32x4 gv[2][2];
#pragma unroll
        for (int bj = 0; bj < 2; ++bj)
#pragma unroll
            for (int n = 0; n < 2; ++n) gv[bj][n] = *(const f32x4*)(gvec + (size_t)b * NMOD + col0 + bj * 128 + n * 16);
#pragma unroll
        for (int ai = 0; ai < 2; ++ai)
#pragma unroll
            for (int m = 0; m < 4; ++m) { const size_t off = (size_t)(row0 + ai * 128 + m * 16) * 1024 + col0;
#pragma unroll
                for (int bj = 0; bj < 2; ++bj)
#pragma unroll
                    for (int n = 0; n < 2; ++n) { const f32x4 xi = *(const f32x4*)(xin + off + bj * 128 + n * 16);
                        *(f32x4*)(xout + off + bj * 128 + n * 16) = xi + gv[bj][n] * acc[ai][bj][m][n]; } }
    }
};
struct EpiMoe1 {
    static constexpr bool PERM = true;
    bf16_t* hid; const float* ew;
    __device__ __forceinline__ void operator()(const AccT& acc, const pg8::Unit& u, int wr, int wc, int fr, int fq) const {
        asm volatile("" : "+v"(fr), "+v"(fq));
        const int r0 = wr * 64 + fr, pnl = u.pn & 3, col0 = 128 * pnl + 16 * wc + 4 * fq;
#pragma unroll
        for (int ai = 0; ai < 2; ++ai)
#pragma unroll
            for (int m = 0; m < 4; ++m) { const int r = r0 + ai * 128 + m * 16; const float cw = r < u.nv ? ew[u.aux + r] : 0.f;
#pragma unroll
                for (int bj = 0; bj < 2; ++bj) { const f32x4 gt = acc[ai][bj][m][0], up = acc[ai][bj][m][1]; f32x4 h;
#pragma unroll
                    for (int i = 0; i < 4; ++i) h[i] = gt[i] * sigmoidf_(gt[i]) * up[i] * cw;
                    u32x2 w; w.x = cvt_pk_bf16(h[0], h[1]); w.y = cvt_pk_bf16(h[2], h[3]);
                    *(u32x2*)(hid + (size_t)(u.pm * 256 + r) * DEXP + col0 + 64 * bj) = w; } }
    }
};
struct EpiMoe2 {
    static constexpr bool PERM = true;
    bf16_t* y; const int* edst;
    __device__ __forceinline__ void operator()(const AccT& acc, const pg8::Unit& u, int wr, int wc, int fr, int fq) const {
        asm volatile("" : "+v"(fr), "+v"(fq));
        const int r0 = wr * 64 + fr, col0 = (u.pn & 3) * 256 + wc * 32 + 8 * fq;
#pragma unroll
        for (int ai = 0; ai < 2; ++ai)
#pragma unroll
            for (int m = 0; m < 4; ++m) { const int r = r0 + ai * 128 + m * 16;
                if (r < u.nv) { const int dst = edst[u.aux + r]; bf16_t* rowp = y + (size_t)dst * 1024 + col0;
#pragma unroll
                    for (int bj = 0; bj < 2; ++bj) *(u32x4*)(rowp + bj * 128) = pack8(acc[ai][bj][m][0], acc[ai][bj][m][1]); } }
    }
};
struct MoeOrder {
    const LAS int* tile_end; int ntiles, G, c;
    __device__ __forceinline__ bool next(int i, pg8::Unit& u) const {
        const int L = i * G + c; if (L >= 4 * ntiles) return false;
        const int rt = L >> 2; int e = 0;
#pragma unroll
        for (int j = 0; j < NE; ++j) e += (rt >= tile_end[j]) ? 1 : 0;
        e = __builtin_amdgcn_readfirstlane(e);
        const int ts = e == 0 ? 0 : __builtin_amdgcn_readfirstlane(tile_end[e - 1]), ne = __builtin_amdgcn_readfirstlane(tile_end[16 + e]);
        u.pm = rt; u.pn = e * 4 + (L & 3); u.aux = e * T + (rt - ts) * 256; u.nv = ne - (rt - ts) * 256; return true;
    }
    __device__ __forceinline__ void a_ready(const pg8::Unit&) const {}
    __device__ __forceinline__ void done(const pg8::Unit&) const {}
};

constexpr int RING_BYTES = 131072, MISC_OFF = 133120, LDS_BYTES = 147456;
struct Args { const float* in[18]; float* out; unsigned char* ws; int ph_lo, ph_hi; };
struct Frame {
    LAS unsigned char* lds; int tid, lane, wave, G, blk;
    float* out; unsigned char* ws; unsigned* ctl;
    __device__ __forceinline__ const float* in(int i) const {
        const LAS unsigned* t = (const LAS unsigned*)(lds + MISC_OFF + 1024) + 2 * i;
        const unsigned lo = __builtin_amdgcn_readfirstlane(t[0]), hi = __builtin_amdgcn_readfirstlane(t[1]);
        return (const float*)(((unsigned long long)hi << 32) | lo);
    }
};
enum { IN_X = 0, IN_C, IN_WADA, IN_BADA, IN_N1G, IN_WIN, IN_QNG, IN_KNG, IN_RELB, IN_WOA, IN_WOB, IN_WOUT, IN_N2G, IN_RW, IN_RB, IN_WG, IN_WU, IN_WDN };

__device__ __forceinline__ int win_src_col(int r) {
    if (r < 1024) return r;
    if (r < 1536) { const int rho = r - 1024, tile = rho >> 8, q = rho & 255, bj = q >> 7, wc = (q >> 5) & 3, j = q & 31; return 1536 + (tile * 4 + wc) * 64 + 32 * bj + j; }
    if (r < 2048) return 2176 + (r - 1536);
    if (r < 2304) { const int q = r - 2048, bj = q >> 7, wc = (q >> 5) & 3, j = q & 31, cs = 32 * bj + j;
        if (wc == 0) return 2048 + cs; if (wc == 1) return 2112 + cs; if (wc == 2) return 2688 + cs; return cs < 8 ? 2752 + cs : -1; }
    if (r < 3328) return 2760 + (r - 2304);
    if (r < 4352) return 3784 + (r - 3328);
    return 1024 + (r - 4352);
}
__device__ __forceinline__ void transpose_item(const float* colp, int ldw, int ksrc0, bf16_t* WT, size_t drow0, int ldk, int kdst0, LAS float* scr, int lane) {
    float tv[32];
    const float* cp = colp ? colp + (size_t)(ksrc0 + (lane >> 5)) * ldw : nullptr;
#pragma unroll
    for (int i = 0; i < 32; ++i) tv[i] = cp ? cp[(size_t)(2 * i) * ldw] : 0.f;
#pragma unroll
    for (int i = 0; i < 32; ++i) scr[(2 * i + (lane >> 5)) * 33 + (lane & 31)] = tv[i];
    LDS_WAIT(); asm volatile("" ::: "memory");
    const int c = lane & 7;
#pragma unroll
    for (int j = 0; j < 4; ++j) { const int n = (lane >> 3) + 8 * j; const LAS float* s = scr + (8 * c) * 33 + n;
        u32x4 o; o.x = pk2(s[0 * 33], s[1 * 33]); o.y = pk2(s[2 * 33], s[3 * 33]); o.z = pk2(s[4 * 33], s[5 * 33]); o.w = pk2(s[6 * 33], s[7 * 33]);
        *(u32x4*)(WT + (drow0 + n) * ldk + kdst0 + 8 * c) = o; }
    LDS_WAIT(); asm volatile("" ::: "memory");
}
constexpr int IT_WIN = 152 * 16, IT_WO = 32 * 16, IT_WOUT = 32 * 16, IT_SMALL = IT_WIN + IT_WO + IT_WOUT;
constexpr int IT_WGU = 16 * 32 * 16, IT_WD = 16 * 32 * 8, IT_EXP = IT_WGU + IT_WD;
__device__ __forceinline__ void convert_small_item(Frame& F, int l, int it, LAS float* scr) {
    const int n31 = F.lane & 31;
    if (it < IT_WIN) { const int rg = it >> 4, kg = it & 15; const int col = win_src_col(rg * 32 + n31);
        transpose_item(col >= 0 ? F.in(IN_WIN) + (size_t)l * DM * NIN + col : nullptr, NIN, kg * 64, (bf16_t*)(F.ws + WS_WIN + l * WIN_LAYER), (size_t)rg * 32, 1024, kg * 64, scr, F.lane); return; }
    it -= IT_WIN;
    if (it < IT_WO) { const int rg = it >> 4, kg = it & 15, k0 = kg * 64; const float* src = (k0 < 512 ? F.in(IN_WOA) : F.in(IN_WOB)) + (size_t)l * 512 * 1024 + rg * 32 + n31;
        transpose_item(src, 1024, k0 & 511, (bf16_t*)(F.ws + WS_WO) + (size_t)l * 1024 * 1024, (size_t)rg * 32, 1024, k0, scr, F.lane); return; }
    it -= IT_WO;
    { const int rg = it >> 4, kg = it & 15; transpose_item(F.in(IN_WOUT) + (size_t)l * 1024 * 1024 + rg * 32 + n31, 1024, kg * 64, (bf16_t*)(F.ws + WS_WOUT) + (size_t)l * 1024 * 1024, (size_t)rg * 32, 1024, kg * 64, scr, F.lane); }
}
__device__ __forceinline__ void convert_expert_item(Frame& F, int l, int it, LAS float* scr) {
    const int n31 = F.lane & 31;
    if (it < IT_WGU) { const int e = it >> 9, r2 = it & 511, rg = r2 >> 4, kg = r2 & 15; const int r = rg * 32 + n31, q = r >> 3, i = r & 7;
        const float* src = (i < 4 ? F.in(IN_WG) : F.in(IN_WU)) + (size_t)(l * NE + e) * DM * DEXP + 4 * q + (i & 3);
        transpose_item(src, DEXP, kg * 64, (bf16_t*)(F.ws + WS_WGU) + (size_t)e * 1024 * 1024, (size_t)rg * 32, 1024, kg * 64, scr, F.lane); return; }
    it -= IT_WGU;
    { const int e = it >> 8, r2 = it & 255, rg = r2 >> 3, kg = r2 & 7;
        transpose_item(F.in(IN_WDN) + (size_t)(l * NE + e) * DEXP * DM + rg * 32 + n31, DM, kg * 64, (bf16_t*)(F.ws + WS_WD) + (size_t)e * 1024 * 512, (size_t)rg * 32, 512, kg * 64, scr, F.lane); }
}

__device__ __forceinline__ void phase_prologue(Frame& F) {
    LAS float* scr = (LAS float*)(F.lds + F.wave * 8448);
    LAS float* sil = (LAS float*)(F.lds + 69632);
    const float* cin = F.in(IN_C); const float* badap = F.in(IN_BADA);
    for (int i = F.tid; i < BATCH * DM; i += NTHR) { const float v = cin[i]; sil[i] = v / (1.f + __expf(-v)); }
    __syncthreads();
    const int gw = F.blk * NWAVES + F.wave, NGW = F.G * NWAVES;
    float* modp = (float*)(F.ws + WS_MODP);
    for (int it = gw; it < 16 * 2 * 96; it += NGW) {
        const int jb = it % 96, l = (it / 96) & 1, kc = it / 192; const int j = jb * 64 + F.lane;
        float a[BATCH];
#pragma unroll
        for (int b = 0; b < BATCH; ++b) a[b] = 0.f;
        const float* wp = F.in(IN_WADA) + ((size_t)l * DM + kc * 64) * NMOD + j;
        for (int k0 = 0; k0 < 64; k0 += 16) { float wv[16];
#pragma unroll
            for (int k = 0; k < 16; ++k) wv[k] = wp[(size_t)(k0 + k) * NMOD];
#pragma unroll
            for (int k = 0; k < 16; ++k)
#pragma unroll
                for (int b = 0; b < BATCH; ++b) a[b] += sil[b * DM + kc * 64 + k0 + k] * wv[k]; }
        const float bias = (kc == 0) ? badap[l * NMOD + j] : 0.f;
#pragma unroll
        for (int b = 0; b < BATCH; ++b) modp[(((size_t)kc * 2 + l) * BATCH + b) * NMOD + j] = a[b] + bias;
    }
    for (int it = gw; it < 2 * IT_SMALL; it += NGW) { const int l = it >= IT_SMALL ? 1 : 0; convert_small_item(F, l, it - l * IT_SMALL, scr); }
    for (int it = gw; it < IT_EXP; it += NGW) convert_expert_item(F, 0, it, scr);
}

__device__ __forceinline__ float modsum(const float* modp, int l, int b, int j) {
    float s = 0.f;
#pragma unroll
    for (int kc = 0; kc < 16; ++kc) s += modp[(((size_t)kc * 2 + l) * BATCH + b) * NMOD + j];
    return s;
}
__device__ __forceinline__ void phase_rows(Frame& F, int l, int mode) {
    LAS float* Av = (LAS float*)F.lds; LAS float* Sv = Av + DM; LAS float* Gv = Sv + DM;
    const float* modp = (const float*)(F.ws + WS_MODP);
    float* mod = (float*)(F.ws + WS_MOD);
    const float* n1g = F.in(IN_N1G); const float* xin = F.in(IN_X);
    const int row_base = F.blk * (T / F.G);
    const int b = row_base / SEQ;
    if (mode == 0) {
        const int per = (2 * BATCH * NMOD) / F.G;
        for (int i = F.tid; i < per; i += NTHR) { const int idx = F.blk * per + i; const int ll = idx / (BATCH * NMOD), bb = (idx / NMOD) % BATCH, j = idx % NMOD; mod[idx] = modsum(modp, ll, bb, j); }
    }
    for (int d = F.tid; d < DM; d += NTHR) {
        if (mode != 2) { Av[d] = n1g[l * DM + d] * (1.f + modsum(modp, l, b, 1 * DM + d)); Sv[d] = modsum(modp, l, b, 0 * DM + d); }
        if (mode != 0) Gv[d] = modsum(modp, l - 1, b, 5 * DM + d);
    }
    if (mode == 1) {
        LAS float* scr = (LAS float*)(F.lds + 16384 + F.wave * 8448);
        const int gw = F.blk * NWAVES + F.wave, NGW = F.G * NWAVES;
        for (int it = gw; it < IT_EXP; it += NGW) convert_expert_item(F, l, it, scr);
    }
    __syncthreads();
    const bf16_t* ybuf = (const bf16_t*)(F.ws + WS_Y);
    bf16_t* hb = (bf16_t*)(F.ws + WS_H);
    const int rows_per_wave = (T / F.G) / NWAVES;
    for (int i0 = 0; i0 < rows_per_wave; i0 += 4) {
        const int row0 = row_base + F.wave * rows_per_wave + i0;
        f32x4 v[4][4]; u32x2 ya[4][4], yb[4][4];
#pragma unroll
        for (int r = 0; r < 4; ++r) { const float* xr = (mode == 0 ? xin : F.out) + (size_t)(row0 + r) * DM;
#pragma unroll
            for (int j = 0; j < 4; ++j) { v[r][j] = *(const f32x4*)(xr + 4 * F.lane + 256 * j);
                if (mode != 0) { ya[r][j] = *(const u32x2*)(ybuf + (size_t)(2 * (row0 + r)) * DM + 4 * F.lane + 256 * j); yb[r][j] = *(const u32x2*)(ybuf + (size_t)(2 * (row0 + r) + 1) * DM + 4 * F.lane + 256 * j); } } }
#pragma unroll
        for (int r = 0; r < 4; ++r) { const int row = row0 + r;
            if (mode != 0) {
#pragma unroll
                for (int j = 0; j < 4; ++j) { const int c0 = 4 * F.lane + 256 * j; const u32x2 y0 = ya[r][j], y1 = yb[r][j];
                    v[r][j][0] += Gv[c0 + 0] * (bflo(y0.x) + bflo(y1.x)); v[r][j][1] += Gv[c0 + 1] * (bfhi(y0.x) + bfhi(y1.x));
                    v[r][j][2] += Gv[c0 + 2] * (bflo(y0.y) + bflo(y1.y)); v[r][j][3] += Gv[c0 + 3] * (bfhi(y0.y) + bfhi(y1.y));
                    *(f32x4*)(F.out + (size_t)row * DM + c0) = v[r][j]; }
            }
            if (mode != 2) {
                float ss = 0.f;
#pragma unroll
                for (int j = 0; j < 4; ++j) ss += (v[r][j][0] * v[r][j][0] + v[r][j][1] * v[r][j][1]) + (v[r][j][2] * v[r][j][2] + v[r][j][3] * v[r][j][3]);
                const float rs = 1.0f / sqrtf(wave_sum(ss) * (1.0f / DM) + EPS);
#pragma unroll
                for (int j = 0; j < 4; ++j) { const int c0 = 4 * F.lane + 256 * j; u32x2 w;
                    w.x = pk2(v[r][j][0] * rs * Av[c0] + Sv[c0], v[r][j][1] * rs * Av[c0 + 1] + Sv[c0 + 1]);
                    w.y = pk2(v[r][j][2] * rs * Av[c0 + 2] + Sv[c0 + 2], v[r][j][3] * rs * Av[c0 + 3] + Sv[c0 + 3]);
                    *(u32x2*)(hb + (size_t)row * DM + c0) = w; }
            }
        }
    }
}

typedef float f32x16 __attribute__((ext_vector_type(16)));
__device__ __forceinline__ bf16x8 pack_bf16x8(float a0, float a1, float a2, float a3, float a4, float a5, float a6, float a7) {
    u32x4 w; w.x = cvt_pk_bf16(a0, a1); w.y = cvt_pk_bf16(a2, a3); w.z = cvt_pk_bf16(a4, a5); w.w = cvt_pk_bf16(a6, a7); return __builtin_bit_cast(bf16x8, w);
}
__device__ __forceinline__ void phase_sb(Frame& F) {
    const bf16_t* qa = (const bf16_t*)(F.ws + WS_QA); const bf16_t* ka = (const bf16_t*)(F.ws + WS_KA); const bf16_t* vaT = (const bf16_t*)(F.ws + WS_VAT);
    bf16_t* oab = (bf16_t*)(F.ws + WS_OAB);
    constexpr int KPITCH = 144, VPITCH = 912, VIMG = 448 * KPITCH;
    for (int bu = F.blk; bu < BATCH * 8 * 8; bu += F.G) {
        int lane = F.lane; asm volatile("" : "+v"(lane)); const int q32 = lane & 31, hi = lane >> 5;
        const int bh = bu >> 3, jblk = bu & 7, b = bh >> 3, h = bh & 7, Q0 = 256 * jblk, KLO = Q0 >= 192 ? Q0 - 192 : 0, nkeys = Q0 + 256 - KLO, nk8 = nkeys >> 3;
        const size_t rowb = (size_t)b * SEQ;
        {
            u32x4 rk[7], rv[7];
#pragma unroll
            for (int i = 0; i < 7; ++i) { const int p = F.tid + 512 * i; if (p < nkeys * 8) rk[i] = *(const u32x4*)(ka + (rowb + KLO + (p >> 3)) * 512 + h * 64 + (p & 7) * 8); }
#pragma unroll
            for (int i = 0; i < 7; ++i) { const int p = F.tid + 512 * i; if (p < nkeys * 8) { const int d = p / nk8, part = p - d * nk8; rv[i] = *(const u32x4*)(vaT + (size_t)(h * 64 + d) * T + rowb + KLO + part * 8); } }
#pragma unroll
            for (int i = 0; i < 7; ++i) { const int p = F.tid + 512 * i; if (p < nkeys * 8) *(LAS u32x4*)(F.lds + (p >> 3) * KPITCH + (p & 7) * 16) = rk[i]; }
#pragma unroll
            for (int i = 0; i < 7; ++i) { const int p = F.tid + 512 * i; if (p < nkeys * 8) { const int d = p / nk8, part = p - d * nk8; *(LAS u32x4*)(F.lds + VIMG + d * VPITCH + part * 16) = rv[i]; } }
        }
        const int qw = Q0 + 32 * F.wave, t = qw + q32;
        const int pirow = 16 * (q32 >> 4) + 8 * ((q32 >> 2) & 1) + 4 * ((q32 >> 3) & 1) + (q32 & 3);
        bf16x8 qf[4];
#pragma unroll
        for (int ks = 0; ks < 4; ++ks) qf[ks] = *(const bf16x8*)(qa + (rowb + t) * 512 + h * 64 + 16 * ks + 8 * hi);
        f32x16 o0, o1;
#pragma unroll
        for (int r = 0; r < 16; ++r) { o0[r] = 0.f; o1[r] = 0.f; }
        float R = 0.f;
        __syncthreads();
        for (int kb = qw; kb >= 0; kb -= 32) {
            bf16x8 kf[4], vf[2][2];
            if (kb >= KLO) {
                const LAS unsigned char* kp = F.lds + (kb - KLO + pirow) * KPITCH + 16 * hi;
#pragma unroll
                for (int ks = 0; ks < 4; ++ks) kf[ks] = *(const LAS bf16x8*)(kp + 32 * ks);
                const LAS unsigned char* vp = F.lds + VIMG + q32 * VPITCH + (kb - KLO + 8 * hi) * 2;
#pragma unroll
                for (int dt = 0; dt < 2; ++dt)
#pragma unroll
                    for (int sx = 0; sx < 2; ++sx) vf[dt][sx] = *(const LAS bf16x8*)(vp + dt * 32 * VPITCH + 32 * sx);
            } else {
                const bf16_t* kp = ka + (rowb + kb + pirow) * 512 + h * 64 + 8 * hi;
#pragma unroll
                for (int ks = 0; ks < 4; ++ks) kf[ks] = *(const bf16x8*)(kp + 16 * ks);
                const bf16_t* vp = vaT + (size_t)(h * 64 + q32) * T + rowb + kb + 8 * hi;
#pragma unroll
                for (int dt = 0; dt < 2; ++dt)
#pragma unroll
                    for (int sx = 0; sx < 2; ++sx) vf[dt][sx] = *(const bf16x8*)(vp + (size_t)dt * 32 * T + 16 * sx);
            }
            f32x16 z;
#pragma unroll
            for (int r = 0; r < 16; ++r) z[r] = 0.f;
#pragma unroll
            for (int ks = 0; ks < 4; ++ks) z = __builtin_amdgcn_mfma_f32_32x32x16_bf16(kf[ks], qf[ks], z, 0, 0, 0);
            float lv[16], zs[16]; bool vl[16];
#pragma unroll
            for (int r = 0; r < 16; ++r) { const float zz = z[r]; const float sp = fmaxf(zz, 0.f) + __builtin_amdgcn_logf(1.f + __builtin_amdgcn_exp2f(-fabsf(zz)));
                vl[r] = (kb + 16 * (r >> 3) + 8 * hi + (r & 7)) < t; lv[r] = vl[r] ? -sp : 0.f; zs[r] = zz - sp; }
            const float g0 = ((lv[0] + lv[1]) + (lv[2] + lv[3])) + ((lv[4] + lv[5]) + (lv[6] + lv[7])), g1 = ((lv[8] + lv[9]) + (lv[10] + lv[11])) + ((lv[12] + lv[13]) + (lv[14] + lv[15]));
            const float p0 = __shfl_xor(g0, 32), p1 = __shfl_xor(g1, 32);
            const float tot = (g0 + p0) + (g1 + p1);
            float av[16];
#pragma unroll
            for (int sg = 0; sg < 2; ++sg) { float sfx = R + (sg == 0 ? (g1 + p1) : 0.f) + (hi == 0 ? (sg == 0 ? p0 : p1) : 0.f);
#pragma unroll
                for (int p = 7; p >= 0; --p) { av[8 * sg + p] = vl[8 * sg + p] ? __builtin_amdgcn_exp2f(zs[8 * sg + p] + sfx) : 0.f; sfx += lv[8 * sg + p]; } }
            R += tot;
            const bf16x8 pf0 = pack_bf16x8(av[0], av[1], av[2], av[3], av[4], av[5], av[6], av[7]);
            const bf16x8 pf1 = pack_bf16x8(av[8], av[9], av[10], av[11], av[12], av[13], av[14], av[15]);
            o0 = __builtin_amdgcn_mfma_f32_32x32x16_bf16(vf[0][0], pf0, o0, 0, 0, 0);
            o0 = __builtin_amdgcn_mfma_f32_32x32x16_bf16(vf[0][1], pf1, o0, 0, 0, 0);
            o1 = __builtin_amdgcn_mfma_f32_32x32x16_bf16(vf[1][0], pf0, o1, 0, 0, 0);
            o1 = __builtin_amdgcn_mfma_f32_32x32x16_bf16(vf[1][1], pf1, o1, 0, 0, 0);
            if (__all(R <= -150.1f)) break;
        }
        bf16_t* op = oab + (rowb + t) * 1024 + h * 64 + 4 * hi;
#pragma unroll
        for (int k = 0; k < 4; ++k) { u32x2 w0, w1; w0.x = cvt_pk_bf16(o0[4 * k], o0[4 * k + 1]); w0.y = cvt_pk_bf16(o0[4 * k + 2], o0[4 * k + 3]);
            w1.x = cvt_pk_bf16(o1[4 * k], o1[4 * k + 1]); w1.y = cvt_pk_bf16(o1[4 * k + 2], o1[4 * k + 3]);
            *(u32x2*)(op + 8 * k) = w0; *(u32x2*)(op + 32 + 8 * k) = w1; }
        __syncthreads();
    }
}

__device__ __forceinline__ unsigned sortable(float f) { const unsigned u = __builtin_bit_cast(unsigned, f); return (u & 0x80000000u) ? ~u : (u | 0x80000000u); }
__device__ __forceinline__ int wave_total(int v) {
    v += __builtin_amdgcn_update_dpp(0, v, 0xB1, 0xf, 0xf, true);
    v += __builtin_amdgcn_update_dpp(0, v, 0x4E, 0xf, 0xf, true);
    v += __builtin_amdgcn_update_dpp(0, v, 0x141, 0xf, 0xf, true);
    v += __builtin_amdgcn_update_dpp(0, v, 0x140, 0xf, 0xf, true);
    return __builtin_amdgcn_readlane(v, 0) + __builtin_amdgcn_readlane(v, 16) + __builtin_amdgcn_readlane(v, 32) + __builtin_amdgcn_readlane(v, 48);
}
typedef unsigned short u16x2 __attribute__((ext_vector_type(2)));
__device__ __forceinline__ u16x2 pk_ge(unsigned x, unsigned cm1) {
    unsigned d; asm("v_pk_sub_u16 %0, %1, %2 clamp\n\tv_pk_min_u16 %0, %0, 1 op_sel_hi:[1,0]" : "=v"(d) : "v"(x), "v"(cm1));
    return __builtin_bit_cast(u16x2, d);
}
template <bool MASKED>
__device__ __forceinline__ void pk_bisect2(const unsigned (&hpa)[16], const unsigned (&lpa)[16], const unsigned (&hpb)[16], const unsigned (&lpb)[16], unsigned hha, unsigned hhb,
                                           int needa, int needb, unsigned& ta, unsigned& tb, bool& exa, bool& exb) {
    ta = 0u; tb = 0u; exa = false; exb = false;
#pragma unroll 1
    for (int bit = 15; bit >= 0; --bit) {
        const unsigned ca = ta | (1u << bit), cb = tb | (1u << bit), ma = (ca - 1u) * 0x10001u, mb_ = (cb - 1u) * 0x10001u;
        u16x2 na = (u16x2){0, 0}, nb = (u16x2){0, 0};
#pragma unroll
        for (int m = 0; m < 16; ++m) {
            if (MASKED) {
                const u16x2 ea = __builtin_elementwise_sub_sat((u16x2){1, 1}, __builtin_bit_cast(u16x2, hpa[m] ^ hha)), eb = __builtin_elementwise_sub_sat((u16x2){1, 1}, __builtin_bit_cast(u16x2, hpb[m] ^ hhb));
                na += pk_ge(lpa[m] & (__builtin_bit_cast(unsigned, ea) * 0xffffu), ma); nb += pk_ge(lpb[m] & (__builtin_bit_cast(unsigned, eb) * 0xffffu), mb_);
            } else { na += pk_ge(hpa[m], ma); nb += pk_ge(hpb[m], mb_); } }
        const int cta = wave_total((int)na.x + (int)na.y), ctb = wave_total((int)nb.x + (int)nb.y);
        if (!exa) { if (cta >= needa) ta = ca; if (cta == needa) exa = true; }
        if (!exb) { if (ctb >= needb) tb = cb; if (ctb == needb) exb = true; }
        if (exa && exb) break;
    }
}
__device__ __forceinline__ void topk_emit_pk(const unsigned (&hp)[16], const unsigned (&lp)[16], unsigned thr, LAS unsigned* maskrow, int lane) {
    int cg = 0, ce = 0;
#pragma unroll
    for (int m = 0; m < 16; ++m) { const unsigned k0 = (hp[m] << 16) | (lp[m] & 0xffffu), k1 = (hp[m] & 0xffff0000u) | (lp[m] >> 16);
        cg += (k0 > thr) ? 1 : 0; ce += (k0 == thr) ? 1 : 0; cg += (k1 > thr) ? 1 : 0; ce += (k1 == thr) ? 1 : 0; }
    const int need = 256 - wave_total(cg), neq = wave_total(ce);
    unsigned bits = 0u;
    if (neq <= need) {
#pragma unroll
        for (int m = 15; m >= 0; --m) { const unsigned k0 = (hp[m] << 16) | (lp[m] & 0xffffu), k1 = (hp[m] & 0xffff0000u) | (lp[m] >> 16);
            bits = (bits << 1) | ((k1 >= thr) ? 1u : 0u); bits = (bits << 1) | ((k0 >= thr) ? 1u : 0u); }
    } else {
        int run = 0; const unsigned long long lt = (1ull << lane) - 1ull;
#pragma unroll 1
        for (int m = 0; m < 16; ++m) {
#pragma unroll
            for (int hf = 0; hf < 2; ++hf) { unsigned k = 0u;
#pragma unroll
                for (int mm = 0; mm < 16; ++mm) if (mm == m) k = hf == 0 ? ((hp[mm] << 16) | (lp[mm] & 0xffffu)) : ((hp[mm] & 0xffff0000u) | (lp[mm] >> 16));
                const unsigned long long eq = __ballot(k == thr);
                const bool tie_sel = (k == thr) && (run + __popcll(eq & lt) < need);
                if (k > thr || tie_sel) bits |= 1u << (2 * m + hf);
                run += __popcll(eq); } }
    }
    maskrow[lane] = bits;
}
__device__ __forceinline__ void topk_select2_pk(const unsigned (&hpa)[16], const unsigned (&lpa)[16], const unsigned (&hpb)[16], const unsigned (&lpb)[16], LAS unsigned* maska, LAS unsigned* maskb, int lane) {
    unsigned ha, hb_; bool exa, exb;
    pk_bisect2<false>(hpa, lpa, hpb, lpb, 0u, 0u, 256, 256, ha, hb_, exa, exb);
    unsigned la = 0u, lb = 0u;
    if (!(exa && exb)) {
        const unsigned hha = ha * 0x10001u, hhb = hb_ * 0x10001u;
        u16x2 ga = (u16x2){0, 0}, gb = (u16x2){0, 0};
#pragma unroll
        for (int m = 0; m < 16; ++m) { ga += pk_ge(hpa[m], hha); gb += pk_ge(hpb[m], hhb); }
        int ra = 256 - wave_total((int)ga.x + (int)ga.y), rb = 256 - wave_total((int)gb.x + (int)gb.y);
        if (ha == 0xffffu) ra = 256; if (hb_ == 0xffffu) rb = 256;
        bool e2a, e2b; unsigned tla, tlb;
        pk_bisect2<true>(hpa, lpa, hpb, lpb, hha, hhb, exa ? 0 : ra, exb ? 0 : rb, tla, tlb, e2a, e2b);
        if (!exa) la = tla; if (!exb) lb = tlb;
    }
    topk_emit_pk(hpa, lpa, (ha << 16) | la, maska, lane);
    topk_emit_pk(hpb, lpb, (hb_ << 16) | lb, maskb, lane);
}
__device__ __forceinline__ int t5_bucket(int d) {
    if (d < 16) return d;
    int bkt = 16;
    bkt += (d >= 19); bkt += (d >= 21); bkt += (d >= 24); bkt += (d >= 27); bkt += (d >= 31); bkt += (d >= 35); bkt += (d >= 40); bkt += (d >= 46);
    bkt += (d >= 52); bkt += (d >= 59); bkt += (d >= 67); bkt += (d >= 77); bkt += (d >= 87); bkt += (d >= 99); bkt += (d >= 113);
    return bkt;
}
constexpr int SC_STRIDE = 2052;
__device__ __forceinline__ void phase_strip(Frame& F, int l) {
    LAS unsigned* SCB = (LAS unsigned*)F.lds;
    LAS unsigned* MSK = (LAS unsigned*)(F.lds + MISC_OFF + 2048);
    LAS float* LUT = (LAS float*)(F.lds + MISC_OFF + 2048 + 4224);
    LAS float* MB = (LAS float*)(F.lds + MISC_OFF + 2048 + 4224 + 3712);
    const bf16_t* qi = (const bf16_t*)(F.ws + WS_QI); const bf16_t* ki = (const bf16_t*)(F.ws + WS_KI); const float* wi = (const float*)(F.ws + WS_WI);
    const bf16_t* qb = (const bf16_t*)(F.ws + WS_QB); const bf16_t* kbp = (const bf16_t*)(F.ws + WS_KB); const bf16_t* vbT = (const bf16_t*)(F.ws + WS_VBT);
    bf16_t* oab = (bf16_t*)(F.ws + WS_OAB);
    const float* relb = F.in(IN_RELB);
    for (int i = F.tid; i < 8 * 114; i += NTHR) { const int h = i / 114, d = i % 114; LUT[i] = relb[t5_bucket(d) * 8 + h] * 1.4426950408889634f; }
    if (F.tid < 8) { const float* qg = F.in(IN_QNG) + l * 64; const float* kg = F.in(IN_KNG) + l * 64; float gq = 0.f, gk = 0.f, bm = -1e30f;
        for (int d = 0; d < 64; ++d) { gq = fmaxf(gq, fabsf(qg[d])); gk = fmaxf(gk, fabsf(kg[d])); }
        for (int k = 0; k < 32; ++k) bm = fmaxf(bm, relb[k * 8 + F.tid]);
        MB[F.tid] = (8.1f * gq * gk + bm) * 1.4426950408889634f; }
    __syncthreads();
    const int w = F.wave;
    for (int vc = F.blk; vc < 256; vc += F.G) {
        const int b = vc & 7, jj = vc >> 3; const size_t rowb = (size_t)b * SEQ;
        for (int it = 0; it < 4; ++it) {
            int lane = F.lane; asm volatile("" : "+v"(lane)); const int q = lane & 15, g = lane >> 4;
            const int si = it == 0 ? jj : (it == 1 ? 63 - jj : (it == 2 ? 64 + jj : 127 - jj)); const int t0 = 16 * si;
            if (si < 16) {
                for (int idx = F.tid; idx < 16 * 64; idx += NTHR) { const int tq = t0 + (idx >> 6), L = idx & 63; unsigned bw = 0u;
#pragma unroll
                    for (int j = 0; j < 4; ++j) bw |= (L + 64 * j <= tq) ? (1u << j) : 0u;
                    MSK[(idx >> 6) * 65 + L] = bw; }
            } else {
                bf16x8 qif[8][2]; float wq[8];
#pragma unroll
                for (int h = 0; h < 8; ++h) { wq[h] = wi[(rowb + t0 + q) * 8 + h];
#pragma unroll
                    for (int ks = 0; ks < 2; ++ks) qif[h][ks] = *(const bf16x8*)(qi + (rowb + t0 + q) * 512 + h * 64 + 32 * ks + 8 * g); }
                const bf16_t* kpb = ki + (rowb + 16 * w + q) * 64 + 8 * g;
                const int ntw = (si - w) / 8 + 1;
                bf16x8 ka0, ka1, kb0, kb1, kc0, kc1;
#define IDX_LOAD(K0, K1, n) do { K0 = *(const bf16x8*)(kpb + (size_t)(128 * (n)) * 64); K1 = *(const bf16x8*)(kpb + (size_t)(128 * (n)) * 64 + 32); } while (0)
#define IDX_TILE(K0, K1, n) do { const bf16x8 kf0 = K0, kf1 = K1; const int kt = w + 8 * (n); if ((n) + 3 < ntw) IDX_LOAD(K0, K1, (n) + 3); \
                    f32x4 sc = (f32x4){0.f, 0.f, 0.f, 0.f}; \
                    _Pragma("unroll") for (int h = 0; h < 8; ++h) { f32x4 d = __builtin_amdgcn_mfma_f32_16x16x32_bf16(kf0, qif[h][0], (f32x4){0.f, 0.f, 0.f, 0.f}, 0, 0, 0); \
                        d = __builtin_amdgcn_mfma_f32_16x16x32_bf16(kf1, qif[h][1], d, 0, 0, 0); \
                        _Pragma("unroll") for (int i = 0; i < 4; ++i) sc[i] += wq[h] * fmaxf(d[i], 0.f); } \
                    u32x4 key; \
                    _Pragma("unroll") for (int i = 0; i < 4; ++i) key[i] = (16 * kt + 4 * g + i <= t0 + q) ? sortable(sc[i] + 0.f) : 0u; \
                    *(LAS u32x4*)(SCB + q * SC_STRIDE + 16 * kt + 4 * g) = key; } while (0)
                IDX_LOAD(ka0, ka1, 0); if (1 < ntw) IDX_LOAD(kb0, kb1, 1); if (2 < ntw) IDX_LOAD(kc0, kc1, 2);
                for (int n = 0; n < ntw; n += 3) { IDX_TILE(ka0, ka1, n); if (n + 1 < ntw) IDX_TILE(kb0, kb1, n + 1); if (n + 2 < ntw) IDX_TILE(kc0, kc1, n + 2); }
#undef IDX_LOAD
#undef IDX_TILE
                __syncthreads();
                const int nk = 16 * (si + 1);
                { unsigned hpa[16], lpa[16], hpb[16], lpb[16]; const int nm = (nk + 127) >> 7;
#pragma unroll
                    for (int m = 0; m < 16; ++m) { hpa[m] = 0u; lpa[m] = 0u; hpb[m] = 0u; lpb[m] = 0u;
                        if (m < nm) { const int s0 = lane + 128 * m, s1 = s0 + 64;
                            const unsigned a0 = (s0 < nk) ? SCB[(2 * w) * SC_STRIDE + s0] : 0u, a1 = (s1 < nk) ? SCB[(2 * w) * SC_STRIDE + s1] : 0u;
                            const unsigned b0 = (s0 < nk) ? SCB[(2 * w + 1) * SC_STRIDE + s0] : 0u, b1 = (s1 < nk) ? SCB[(2 * w + 1) * SC_STRIDE + s1] : 0u;
                            hpa[m] = (a0 >> 16) | (a1 & 0xffff0000u); lpa[m] = (a0 & 0xffffu) | (a1 << 16);
                            hpb[m] = (b0 >> 16) | (b1 & 0xffff0000u); lpb[m] = (b0 & 0xffffu) | (b1 << 16); } }
                    topk_select2_pk(hpa, lpa, hpb, lpb, MSK + (2 * w) * 65, MSK + (2 * w + 1) * 65, lane); }
            }
            __syncthreads();
            {
                const int h = w, t = t0 + q;
                bf16x8 qf[2];
#pragma unroll
                for (int ks = 0; ks < 2; ++ks) qf[ks] = *(const bf16x8*)(qb + (rowb + t) * 512 + h * 64 + 32 * ks + 8 * g);
                f32x4 o[4];
#pragma unroll
                for (int dt = 0; dt < 4; ++dt) o[dt] = (f32x4){0.f, 0.f, 0.f, 0.f};
                float l = 0.f;
                const float mb = MB[h], cfar = LUT[h * 114 + 113] - mb;
                unsigned mwr[2][8];
#pragma unroll
                for (int p = 0; p < 2; ++p)
#pragma unroll
                    for (int e = 0; e < 8; ++e) mwr[p][e] = MSK[q * 65 + 32 * p + 8 * g + e];
                const int nch = (t0 + 15) / 32 + 1, nst = (t0 + 15) / 128 + 1;
                constexpr int STG = 35840, VOFF = 18432;
                const bf16_t* gk0 = kbp + (rowb + (F.tid >> 3)) * 64 + 8 * (F.tid & 7);
                const bf16_t* gv0 = vbT + (size_t)(F.tid >> 4) * T + rowb + 8 * (F.tid & 15);
                const int dk0 = (F.tid >> 3) * 144 + (F.tid & 7) * 16, dv0 = VOFF + (F.tid >> 4) * 272 + (F.tid & 15) * 16;
                u32x4 ra[4];
#define DSA_LOAD(R, st) do { R[0] = *(const u32x4*)(gk0 + (size_t)(128 * (st)) * 64); R[1] = *(const u32x4*)(gk0 + (size_t)(128 * (st) + 64) * 64); \
                    R[2] = *(const u32x4*)(gv0 + 128 * (st)); R[3] = *(const u32x4*)(gv0 + (size_t)32 * T + 128 * (st)); } while (0)
#define DSA_PUT(R, st) do { LAS unsigned char* sp_ = F.lds + ((st) % 3) * STG; *(LAS u32x4*)(sp_ + dk0) = R[0]; *(LAS u32x4*)(sp_ + dk0 + 64 * 144) = R[1]; \
                    *(LAS u32x4*)(sp_ + dv0) = R[2]; *(LAS u32x4*)(sp_ + dv0 + 32 * 272) = R[3]; } while (0)
                DSA_LOAD(ra, 0); DSA_PUT(ra, 0); if (nst > 1) DSA_LOAD(ra, 1);
                asm volatile("s_waitcnt lgkmcnt(0)" ::: "memory"); __builtin_amdgcn_s_barrier(); asm volatile("" ::: "memory");
#define DSA_STAGE(st, RN) do { \
                    if ((st) + 1 < nst) { DSA_PUT(RN, (st) + 1); if ((st) + 2 < nst) DSA_LOAD(RN, (st) + 2); } \
                    const LAS unsigned char* stg = F.lds + ((st) % 3) * STG; \
                    _Pragma("unroll") for (int cc = 0; cc < 4; ++cc) { const int c = 4 * (st) + cc; if (c < nch) { \
                        bf16x8 kf[2][2], vf[4];                                    \
                        _Pragma("unroll") for (int tl = 0; tl < 2; ++tl) _Pragma("unroll") for (int ks = 0; ks < 2; ++ks) kf[tl][ks] = *(const LAS bf16x8*)(stg + (32 * cc + 8 * (q >> 2) + 4 * tl + (q & 3)) * 144 + 16 * g + 64 * ks); \
                        _Pragma("unroll") for (int dt = 0; dt < 4; ++dt) vf[dt] = *(const LAS bf16x8*)(stg + VOFF + (16 * dt + q) * 272 + 64 * cc + 16 * g); \
                        const bool farc = (t0 - (32 * c + 31)) >= 113; \
                        const float ci = farc ? cfar : -mb; \
                        f32x4 s0 = __builtin_amdgcn_mfma_f32_16x16x32_bf16(kf[0][0], qf[0], (f32x4){ci, ci, ci, ci}, 0, 0, 0); \
                        s0 = __builtin_amdgcn_mfma_f32_16x16x32_bf16(kf[0][1], qf[1], s0, 0, 0, 0); \
                        f32x4 s1 = __builtin_amdgcn_mfma_f32_16x16x32_bf16(kf[1][0], qf[0], (f32x4){ci, ci, ci, ci}, 0, 0, 0); \
                        s1 = __builtin_amdgcn_mfma_f32_16x16x32_bf16(kf[1][1], qf[1], s1, 0, 0, 0); \
                        if (!farc) { \
                            _Pragma("unroll") for (int i = 0; i < 4; ++i) { const int k0 = 32 * c + 8 * g + i, k1 = k0 + 4; \
                                int d0 = t - k0, d1 = t - k1; d0 = d0 < 0 ? 0 : (d0 > 113 ? 113 : d0); d1 = d1 < 0 ? 0 : (d1 > 113 ? 113 : d1); \
                                s0[i] += LUT[h * 114 + d0]; s1[i] += LUT[h * 114 + d1]; } } \
                        float p[8]; \
                        _Pragma("unroll") for (int i = 0; i < 4; ++i) { \
                            p[i] = __builtin_bit_cast(float, __builtin_bit_cast(unsigned, __builtin_amdgcn_exp2f(s0[i])) & (unsigned)__builtin_amdgcn_sbfe((int)mwr[cc & 1][i], (unsigned)(c >> 1), 1u)); \
                            p[4 + i] = __builtin_bit_cast(float, __builtin_bit_cast(unsigned, __builtin_amdgcn_exp2f(s1[i])) & (unsigned)__builtin_amdgcn_sbfe((int)mwr[cc & 1][4 + i], (unsigned)(c >> 1), 1u)); } \
                        l += ((p[0] + p[1]) + (p[2] + p[3])) + ((p[4] + p[5]) + (p[6] + p[7])); \
                        const bf16x8 pf = pack_bf16x8(p[0], p[1], p[2], p[3], p[4], p[5], p[6], p[7]); \
                        _Pragma("unroll") for (int dt = 0; dt < 4; ++dt) o[dt] = __builtin_amdgcn_mfma_f32_16x16x32_bf16(vf[dt], pf, o[dt], 0, 0, 0); } __builtin_amdgcn_sched_barrier(0); } \
                    asm volatile("s_waitcnt lgkmcnt(0)" ::: "memory"); __builtin_amdgcn_s_barrier(); asm volatile("" ::: "memory"); } while (0)
                for (int st = 0; st < nst; ++st) { DSA_STAGE(st, ra); }
#undef DSA_STAGE
#undef DSA_LOAD
#undef DSA_PUT
                l += __shfl_xor(l, 16); l += __shfl_xor(l, 32);
                const float il = 1.f / l;
                bf16_t* op = oab + (rowb + t) * 1024 + 512 + h * 64 + 4 * g;
#pragma unroll
                for (int dt = 0; dt < 4; ++dt) { u32x2 wv; wv.x = cvt_pk_bf16(o[dt][0] * il, o[dt][1] * il); wv.y = cvt_pk_bf16(o[dt][2] * il, o[dt][3] * il); *(u32x2*)(op + 16 * dt) = wv; }
            }
            __syncthreads();
        }
    }
}

__device__ __forceinline__ void phase_h2_route(Frame& F, int l) {
    LAS float* Av = (LAS float*)F.lds; LAS float* Sv = Av + DM;
    LAS float* RW = (LAS float*)(F.lds + 8192);
    LAS float* RB = (LAS float*)(F.lds + 73728);
    LAS int* lcnt = (LAS int*)(F.lds + 73728 + 64);
    LAS int* lbase = (LAS int*)(F.lds + 73728 + 128);
    LAS int* rinfo = (LAS int*)(F.lds + 73728 + 256);
    const float* mod = (const float*)(F.ws + WS_MOD) + (size_t)l * BATCH * NMOD;
    const int rows_per_blk = T / F.G, row_base = F.blk * rows_per_blk, b = row_base / SEQ;
    const float* n2g = F.in(IN_N2G); const float* rwp = F.in(IN_RW); const float* rbp = F.in(IN_RB);
    for (int d = F.tid; d < DM; d += NTHR) { Av[d] = n2g[l * DM + d] * (1.f + mod[(size_t)b * NMOD + 4 * DM + d]); Sv[d] = mod[(size_t)b * NMOD + 3 * DM + d]; }
    for (int i = F.tid; i < DM * NE; i += NTHR) RW[(i & 15) * DM + (i >> 4)] = rwp[i];
    if (F.tid < NE) { RB[F.tid] = rbp[F.tid]; lcnt[F.tid] = 0; }
    __syncthreads();
    bf16_t* hb = (bf16_t*)(F.ws + WS_H);
    const int rows_per_wave = rows_per_blk / NWAVES;
    for (int i0 = 0; i0 < rows_per_wave; i0 += 2) {
      f32x4 vin[2][4];
#pragma unroll
      for (int r = 0; r < 2; ++r)
#pragma unroll
          for (int j = 0; j < 4; ++j) vin[r][j] = *(const f32x4*)(F.out + (size_t)(row_base + F.wave * rows_per_wave + i0 + r) * DM + 4 * F.lane + 256 * j);
#pragma unroll 1
      for (int rr = 0; rr < 2; ++rr) {
        const int lr = F.wave * rows_per_wave + i0 + rr, row = row_base + lr;
        f32x4 v[4]; float ss = 0.f;
#pragma unroll
        for (int j = 0; j < 4; ++j) { v[j] = rr == 0 ? vin[0][j] : vin[1][j]; ss += (v[j][0] * v[j][0] + v[j][1] * v[j][1]) + (v[j][2] * v[j][2] + v[j][3] * v[j][3]); }
        const float r = 1.0f / sqrtf(wave_sum(ss) * (1.0f / DM) + EPS);
        float lg[NE];
#pragma unroll
        for (int e = 0; e < NE; ++e) lg[e] = 0.f;
#pragma unroll
        for (int j = 0; j < 4; ++j) { const int c0 = 4 * F.lane + 256 * j; u32x2 w;
#pragma unroll
            for (int k = 0; k < 4; ++k) v[j][k] = v[j][k] * r * Av[c0 + k] + Sv[c0 + k];
#pragma unroll
            for (int e = 0; e < NE; ++e) { const f32x4 rw = *(const LAS f32x4*)(RW + e * DM + c0);
                lg[e] += (v[j][0] * rw[0] + v[j][1] * rw[1]) + (v[j][2] * rw[2] + v[j][3] * rw[3]); }
            w.x = pk2(v[j][0], v[j][1]); w.y = pk2(v[j][2], v[j][3]);
            *(u32x2*)(hb + (size_t)row * DM + c0) = w; }
        float mxl = -1e30f;
#pragma unroll
        for (int e = 0; e < NE; ++e) { lg[e] = wave_sum(lg[e]) + RB[e]; mxl = fmaxf(mxl, lg[e]); }
        float pr[NE], den = 0.f;
#pragma unroll
        for (int e = 0; e < NE; ++e) { pr[e] = expf(lg[e] - mxl); den += pr[e]; }
        const float iden = 1.f / den;
#pragma unroll
        for (int e = 0; e < NE; ++e) pr[e] *= iden;
        int bg = 0; float bs = -1.f, bv0 = 0.f, bv1 = 0.f; int bi0 = 0, bi1 = 1;
#pragma unroll
        for (int g = 0; g < 4; ++g) {
            float v0 = pr[4 * g], v1 = -1.f; int i0 = 0, i1 = -1;
#pragma unroll
            for (int k = 1; k < 4; ++k) { const float p = pr[4 * g + k];
                if (p > v0) { v1 = v0; i1 = i0; v0 = p; i0 = k; } else if (p > v1) { v1 = p; i1 = k; } }
            const float gs = v0 + v1;
            if (gs > bs) { bs = gs; bg = g; bv0 = v0; bv1 = v1; bi0 = i0; bi1 = i1; }
        }
        const int e0 = bg * 4 + bi0, e1 = bg * 4 + bi1; const float wsum = bv0 + bv1, w0 = bv0 / wsum, w1 = bv1 / wsum;
        if (F.lane == 0) { const int p0 = __hip_atomic_fetch_add(lcnt + e0, 1, __ATOMIC_RELAXED, __HIP_MEMORY_SCOPE_WORKGROUP), p1 = __hip_atomic_fetch_add(lcnt + e1, 1, __ATOMIC_RELAXED, __HIP_MEMORY_SCOPE_WORKGROUP);
            rinfo[lr * 6 + 0] = e0; rinfo[lr * 6 + 1] = p0; rinfo[lr * 6 + 2] = __float_as_int(w0); rinfo[lr * 6 + 3] = e1; rinfo[lr * 6 + 4] = p1; rinfo[lr * 6 + 5] = __float_as_int(w1); }
      }
    }
    __syncthreads();
    unsigned* gcnt = F.ctl + CW_GCNT + 64 * l;
    if (F.tid < NE) lbase[F.tid] = (int)__hip_atomic_fetch_add(gcnt + F.tid, (unsigned)lcnt[F.tid], RLX_AGENT);
    __syncthreads();
    int* etok = (int*)(F.ws + WS_ETOK); float* ew = (float*)(F.ws + WS_EW); int* edst = (int*)(F.ws + WS_EDST);
    if (F.tid < 2 * rows_per_blk) { const int lr = F.tid >> 1, k = F.tid & 1; const int e = rinfo[lr * 6 + 3 * k], p = rinfo[lr * 6 + 3 * k + 1]; const float w = __int_as_float(rinfo[lr * 6 + 3 * k + 2]);
        const int slot = lbase[e] + p, tok = row_base + lr;
        etok[e * T + slot] = tok; ew[e * T + slot] = w; edst[e * T + slot] = 2 * tok + k; }
}

__device__ __forceinline__ int moe_table(Frame& F, int l, LAS int* tile_end) {
    if (F.tid < 64) { const int e = F.lane & 15; const int n = (int)__hip_atomic_load(F.ctl + CW_GCNT + 64 * l + e, RLX_AGENT); int tiles = (n + 255) >> 8, cum = tiles;
#pragma unroll
        for (int o = 1; o < 16; o <<= 1) { const int v = __shfl_up(cum, o, 16); if (e >= o) cum += v; }
        if (F.lane < 16) { tile_end[e] = cum; tile_end[16 + e] = n; } }
    __syncthreads();
    return tile_end[15];
}
#define XB_TMO      128
#define XB_XCNT(j)  (256  + 64 * (j))
#define XB_XSUB(j)  (1280 + 64 * (j))
#define XB_XGEN(j)  (2304 + 64 * (j))
#define XB_TOP      3328
#define XB_TOPGEN   3392
#define XCD_BAR_WORDS 3456
#define XB_SPIN_CAP (1u << 20)
__device__ __forceinline__ unsigned xb_ld(unsigned* p)              { return __hip_atomic_load(p, __ATOMIC_RELAXED, __HIP_MEMORY_SCOPE_AGENT); }
__device__ __forceinline__ unsigned xb_add(unsigned* p, unsigned v) { return __hip_atomic_fetch_add(p, v, __ATOMIC_RELAXED, __HIP_MEMORY_SCOPE_AGENT); }
__device__ __forceinline__ unsigned xb_xcc_id() { return (unsigned)__builtin_amdgcn_s_getreg((3 << 11) | 20) & 0xFu; }
#define XB_SPIN(cond, bar) do { unsigned _sp = 0; while (cond) { __builtin_amdgcn_s_sleep(1); \
    if ((++_sp & 255u) == 0u) { if (xb_ld(&(bar)[XB_TMO])) break; if (_sp > XB_SPIN_CAP) { atomicAdd(&(bar)[XB_TMO], 1u); break; } } } } while (0)
struct XcdBarrier { unsigned* bar; unsigned x; volatile LAS unsigned* st; };
__device__ __forceinline__ XcdBarrier xcd_barrier_post(unsigned* bar, volatile LAS unsigned* st) {
    XcdBarrier b; b.bar = bar; b.x = xb_xcc_id(); b.st = st;
    if (threadIdx.x == 0) (void)xb_add(&bar[XB_XCNT(b.x)], 1u);
    return b;
}
__device__ __forceinline__ void xcd_barrier_complete(unsigned* bar, unsigned x, unsigned& nloc, unsigned& nx) {
    const unsigned G = gridDim.x * gridDim.y * gridDim.z;
    unsigned sum, cnt, mine, sp = 0u;
    for (;;) {
        sum = 0u; cnt = 0u; mine = 0u;
#pragma unroll 1
        for (unsigned j = 0; j < 16; ++j) { const unsigned c = xb_ld(&bar[XB_XCNT(j)]); sum += c; cnt += (c > 0u) ? 1u : 0u; mine = (j == x) ? c : mine; }
        if (sum == G) break;
        __builtin_amdgcn_s_sleep(1);
        if ((++sp & 255u) == 0u) { if (xb_ld(&bar[XB_TMO])) break; if (sp > XB_SPIN_CAP) { atomicAdd(&bar[XB_TMO], 1u); break; } }
    }
    nloc = mine > 0u ? mine : 1u; nx = cnt > 0u ? cnt : 1u;
}
__device__ __forceinline__ void xcd_barrier(const XcdBarrier& b) {
    asm volatile("s_waitcnt vmcnt(0)" ::: "memory");
    __syncthreads();
    if (threadIdx.x == 0) {
        unsigned* bar = b.bar; asm volatile("" : "+s"(bar));
        __builtin_amdgcn_s_waitcnt(0);
        unsigned nloc = b.st[0], nx = b.st[1];
        if (nloc == 0u) { xcd_barrier_complete(bar, b.x, nloc, nx); b.st[0] = nloc; b.st[1] = nx; }
        const unsigned old = xb_add(&bar[XB_XSUB(b.x)], 1u);
        const unsigned gen = old / nloc;
        if (old + 1u == (gen + 1u) * nloc) {
            __builtin_amdgcn_fence(__ATOMIC_RELEASE, "agent");
            asm volatile("s_waitcnt vmcnt(0)" ::: "memory");
            const unsigned og = xb_add(&bar[XB_TOP], 1u);
            const unsigned tg = og / nx;
            if (og + 1u == (tg + 1u) * nx) xb_add(&bar[XB_TOPGEN], 1u);
            else XB_SPIN(xb_ld(&bar[XB_TOPGEN]) == tg, bar);
            __builtin_amdgcn_fence(__ATOMIC_ACQUIRE, "agent");
            xb_add(&bar[XB_XGEN(b.x)], 1u);
            asm volatile("s_waitcnt vmcnt(0)" ::: "memory");
        } else {
            XB_SPIN(xb_ld(&bar[XB_XGEN(b.x)]) == gen, bar);
            __builtin_amdgcn_fence(__ATOMIC_ACQUIRE, "agent");
            asm volatile("s_waitcnt vmcnt(0)" ::: "memory");
        }
    }
    __syncthreads();
}

constexpr int PH_PER_LAYER = 8, PH_FINAL = 1 + PH_PER_LAYER * DEPTH, N_PHASES = PH_FINAL + 1;
__global__ void __launch_bounds__(NTHR, 2) fwd_kernel(Args args) {
    extern __shared__ __attribute__((aligned(16))) unsigned char lds_raw[];
    Frame F;
    F.lds = (LAS unsigned char*)lds_raw;
    F.tid = threadIdx.x; F.lane = F.tid & 63; F.wave = __builtin_amdgcn_readfirstlane(F.tid >> 6); F.G = gridDim.x; F.blk = blockIdx.x;
    F.out = args.out; F.ws = args.ws; F.ctl = (unsigned*)(args.ws + WS_CTL);
    volatile LAS unsigned* MISC = (volatile LAS unsigned*)(F.lds + MISC_OFF);
    for (int u = F.tid; u < (LDS_BYTES - MISC_OFF) / 4; u += NTHR) ((LAS unsigned*)(F.lds + MISC_OFF))[u] = 0u;
    __syncthreads();
    if (F.tid < 36) ((LAS unsigned*)(F.lds + MISC_OFF + 1024))[F.tid] = ((const unsigned*)__builtin_amdgcn_kernarg_segment_ptr())[F.tid];
    __syncthreads();
    const int lo = args.ph_lo, hi = args.ph_hi;
    XcdBarrier bar; bar.bar = F.ctl + CW_BAR; bar.x = 0; bar.st = nullptr;
    if (hi - lo > 1) bar = xcd_barrier_post(F.ctl + CW_BAR, MISC + 8);
#define SEAM(k) do { if ((k) + 1 < hi) xcd_barrier(bar); } while (0)
    for (int ph = lo; ph < hi; ++ph) {
        { int t_ = threadIdx.x; asm volatile("" : "+v"(t_)); F.tid = t_; F.lane = t_ & 63; F.wave = __builtin_amdgcn_readfirstlane(t_ >> 6);
          unsigned char* w_ = args.ws; asm volatile("" : "+s"(w_)); F.ws = w_; F.ctl = (unsigned*)(w_ + WS_CTL); float* o_ = args.out; asm volatile("" : "+s"(o_)); F.out = o_; }
        if (ph == 0) { phase_prologue(F); }
        else if (ph == PH_FINAL) { phase_rows(F, DEPTH, 2); }
        else {
            const int l = (ph - 1) / PH_PER_LAYER, s = (ph - 1) % PH_PER_LAYER;
            bf16_t* hb = (bf16_t*)(F.ws + WS_H);
            if (s == 0) { phase_rows(F, l, l == 0 ? 0 : 1); }
            else if (s == 1) {
                { pg8::Gemm g{hb, (const bf16_t*)(F.ws + WS_WIN + l * WIN_LAYER), nullptr}; pg8::StaticOrder S; S.init(T, NMAIN, F.G, F.blk);
                  EpiIn E{F.ws, F.in(IN_QNG) + l * 64, F.in(IN_KNG) + l * 64};
                  pg8::gemm_phase<1024, 1024, 1024, EpiIn, pg8::StaticOrder, true>(F.lds, g, S, E, F.tid); }
                { pg8::Gemm g{(const bf16_t*)(F.ws + WS_WIN + l * WIN_LAYER) + (size_t)NMAIN * 1024, hb, nullptr}; pg8::StaticOrder S; S.init(512, T, F.G, (F.blk + F.G / 2) % F.G);
                  EpiPlain E{(bf16_t*)(F.ws + WS_VAT), T};
                  pg8::gemm_phase<1024, 1024, 1024, EpiPlain, pg8::StaticOrder, true>(F.lds, g, S, E, F.tid); }
            }
            else if (s == 2) { phase_strip(F, l); phase_sb(F); }
            else if (s == 3) {
                pg8::Gemm g{(const bf16_t*)(F.ws + WS_OAB), (const bf16_t*)(F.ws + WS_WO) + (size_t)l * 1024 * 1024, nullptr}; pg8::StaticOrder S; S.init(T, 1024, F.G, F.blk);
                EpiMerge E{(bf16_t*)(F.ws + WS_MERGED), (const bf16_t*)(F.ws + WS_SGA), (const bf16_t*)(F.ws + WS_SGB)};
                pg8::gemm_phase<1024, 1024, 1024, EpiMerge, pg8::StaticOrder, true, false, true>(F.lds, g, S, E, F.tid);
            }
            else if (s == 4) {
                pg8::Gemm g{(const bf16_t*)(F.ws + WS_MERGED), (const bf16_t*)(F.ws + WS_WOUT) + (size_t)l * 1024 * 1024, nullptr}; pg8::StaticOrder S; S.init(T, 1024, F.G, F.blk);
                EpiOut E{l == 0 ? F.in(IN_X) : F.out, F.out, (const float*)(F.ws + WS_MOD) + (size_t)l * BATCH * NMOD + 2 * DM};
                pg8::gemm_phase<1024, 1024, 1024, EpiOut, pg8::StaticOrder, true>(F.lds, g, S, E, F.tid);
            }
            else if (s == 5) { phase_h2_route(F, l); }
            else if (s == 6 || s == 7) {
                LAS int* tile_end = (LAS int*)(F.lds + MISC_OFF + 512);
                const int ntiles = moe_table(F, l, tile_end);
                MoeOrder S{tile_end, ntiles, F.G, F.blk};
                if (s == 6) { pg8::Gemm g{(const bf16_t*)(F.ws + WS_H), (const bf16_t*)(F.ws + WS_WGU), (const int*)(F.ws + WS_ETOK)};
                    EpiMoe1 E{(bf16_t*)(F.ws + WS_HID), (const float*)(F.ws + WS_EW)};
                    pg8::gemm_phase<1024, 1024, 1024, EpiMoe1, MoeOrder, true, true>(F.lds, g, S, E, F.tid); }
                else { pg8::Gemm g{(const bf16_t*)(F.ws + WS_HID), (const bf16_t*)(F.ws + WS_WD), nullptr};
                    EpiMoe2 E{(bf16_t*)(F.ws + WS_Y), (const int*)(F.ws + WS_EDST)};
                    pg8::gemm_phase<512, 512, 512, EpiMoe2, MoeOrder, true>(F.lds, g, S, E, F.tid); }
            }
        }
        __syncthreads();
        SEAM(ph);
    }
#undef SEAM
}

extern "C" void kernel_launch(void* const* d_in, const int* in_sizes, int n_in, void* d_out, int out_size, void* d_ws, size_t ws_size, hipStream_t stream) {
    static int grid = 0;
    if (grid == 0) {
        if (n_in != 18 || out_size != T * DM || ws_size < WS_END) { fprintf(stderr, "kernel_launch: unexpected problem (n_in %d, out %d, ws %zu)\n", n_in, out_size, ws_size); grid = -1; return; }
        int dev = 0, cus = 0;
        if (hipGetDevice(&dev) != hipSuccess || hipDeviceGetAttribute(&cus, hipDeviceAttributeMultiprocessorCount, dev) != hipSuccess) { grid = -1; return; }
        if (hipFuncSetAttribute((const void*)fwd_kernel, hipFuncAttributeMaxDynamicSharedMemorySize, LDS_BYTES) != hipSuccess) { fprintf(stderr, "kernel_launch: hipFuncSetAttribute failed\n"); grid = -1; return; }
        (void)hipGetLastError();
        grid = cus;
        if (grid != 256) fprintf(stderr, "kernel_launch: %d CUs (built for 256)\n", grid);
    }
    if (grid < 0) return;
    (void)hipMemsetAsync((char*)d_ws + WS_CTL, 0, CTL_ZERO_BYTES, stream);
    Args a{};
    for (int i = 0; i < 18; ++i) a.in[i] = (const float*)d_in[i];
    a.out = (float*)d_out; a.ws = (unsigned char*)d_ws;
#if ONE_LAUNCH
    a.ph_lo = 0; a.ph_hi = N_PHASES;
    hipLaunchKernelGGL(fwd_kernel, dim3(grid), dim3(NTHR), LDS_BYTES, stream, a);
#else
    for (int ph = 0; ph < N_PHASES; ++ph) {
        const int s = ph == 0 || ph == PH_FINAL ? -1 : (ph - 1) % PH_PER_LAYER;
        (void)s;
        a.ph_lo = ph; a.ph_hi = ph + 1;
        hipLaunchKernelGGL(fwd_kernel, dim3(grid), dim3(NTHR), LDS_BYTES, stream, a);
    }
#endif
}
```
